# Optimizing an MI355X kernel written in HIP

```python
import jax, jax.numpy as jnp
from jax import lax
import numpy as np

D_MODEL = 1024
BATCH = 8
SEQ = 2048
DEPTH = 1

GLA_HEADS = 4
GLA_DK = 64
GLA_DV = 128
GLA_GATE_RANK = 16
GLA_GATE_NORMALIZER = 16.0
GLA_CHUNK = 64
MLA_HEADS = 8
MLA_NOPE = 64
MLA_ROPE = 32
MLA_QK = MLA_NOPE + MLA_ROPE
MLA_V = 64
MLA_Q_RANK = 256
MLA_KV_RANK = 128
ROPE_BASE = 10000.0
Q_BLOCK = 128
GLA_WIDTH = GLA_HEADS * GLA_DV
MLA_WIDTH = MLA_HEADS * MLA_V
MIX_WIDTH = GLA_WIDTH + MLA_WIDTH
IN_SPLITS = (GLA_HEADS * GLA_DK, GLA_HEADS * GLA_DK, GLA_WIDTH, GLA_WIDTH,
             GLA_GATE_RANK, GLA_GATE_RANK, MLA_Q_RANK, MLA_KV_RANK, MLA_ROPE)
IN_WIDTH = sum(IN_SPLITS)
N_GROUPS = 4
EXPERTS_PER_GROUP = 8
TOP_K_IN_GROUP = 2
D_EXPERT = 256
EPS = 1e-6

kernel_name = 'hybrid_gla_mla_hmoe_encoder_block'


def rms_norm(x, gain):
    xf = x.astype(jnp.float32)
    y = xf * lax.rsqrt(jnp.mean(xf * xf, axis=-1, keepdims=True) + EPS)
    return (y * gain.astype(jnp.float32)).astype(x.dtype)


def gla_chunked(q, k, v, g, strict):
    B, H, S, DK = q.shape
    DV = v.shape[-1]
    C = GLA_CHUNK
    n = S // C
    qc = q.reshape(B, H, n, C, DK)
    kc = k.reshape(B, H, n, C, DK)
    vc = v.reshape(B, H, n, C, DV)
    b = jnp.cumsum(g.reshape(B, H, n, C, DK), axis=3)
    b_ref = b[:, :, :, C // 2 - 1:C // 2, :]
    q_rel = qc * jnp.exp(b - b_ref)
    k_rel = kc * jnp.exp(b_ref - b)
    scores = jnp.einsum('bhnid,bhnjd->bhnij', q_rel, k_rel)
    mask = jnp.tril(jnp.ones((C, C), dtype=bool), k=-1 if strict else 0)
    scores = jnp.where(mask, scores, 0.0)
    o_intra = jnp.einsum('bhnij,bhnjv->bhniv', scores, vc)
    b_last = b[:, :, :, -1:, :]
    kv_chunk = jnp.einsum('bhncd,bhncv->nbhdv', kc * jnp.exp(b_last - b), vc)
    decay_chunk = jnp.moveaxis(jnp.exp(b_last[:, :, :, 0, :]), 2, 0)

    def step(state, inp):
        dec, kv = inp
        return dec[..., None] * state + kv, state

    state0 = jnp.zeros((B, H, DK, DV), dtype=q.dtype)
    _, states = lax.scan(step, state0, (decay_chunk, kv_chunk))
    o_inter = jnp.einsum('bhnid,nbhdv->bhniv', qc * jnp.exp(b), states)
    return (o_intra + o_inter).reshape(B, H, S, DV)


def rope_tables(positions):
    inv_freq = ROPE_BASE ** (-jnp.arange(0, MLA_ROPE, 2, dtype=jnp.float32) / MLA_ROPE)
    ang = positions.astype(jnp.float32)[..., None] * inv_freq
    return jnp.cos(ang)[:, :, None, :], jnp.sin(ang)[:, :, None, :]


def apply_rope(t, cos, sin):
    t1, t2 = jnp.split(t, 2, axis=-1)
    return jnp.concatenate([t1 * cos - t2 * sin, t1 * sin + t2 * cos], axis=-1)


def dense_block_attention(q, k, v):
    B, S, H, Dq = q.shape
    Dv = v.shape[-1]
    n = S // Q_BLOCK
    qb = q.reshape(B, n, Q_BLOCK, H, Dq).transpose(1, 0, 3, 2, 4)
    kh = k.transpose(0, 2, 1, 3).astype(jnp.float32)
    vh = v.transpose(0, 2, 1, 3).astype(jnp.float32)
    scale = Dq ** -0.5

    def one_block(q_blk):
        s = jnp.einsum('bhqd,bhkd->bhqk', q_blk.astype(jnp.float32), kh) * scale
        p = jax.nn.softmax(s, axis=-1)
        return jnp.einsum('bhqk,bhkv->bhqv', p, vh)

    o = lax.map(one_block, qb)
    return o.transpose(1, 0, 3, 2, 4).reshape(B, S, H * Dv)


def hybrid_mixer(h, positions, w_in, gla_gk_fwd_w, gla_gk_fwd_b, gla_gk_bwd_w, gla_gk_bwd_b,
                 gla_out_gain, mla_q_gain, mla_w_qb, mla_kv_gain, mla_w_kvb,
                 q_norm_gain, k_norm_gain, w_out):
    B, S, _ = h.shape
    f32 = jnp.float32
    proj = h @ w_in
    split_idx = [int(i) for i in np.cumsum(IN_SPLITS)[:-1]]
    g_q, g_k, g_v, g_gate, g_lr_f, g_lr_b, m_q_a, m_kv_a, m_k_rope = jnp.split(proj, split_idx, axis=-1)

    def heads(t, d):
        return t.reshape(B, S, GLA_HEADS, d).transpose(0, 2, 1, 3).astype(f32)

    q = heads(g_q, GLA_DK) * GLA_DK ** -0.5
    k = heads(g_k, GLA_DK)
    v = heads(g_v, GLA_DV)
    lg_f = jax.nn.log_sigmoid((g_lr_f @ gla_gk_fwd_w + gla_gk_fwd_b).astype(f32)) / GLA_GATE_NORMALIZER
    lg_b = jax.nn.log_sigmoid((g_lr_b @ gla_gk_bwd_w + gla_gk_bwd_b).astype(f32)) / GLA_GATE_NORMALIZER
    g_f = heads(lg_f, GLA_DK)
    g_b = heads(lg_b, GLA_DK)
    flip = lambda t: t[:, :, ::-1]
    o_fwd = gla_chunked(q, k, v, g_f, False)
    o_bwd = flip(gla_chunked(flip(q), flip(k), flip(v), flip(g_b), True))
    o_gla = (o_fwd + o_bwd).transpose(0, 2, 1, 3)
    o_gla = rms_norm(o_gla, gla_out_gain) * jax.nn.silu(g_gate.reshape(B, S, GLA_HEADS, GLA_DV).astype(f32))
    gla_out = o_gla.reshape(B, S, GLA_WIDTH).astype(h.dtype)

    mq = (rms_norm(m_q_a, mla_q_gain) @ mla_w_qb).reshape(B, S, MLA_HEADS, MLA_QK)
    mkv = (rms_norm(m_kv_a, mla_kv_gain) @ mla_w_kvb).reshape(B, S, MLA_HEADS, MLA_NOPE + MLA_V)
    mk_nope, mv = mkv[..., :MLA_NOPE], mkv[..., MLA_NOPE:]
    mk = jnp.concatenate([mk_nope, jnp.broadcast_to(m_k_rope[:, :, None, :], (B, S, MLA_HEADS, MLA_ROPE))], axis=-1)
    mq = rms_norm(mq, q_norm_gain).astype(f32)
    mk = rms_norm(mk, k_norm_gain).astype(f32)
    cos, sin = rope_tables(positions)
    mq = jnp.concatenate([mq[..., :MLA_NOPE], apply_rope(mq[..., MLA_NOPE:], cos, sin)], axis=-1)
    mk = jnp.concatenate([mk[..., :MLA_NOPE], apply_rope(mk[..., MLA_NOPE:], cos, sin)], axis=-1)
    mla_out = dense_block_attention(mq, mk, mv).astype(h.dtype)

    return jnp.concatenate([gla_out, mla_out], axis=-1) @ w_out


def hierarchical_moe(h, w_router_group, b_router_group, w_router_expert, b_router_expert,
                     w_expert_gate, w_expert_up, w_expert_down):
    B, S, D = h.shape
    f32 = jnp.float32
    t = h.reshape(B * S, D)
    p_group = jax.nn.softmax((t @ w_router_group).astype(f32) + b_router_group.astype(f32), axis=-1)
    g_idx = jnp.argmax(p_group, axis=-1)
    g_onehot = jax.nn.one_hot(g_idx, N_GROUPS, dtype=f32)
    p_top_group = jnp.sum(p_group * g_onehot, axis=-1)
    logits_e = ((t @ w_router_expert).astype(f32) + b_router_expert.astype(f32)).reshape(-1, N_GROUPS, EXPERTS_PER_GROUP)
    logits_sel = jnp.take_along_axis(logits_e, g_idx[:, None, None], axis=1)[:, 0]
    p_e = jax.nn.softmax(logits_sel, axis=-1)
    top_v, top_i = lax.top_k(p_e, TOP_K_IN_GROUP)
    top_v = top_v / jnp.sum(top_v, axis=-1, keepdims=True)
    w_in_group = jnp.sum(jax.nn.one_hot(top_i, EXPERTS_PER_GROUP, dtype=f32) * top_v[..., None], axis=1)
    gate = g_onehot[:, :, None] * (p_top_group[:, None] * w_in_group)[:, None, :]
    out = jnp.zeros_like(t)
    for gi in range(N_GROUPS):
        hid = jax.nn.silu(jnp.einsum('td,edf->tef', t, w_expert_gate[gi])) * jnp.einsum('td,edf->tef', t, w_expert_up[gi])
        hid = hid * gate[:, gi, :, None].astype(t.dtype)
        out = out + jnp.einsum('tef,efd->td', hid, w_expert_down[gi])
    return out.reshape(B, S, D)


def setup_inputs(seed: int = 0) -> dict:
    key = jax.random.key(seed)
    ks = jax.random.split(key, 24)
    L = DEPTH
    f32 = jnp.float32

    def nrm(k, shape, fan_in):
        return jax.random.normal(k, shape, f32) * fan_in ** -0.5

    def gain(k, shape):
        return 1.0 + 0.05 * jax.random.normal(k, shape, f32)

    def bias(k, shape):
        return 0.01 * jax.random.normal(k, shape, f32)

    return {
        'x': jax.random.normal(ks[0], (BATCH, SEQ, D_MODEL), f32),
        'positions': jnp.broadcast_to(jnp.arange(SEQ, dtype=jnp.int32)[None, :], (BATCH, SEQ)),
        'norm1_gain': gain(ks[1], (L, D_MODEL)),
        'w_in': nrm(ks[2], (L, D_MODEL, IN_WIDTH), D_MODEL),
        'gla_gk_fwd_w': nrm(ks[3], (L, GLA_GATE_RANK, GLA_HEADS * GLA_DK), GLA_GATE_RANK),
        'gla_gk_fwd_b': bias(ks[4], (L, GLA_HEADS * GLA_DK)),
        'gla_gk_bwd_w': nrm(ks[5], (L, GLA_GATE_RANK, GLA_HEADS * GLA_DK), GLA_GATE_RANK),
        'gla_gk_bwd_b': bias(ks[6], (L, GLA_HEADS * GLA_DK)),
        'gla_out_gain': gain(ks[7], (L, GLA_DV)),
        'mla_q_gain': gain(ks[8], (L, MLA_Q_RANK)),
        'mla_w_qb': nrm(ks[9], (L, MLA_Q_RANK, MLA_HEADS * MLA_QK), MLA_Q_RANK),
        'mla_kv_gain': gain(ks[10], (L, MLA_KV_RANK)),
        'mla_w_kvb': nrm(ks[11], (L, MLA_KV_RANK, MLA_HEADS * (MLA_NOPE + MLA_V)), MLA_KV_RANK),
        'q_norm_gain': gain(ks[12], (L, MLA_QK)),
        'k_norm_gain': gain(ks[13], (L, MLA_QK)),
        'w_out': nrm(ks[14], (L, MIX_WIDTH, D_MODEL), MIX_WIDTH),
        'norm2_gain': gain(ks[15], (L, D_MODEL)),
        'w_router_group': nrm(ks[16], (L, D_MODEL, N_GROUPS), D_MODEL),
        'b_router_group': bias(ks[17], (L, N_GROUPS)),
        'w_router_expert': nrm(ks[18], (L, D_MODEL, N_GROUPS * EXPERTS_PER_GROUP), D_MODEL),
        'b_router_expert': bias(ks[19], (L, N_GROUPS * EXPERTS_PER_GROUP)),
        'w_expert_gate': nrm(ks[20], (L, N_GROUPS, EXPERTS_PER_GROUP, D_MODEL, D_EXPERT), D_MODEL),
        'w_expert_up': nrm(ks[21], (L, N_GROUPS, EXPERTS_PER_GROUP, D_MODEL, D_EXPERT), D_MODEL),
        'w_expert_down': nrm(ks[22], (L, N_GROUPS, EXPERTS_PER_GROUP, D_EXPERT, D_MODEL), D_EXPERT),
    }


def reference(x, positions, norm1_gain, w_in, gla_gk_fwd_w, gla_gk_fwd_b, gla_gk_bwd_w, gla_gk_bwd_b,
              gla_out_gain, mla_q_gain, mla_w_qb, mla_kv_gain, mla_w_kvb, q_norm_gain, k_norm_gain,
              w_out, norm2_gain, w_router_group, b_router_group, w_router_expert, b_router_expert,
              w_expert_gate, w_expert_up, w_expert_down):
    for l in range(DEPTH):
        h = rms_norm(x, norm1_gain[l])
        x = x + hybrid_mixer(h, positions, w_in[l], gla_gk_fwd_w[l], gla_gk_fwd_b[l], gla_gk_bwd_w[l],
                             gla_gk_bwd_b[l], gla_out_gain[l], mla_q_gain[l], mla_w_qb[l], mla_kv_gain[l],
                             mla_w_kvb[l], q_norm_gain[l], k_norm_gain[l], w_out[l])
        h = rms_norm(x, norm2_gain[l])
        x = x + hierarchical_moe(h, w_router_group[l], b_router_group[l], w_router_expert[l],
                                 b_router_expert[l], w_expert_gate[l], w_expert_up[l], w_expert_down[l])
    return x
```

```cpp
#include <hip/hip_runtime.h>
#include <cstdio>
#include <cstdint>

typedef _Float16 h16;

constexpr int BATCH = 8, SEQ = 2048, T = BATCH * SEQ, DM = 1024;
constexpr int NPROJ = 2048;
constexpr int PC_Q = 0, PC_K = 256, PC_V = 512, PC_GATE = 1024, PC_MQA = 1536, PC_MKVA = 1792, PC_KROPE = 1920, PC_LRF = 1952, PC_LRB = 1968;
constexpr int NEXP = 32, DEXP = 256;
constexpr int ECAP = 16384;
constexpr int SLOT_ROWS = 32768 + 32 * 256;
constexpr float EPS = 1e-6f;

constexpr size_t MiB = 1u << 20;
constexpr size_t WS_CTL = 0;
constexpr size_t WS_WINT = 1 * MiB;
constexpr size_t WS_WQBT = 5 * MiB;
constexpr size_t WS_WKVBT = 5 * MiB + 512 * 1024;
constexpr size_t WS_WOUTT = 6 * MiB;
constexpr size_t WS_WGUT = 8 * MiB;
constexpr size_t WS_WDT = 40 * MiB;
constexpr size_t WS_ROUTE = 56 * MiB;
constexpr size_t WS_RS2 = WS_ROUTE + 256 * 1024;
constexpr size_t WS_TOKE = WS_RS2 + 64 * 1024;
constexpr size_t WS_TOKP = WS_TOKE + 128 * 1024;
constexpr size_t WS_TOKW = WS_TOKP + 128 * 1024;
constexpr size_t WS_ETOK = WS_ROUTE + 1 * MiB;
constexpr size_t WS_A = 60 * MiB;
constexpr size_t WS_H1 = WS_A, WS_PROJ = WS_A + 32 * MiB, WS_MIX = WS_A, WS_Y = WS_A;
constexpr size_t WS_B = 156 * MiB;
constexpr size_t WS_QF = WS_B, WS_KF = WS_B + 24 * MiB, WS_VF = WS_B + 48 * MiB, WS_HID = WS_B;
constexpr size_t WS_OGLA = 220 * MiB;
constexpr size_t WS_X1H = WS_OGLA;
constexpr size_t WS_WRT16 = WS_ROUTE + 3 * MiB;
constexpr size_t WS_SSQ = 254 * MiB;
constexpr size_t WS_ESC = 200 * MiB;
constexpr size_t WS_CS = 252 * MiB;
constexpr size_t WS_END = 256 * MiB;

__device__ __forceinline__ int win_src_col(int n) {
    if (n < 1536) return n;
    if (n < 1792) return 1568 + (n - 1536);
    if (n < 1920) return 1824 + (n - 1792);
    if (n < 1952) return 1952 + (n - 1920);
    if (n < 1968) return 1536 + (n - 1952);
    if (n < 1984) return 1552 + (n - 1968);
    return -1;
}

#define LAS __attribute__((address_space(3)))
#define GAS __attribute__((address_space(1)))
typedef unsigned u32x4 __attribute__((ext_vector_type(4)));
typedef float f32x4 __attribute__((ext_vector_type(4)));
#define LDS_WAIT() asm volatile("s_waitcnt lgkmcnt(0)" ::: "memory")
#define VM_WAIT() asm volatile("s_waitcnt vmcnt(0)" ::: "memory")
constexpr int NWAVES = 8, NTHREADS = 512;
constexpr int RING_BYTES = 131072, MISC_OFF = RING_BYTES + 320, LDS_BYTES = 147456;
constexpr int CW_CNT = 0;
constexpr int CW_BAR = 4096;
constexpr int CW_GLADONE = 10240;
constexpr int CW_Q = 12288;
constexpr size_t CTL_ZERO_BYTES = 131072;
constexpr int CW_MOEQ = 14336;
constexpr int CW_DONE = 16384;
constexpr int PH_MIX = 3, PH_COMB = 4, PH_OUT = 5, PH_ROUTE = 6, PH_UP = 7, PH_DOWN = 8, PH_FIN = 9, PH_END = 10;

__device__ __forceinline__ unsigned pk_h2(float a, float b) { typedef _Float16 h2 __attribute__((ext_vector_type(2))); h2 v = {(h16)a, (h16)b}; return __builtin_bit_cast(unsigned, v); }

#define XB_TMO      128
#define XB_XCNT(j)  (256  + 64 * (j))
#define XB_XSUB(j)  (1280 + 64 * (j))
#define XB_XGEN(j)  (2304 + 64 * (j))
#define XB_TOP      3328
#define XB_TOPGEN   3392
#define XCD_BAR_WORDS 3456
#define XB_SPIN_CAP (1u << 18)
__device__ __forceinline__ unsigned xb_ld(unsigned* p)              { return __hip_atomic_load(p, __ATOMIC_RELAXED, __HIP_MEMORY_SCOPE_AGENT); }
__device__ __forceinline__ unsigned xb_add(unsigned* p, unsigned v) { return __hip_atomic_fetch_add(p, v, __ATOMIC_RELAXED, __HIP_MEMORY_SCOPE_AGENT); }
__device__ __forceinline__ unsigned xb_xcc_id() { return (unsigned)__builtin_amdgcn_s_getreg((3 << 11) | 20) & 0xFu; }
#define XB_SPIN(cond, bar) do { unsigned _sp = 0; while (cond) { __builtin_amdgcn_s_sleep(1); \
    if ((++_sp & 255u) == 0u) { if (xb_ld(&(bar)[XB_TMO])) break; if (_sp > XB_SPIN_CAP) { atomicAdd(&(bar)[XB_TMO], 1u); break; } } } } while (0)
struct XcdBarrier { unsigned* bar; unsigned x; volatile LAS unsigned* st; };
__device__ __forceinline__ XcdBarrier xcd_barrier_post(unsigned* bar, volatile LAS unsigned* st) {
    XcdBarrier b; b.bar = bar; b.x = xb_xcc_id(); b.st = st;
    if (threadIdx.x == 0) (void)xb_add(&bar[XB_XCNT(b.x)], 1u);
    return b;
}
__device__ __forceinline__ void xcd_barrier_complete(unsigned* bar, unsigned x, unsigned& nloc, unsigned& nx) {
    const unsigned G = gridDim.x * gridDim.y * gridDim.z;
    unsigned sum, cnt, mine, sp = 0u;
    for (;;) {
        sum = 0u; cnt = 0u; mine = 0u;
#pragma unroll
        for (unsigned j = 0; j < 16; ++j) { const unsigned c = xb_ld(&bar[XB_XCNT(j)]); sum += c; cnt += (c > 0u) ? 1u : 0u; mine = (j == x) ? c : mine; }
        if (sum == G) break;
        __builtin_amdgcn_s_sleep(1);
        if ((++sp & 255u) == 0u) { if (xb_ld(&bar[XB_TMO])) break; if (sp > XB_SPIN_CAP) { atomicAdd(&bar[XB_TMO], 1u); break; } }
    }
    nloc = mine > 0u ? mine : 1u; nx = cnt > 0u ? cnt : 1u;
}
__device__ __forceinline__ void xcd_barrier(const XcdBarrier& b) {
    asm volatile("s_waitcnt vmcnt(0)" ::: "memory");
    __syncthreads();
    if (threadIdx.x == 0) {
        unsigned* bar = b.bar;
        __builtin_amdgcn_s_waitcnt(0);
        unsigned nloc = b.st[0], nx = b.st[1];
        if (nloc == 0u) { xcd_barrier_complete(bar, b.x, nloc, nx); b.st[0] = nloc; b.st[1] = nx; }
        const unsigned old = xb_add(&bar[XB_XSUB(b.x)], 1u);
        const unsigned gen = old / nloc;
        if (old + 1u == (gen + 1u) * nloc) {
            __builtin_amdgcn_fence(__ATOMIC_RELEASE, "agent");
            asm volatile("s_waitcnt vmcnt(0)" ::: "memory");
            const unsigned og = xb_add(&bar[XB_TOP], 1u);
            const unsigned tg = og / nx;
            if (og + 1u == (tg + 1u) * nx) xb_add(&bar[XB_TOPGEN], 1u);
            else XB_SPIN(xb_ld(&bar[XB_TOPGEN]) == tg, bar);
            __builtin_amdgcn_fence(__ATOMIC_ACQUIRE, "agent");
            xb_add(&bar[XB_XGEN(b.x)], 1u);
            asm volatile("s_waitcnt vmcnt(0)" ::: "memory");
        } else {
            XB_SPIN(xb_ld(&bar[XB_XGEN(b.x)]) == gen, bar);
            __builtin_amdgcn_fence(__ATOMIC_ACQUIRE, "agent");
            asm volatile("s_waitcnt vmcnt(0)" ::: "memory");
        }
    }
    __syncthreads();
}

template <int NBATCH>
__device__ __forceinline__ void tr_item(const float* __restrict__ src, int src_ld, int k0, int c0, h16* __restrict__ dst, int dst_ld, long row0, int rstride,
                                        const float* __restrict__ kg, float scale, LAS float* scr, int lane) {
#pragma unroll
    for (int bt = 0; bt < 32 / NBATCH; ++bt) {
        float tv[NBATCH];
#pragma unroll
        for (int i = 0; i < NBATCH; ++i) { const int kk = 2 * (bt * NBATCH + i) + (lane >> 5); tv[i] = src[(size_t)(k0 + kk) * src_ld + c0 + (lane & 31)]; }
#pragma unroll
        for (int i = 0; i < NBATCH; ++i) { const int kk = 2 * (bt * NBATCH + i) + (lane >> 5); float v = tv[i] * scale; if (kg) v *= kg[k0 + kk]; scr[kk * 33 + (lane & 31)] = v; }
    }
    LDS_WAIT(); asm volatile("" ::: "memory");
    const int c = lane & 7;
#pragma unroll
    for (int j = 0; j < 4; ++j) { const int n = (lane >> 3) + 8 * j; const LAS float* s = scr + (8 * c) * 33 + n;
        u32x4 o; o.x = pk_h2(s[0 * 33], s[1 * 33]); o.y = pk_h2(s[2 * 33], s[3 * 33]); o.z = pk_h2(s[4 * 33], s[5 * 33]); o.w = pk_h2(s[6 * 33], s[7 * 33]);
        *(u32x4*)(dst + (size_t)(row0 + (long)n * rstride) * dst_ld + k0 + 8 * c) = o; }
    LDS_WAIT(); asm volatile("" ::: "memory");
}
struct TrP { const float* src; int src_ld, k0, c0; h16* dst; int dst_ld; long row0; int rstride; const float* kg; };
__device__ __forceinline__ void tr_load(const TrP& p, float (&tv)[32], int lane) {
#pragma unroll
    for (int i = 0; i < 32; ++i) { const int kk = 2 * i + (lane >> 5); tv[i] = p.src[(size_t)(p.k0 + kk) * p.src_ld + p.c0 + (lane & 31)]; }
}
__device__ __forceinline__ void tr_finish(const TrP& p, const float (&tv)[32], LAS float* scr, int lane) {
#pragma unroll
    for (int i = 0; i < 32; ++i) { const int kk = 2 * i + (lane >> 5); float v = tv[i]; if (p.kg) v *= p.kg[p.k0 + kk]; scr[kk * 33 + (lane & 31)] = v; }
    LDS_WAIT(); asm volatile("" ::: "memory");
    const int c = lane & 7;
#pragma unroll
    for (int j = 0; j < 4; ++j) { const int n = (lane >> 3) + 8 * j; const LAS float* s = scr + (8 * c) * 33 + n;
        u32x4 o; o.x = pk_h2(s[0 * 33], s[1 * 33]); o.y = pk_h2(s[2 * 33], s[3 * 33]); o.z = pk_h2(s[4 * 33], s[5 * 33]); o.w = pk_h2(s[6 * 33], s[7 * 33]);
        *(u32x4*)(p.dst + (size_t)(p.row0 + (long)n * p.rstride) * p.dst_ld + p.k0 + 8 * c) = o; }
    LDS_WAIT(); asm volatile("" ::: "memory");
}
__device__ __forceinline__ float wave_sum(float v) {
#pragma unroll
    for (int o = 1; o < 64; o <<= 1) v += __shfl_xor(v, o);
    return v;
}
struct MArgs { const void* in[24]; float* out; unsigned char* ws; int ph_lo, ph_hi, li, pad; };

__device__ __forceinline__ TrP expert_params(const MArgs& a, int r) {
    unsigned char* ws = a.ws;
    const float* wg = (const float*)a.in[21]; const float* wu = (const float*)a.in[22]; const float* wd = (const float*)a.in[23]; const float* gain2 = (const float*)a.in[16];
    h16* WguT = (h16*)(ws + WS_WGUT); h16* WdT = (h16*)(ws + WS_WDT);
    if (r < 8192) { const int e = r >> 8, sx = (r >> 7) & 1, kb = (r >> 3) & 15, nb = r & 7;
        return TrP{(sx ? wu : wg) + (size_t)e * 1024 * 256, 256, 64 * kb, 32 * nb, WguT, 1024, (long)e * 512 + 64 * nb + sx, 2, gain2}; }
    r -= 8192; const int e = r >> 7, kb = (r >> 5) & 3, nb = r & 31;
    return TrP{wd + (size_t)e * 256 * 1024, 1024, 64 * kb, 32 * nb, WdT, 256, (long)e * 1024 + 32 * nb, 1, nullptr};
}
__device__ __forceinline__ void expert_items4(const MArgs& a, int r0, LAS float* scr, int lane) {
    float ta[32], tb[32];
    const TrP p0 = expert_params(a, r0), p1 = expert_params(a, r0 + 1), p2 = expert_params(a, r0 + 2), p3 = expert_params(a, r0 + 3);
    tr_load(p0, ta, lane); tr_load(p1, tb, lane);
    tr_finish(p0, ta, scr, lane); tr_load(p2, ta, lane);
    tr_finish(p1, tb, scr, lane); tr_load(p3, tb, lane);
    tr_finish(p2, ta, scr, lane); tr_finish(p3, tb, scr, lane);
}

__device__ __forceinline__ void p0_prologue(const MArgs& a, LAS unsigned char* lds, int gw, int NGW, int lane, int wave) {
    unsigned char* ws = a.ws;
    LAS float* scr = (LAS float*)(lds + wave * 16384);
    const float* w_in = (const float*)a.in[3]; const float* w_qb = (const float*)a.in[10]; const float* w_kvb = (const float*)a.in[12]; const float* w_out = (const float*)a.in[15];
    const float* wg = (const float*)a.in[21]; const float* wu = (const float*)a.in[22]; const float* wd = (const float*)a.in[23];
    const float* q_gain = (const float*)a.in[9]; const float* kv_gain = (const float*)a.in[11]; const float* gain2 = (const float*)a.in[16];
    h16* WinT = (h16*)(ws + WS_WINT); h16* WqbT = (h16*)(ws + WS_WQBT); h16* WkvbT = (h16*)(ws + WS_WKVBT); h16* WoutT = (h16*)(ws + WS_WOUTT);
    h16* WguT = (h16*)(ws + WS_WGUT); h16* WdT = (h16*)(ws + WS_WDT);
    constexpr int I_IN = 16 * 62, I_OUT = 16 * 32, I_QB = 4 * 24, I_KVB = 2 * 32;
    constexpr int NITEMS = I_IN + I_OUT + I_QB + I_KVB;
    for (int it = gw; it < NITEMS; it += NGW) {
        int r = it;
        if (r < I_IN) { const int kb = r / 62, nb = r % 62, n0 = 32 * nb;
            tr_item<32>(w_in, 1984, 64 * kb, win_src_col(n0), WinT, 1024, n0, 1, nullptr, n0 < 256 ? 0.125f : 1.f, scr, lane); continue; }
        r -= I_IN;
        if (r < I_OUT) { const int kb = r >> 5, nb = r & 31;
            tr_item<32>(w_out, 1024, 64 * kb, 32 * nb, WoutT, 1024, 32 * nb, 1, nullptr, 1.f, scr, lane); continue; }
        r -= I_OUT;
        if (r < I_QB) { const int kb = r / 24, nb = r % 24, c0 = 32 * nb, h = c0 / 96, d0 = c0 % 96;
            tr_item<32>(w_qb, 768, 64 * kb, c0, WqbT, 256, h * 128 + d0, 1, q_gain, 1.f, scr, lane); continue; }
        r -= I_QB;
        { const int kb = r >> 5, nb = r & 31;
            tr_item<32>(w_kvb, 1024, 64 * kb, 32 * nb, WkvbT, 256, 32 * nb, 1, kv_gain, 1.f, scr, lane); }
    }
    const u32x4 z4 = {0u, 0u, 0u, 0u};
    for (int i = gw; i < 128; i += NGW) *(u32x4*)((char*)(WinT + (size_t)1984 * 1024) + (size_t)i * 1024 + lane * 16) = z4;
    for (int i = gw; i < 128; i += NGW) { const int row = (i >> 4) * 128 + 96 + 2 * (i & 15) + (lane >> 5);
        *(u32x4*)((char*)(WqbT + (size_t)row * 256) + (lane & 31) * 16) = z4; }
    for (int i = gw; i < 256; i += NGW) { const int row = i * 4 + (lane >> 4);
        *(u32x4*)((char*)(WkvbT + (size_t)row * 256 + 128) + (lane & 15) * 16) = z4; }
    { const float* wrg = (const float*)a.in[17]; const float* wre = (const float*)a.in[19]; h16* W16 = (h16*)(ws + WS_WRT16);
      for (int i = gw; i < 256 * 1024 / 64; i += NGW) { const int idx = i * 64 + lane, k = idx & 1023, j = idx >> 10; float v = 0.f;
          if (j < 4) v = wrg[k * 4 + j] * gain2[k]; else if (j < 36) v = wre[k * 32 + (j - 4)] * gain2[k];
          W16[idx] = (h16)v; } }
    { const int* positions = (const int*)a.in[1]; float* CS = (float*)(ws + WS_CS);
      for (int i = gw; i < T * 16 / 64; i += NGW) { const int idx = i * 64 + lane, m = idx >> 4, fi = idx & 15;
          const float inv = exp2f(-(float)fi * (13.287712379549449f / 16.0f)); const float ang = (float)positions[m] * inv;
          CS[m * 32 + fi] = cosf(ang); CS[m * 32 + 16 + fi] = sinf(ang); } }
    { const float* x = (const float*)a.in[0]; const float* g1 = (const float*)a.in[2]; h16* H1 = (h16*)(ws + WS_H1);
      f32x4 g[4];
#pragma unroll
      for (int j = 0; j < 4; ++j) g[j] = ((const f32x4*)g1)[lane + 64 * j];
      for (int m = gw; m < T; m += 2 * NGW) {
          const int m2 = m + NGW;
          const f32x4* xr = (const f32x4*)(x + (size_t)m * DM) + lane; const f32x4* xr2 = (const f32x4*)(x + (size_t)(m2 < T ? m2 : m) * DM) + lane;
          f32x4 v[4], v2[4]; float s = 0.f, s2 = 0.f;
#pragma unroll
          for (int j = 0; j < 4; ++j) { v[j] = xr[64 * j]; v2[j] = xr2[64 * j]; }
#pragma unroll
          for (int j = 0; j < 4; ++j) { s += (v[j].x * v[j].x + v[j].y * v[j].y) + (v[j].z * v[j].z + v[j].w * v[j].w); s2 += (v2[j].x * v2[j].x + v2[j].y * v2[j].y) + (v2[j].z * v2[j].z + v2[j].w * v2[j].w); }
          const float rs = rsqrtf(wave_sum(s) * (1.f / DM) + EPS), rs2 = rsqrtf(wave_sum(s2) * (1.f / DM) + EPS);
          unsigned long long* o8 = (unsigned long long*)(H1 + (size_t)m * DM) + lane;
#pragma unroll
          for (int j = 0; j < 4; ++j) o8[64 * j] = (unsigned long long)pk_h2(v[j].x * rs * g[j].x, v[j].y * rs * g[j].y) | ((unsigned long long)pk_h2(v[j].z * rs * g[j].z, v[j].w * rs * g[j].w) << 32);
          if (m2 < T) { unsigned long long* p8 = (unsigned long long*)(H1 + (size_t)m2 * DM) + lane;
#pragma unroll
              for (int j = 0; j < 4; ++j) p8[64 * j] = (unsigned long long)pk_h2(v2[j].x * rs2 * g[j].x, v2[j].y * rs2 * g[j].y) | ((unsigned long long)pk_h2(v2[j].z * rs2 * g[j].z, v2[j].w * rs2 * g[j].w) << 32); }
      } }
}

namespace g8 {
typedef _Float16 f16x8 __attribute__((ext_vector_type(8)));
constexpr int BM = 256, BK = 64, HALF = 128, HTB = HALF * BK * 2, STAGE_BYTES = 8 * HTB, NXCD = 8, WGM = 8;
__host__ __device__ __forceinline__ int lds_byte(int r, int c) { const int st = (r >> 4) * 2 + (c >> 5), rr = r & 15, cc = c & 31, ob = rr * 64 + cc * 2; return st * 1024 + (ob ^ (((ob >> 9) & 1) << 5)); }
__host__ __device__ __forceinline__ void stage_rc(int b, int& R, int& C) { const int st = b / 1024, sb = b % 1024, swz = sb ^ (((sb >> 9) & 1) << 5); R = (st >> 1) * 16 + swz / 64; C = (st & 1) * 32 + (swz % 64) / 2; }
__host__ __device__ __forceinline__ int perm32(int rho) { const int n = rho >> 4, i = rho & 15; return 8 * (i >> 2) + 4 * n + (i & 3); }
struct Unit { int pm, pn, e, half; };
struct StaticOrder {
    int nM, nN, nwg, G, c;
    __device__ __forceinline__ void init(int nM_, int nN_, int G_, int c_) { nM = nM_; nN = nN_; nwg = nM * nN; G = G_; c = c_; }
    __device__ __forceinline__ bool next(int i, Unit& u) const {
        const long L = (long)i * G + c; if (L >= nwg) return false;
        int wgid = (int)L; { const int q = nwg / NXCD, r = nwg % NXCD, xcd = wgid % NXCD, off = wgid / NXCD; wgid = (xcd < r ? xcd * (q + 1) : r * (q + 1) + (xcd - r) * q) + off; }
        const int nig = WGM * nN, gid = wgid / nig, fm = gid * WGM, gsz = (nM - fm) < WGM ? (nM - fm) : WGM;
        u.pm = fm + ((wgid % nig) % gsz); u.pn = (wgid % nig) / gsz; u.e = 0; u.half = 0; return true;
    }
    __device__ __forceinline__ void a_ready(const Unit&) const {}
};
struct PlainProb {
    const h16* A; const h16* Bt; int lda, ldb, K;
    __device__ __forceinline__ const char* a_base() const { return (const char*)A; }
    __device__ __forceinline__ unsigned a_row_off(const Unit& u, int h, int R) const { return (unsigned)((u.pm * BM + h * HALF + R) * lda); }
    __device__ __forceinline__ const char* b_base(const Unit& u) const { return (const char*)(Bt + (size_t)u.pn * BM * ldb); }
};

template <class P, class Epi, class Sched, bool ALIGN_EPI, bool HALFSKIP = false>
__device__ __forceinline__ void gemm_phase(LAS unsigned char* lds, const P& p, const Sched& S, const Epi& E) {
    const int tid = threadIdx.x, wid = __builtin_amdgcn_readfirstlane(tid >> 6), lane = tid & 63, wr = wid >> 2, wc = wid & 3, fr = lane & 15, fq = lane >> 4;
    const int K = p.K, nt = K / BK;
    int Rs[2], Cs[2]; unsigned voffB[2];
#pragma unroll
    for (int i = 0; i < 2; ++i) { int R, C; stage_rc(tid * 16 + i * 8192, R, C); Rs[i] = R; Cs[i] = C; const int Rb = Epi::PERM ? ((R & ~31) + perm32(R & 31)) : R; voffB[i] = (unsigned)(Rb * p.ldb + C) * 2u; }
    const size_t kstep = (size_t)(BK * 2);
    const size_t hstepB = (size_t)HALF * p.ldb * 2;
    const unsigned ldsw = (unsigned)wid * 1024u;
    const int aoff = lds_byte(wr * 64 + fr, fq * 8), boff = lds_byte(wc * 32 + fr, fq * 8);
#define G8_SA(b, h) (((b) * 2 + (h)) * HTB)
#define G8_SB(b, h) ((4 + (b) * 2 + (h)) * HTB)
#define G8_STAGE(bufoff, gbase, voff) do { _Pragma("unroll") for (int _i = 0; _i < 2; ++_i) \
        __builtin_amdgcn_global_load_lds((const unsigned*)((const char*)(gbase) + (voff)[_i]), (LAS unsigned*)(lds + (bufoff) + ldsw + _i * 8192), 16, 0, 0); } while (0)
#define G8_LDA(dst, b, h) do { _Pragma("unroll") for (int m = 0; m < 4; ++m) _Pragma("unroll") for (int k = 0; k < 2; ++k) dst[m][k] = *(const LAS f16x8*)(lds + G8_SA(b, h) + aoff + m * 2048 + k * 1024); } while (0)
#define G8_LDB(dst, b, h) do { _Pragma("unroll") for (int n = 0; n < 2; ++n) _Pragma("unroll") for (int k = 0; k < 2; ++k) dst[n][k] = *(const LAS f16x8*)(lds + G8_SB(b, h) + boff + n * 2048 + k * 1024); } while (0)
#define G8_MMA(ai, bj, At, Bt) do { __builtin_amdgcn_s_setprio(1); _Pragma("unroll") for (int m = 0; m < 4; ++m) _Pragma("unroll") for (int n = 0; n < 2; ++n) _Pragma("unroll") for (int k = 0; k < 2; ++k) \
        acc[ai][bj][m][n] = __builtin_amdgcn_mfma_f32_16x16x32_f16(Bt[n][k], At[m][k], acc[ai][bj][m][n], 0, 0, 0); __builtin_amdgcn_s_setprio(0); } while (0)
#define G8_WAIT_V(n) asm volatile("s_waitcnt vmcnt(" #n ")" ::: "memory")
#define G8_WAIT_L(n) asm volatile("s_waitcnt lgkmcnt(" #n ")" ::: "memory")
#define G8_BAR __builtin_amdgcn_s_barrier()
#define G8_SCHED __builtin_amdgcn_sched_barrier(0)
    Unit cur, nxt; int ui = 0;
    if (!S.next(0, cur)) return;
    f32x4 acc[2][2][4][2];
#pragma unroll
    for (int a = 0; a < 2; ++a)
#pragma unroll
        for (int b = 0; b < 2; ++b)
#pragma unroll
            for (int m = 0; m < 4; ++m)
#pragma unroll
                for (int n = 0; n < 2; ++n) acc[a][b][m][n] = (f32x4){0.f, 0.f, 0.f, 0.f};
    f16x8 At[4][2], B0[2][2], B1[2][2];
    const char* const A0 = p.a_base();
    unsigned vAc[2][2], vAn[2][2];
#pragma unroll
    for (int h = 0; h < 2; ++h)
#pragma unroll
        for (int i = 0; i < 2; ++i) vAc[h][i] = (p.a_row_off(cur, h, Rs[i]) + (unsigned)Cs[i]) * 2u;
    const char* cB = p.b_base(cur);
    S.a_ready(cur);
    G8_STAGE(G8_SB(0, 0), cB, voffB); G8_STAGE(G8_SB(0, 1), cB + hstepB, voffB); G8_STAGE(G8_SA(0, 0), A0, vAc[0]); G8_STAGE(G8_SA(0, 1), A0, vAc[1]);
    if (wr == 1) G8_BAR;
    G8_WAIT_V(2); G8_BAR;
    G8_STAGE(G8_SB(1, 0), cB + kstep, voffB); G8_STAGE(G8_SA(1, 0), A0 + kstep, vAc[0]); G8_STAGE(G8_SB(1, 1), cB + hstepB + kstep, voffB);
    G8_WAIT_V(6); G8_BAR;
    for (;;) {
        const bool has_next = S.next(ui + 1, nxt);
        if (has_next) {
#pragma unroll
            for (int h = 0; h < 2; ++h)
#pragma unroll
                for (int i = 0; i < 2; ++i) vAn[h][i] = (p.a_row_off(nxt, h, Rs[i]) + (unsigned)Cs[i]) * 2u;
        } else {
#pragma unroll
            for (int h = 0; h < 2; ++h)
#pragma unroll
                for (int i = 0; i < 2; ++i) vAn[h][i] = vAc[h][i];
        }
        const char* nB = has_next ? p.b_base(nxt) : cB;
        const bool skip1 = HALFSKIP && cur.half != 0;
        for (int t = 0; t < nt; t += 2) {
            const bool last = (t == nt - 2);
            if (last && has_next) S.a_ready(nxt);
            const char* a1 = A0 + (size_t)(t + 1) * kstep;
            const char* a2 = last ? A0 : A0 + (size_t)(t + 2) * kstep; const char* b2 = last ? nB : cB + (size_t)(t + 2) * kstep;
            const char* a3 = a2 + kstep; const char* b3 = b2 + kstep;
            unsigned v2[2][2];
#pragma unroll
            for (int h = 0; h < 2; ++h)
#pragma unroll
                for (int i = 0; i < 2; ++i) v2[h][i] = last ? vAn[h][i] : vAc[h][i];
            G8_LDB(B0, 0, 0); G8_LDB(B1, 0, 1); G8_SCHED; G8_LDA(At, 0, 0); G8_STAGE(G8_SA(1, 1), a1, vAc[1]);
            G8_WAIT_V(8); G8_WAIT_L(0); G8_BAR; G8_MMA(0, 0, At, B0); G8_MMA(0, 1, At, B1); G8_BAR; G8_SCHED;
            if (!skip1) G8_LDA(At, 0, 1); G8_STAGE(G8_SB(0, 0), b2, voffB); G8_STAGE(G8_SB(0, 1), b2 + hstepB, voffB); G8_STAGE(G8_SA(0, 0), a2, v2[0]);
            G8_WAIT_V(8); G8_WAIT_L(0); G8_BAR; if (!skip1) { G8_MMA(1, 0, At, B0); G8_MMA(1, 1, At, B1); } G8_BAR; G8_SCHED;
            G8_LDB(B0, 1, 0); G8_LDB(B1, 1, 1); G8_SCHED; G8_LDA(At, 1, 0); G8_STAGE(G8_SA(0, 1), a2, v2[1]);
            G8_WAIT_V(8); G8_WAIT_L(0); G8_BAR; G8_MMA(0, 0, At, B0); G8_MMA(0, 1, At, B1); G8_BAR; G8_SCHED;
            if (!skip1) G8_LDA(At, 1, 1); G8_STAGE(G8_SB(1, 0), b3, voffB); G8_STAGE(G8_SB(1, 1), b3 + hstepB, voffB); G8_STAGE(G8_SA(1, 0), a3, v2[0]);
            G8_WAIT_V(8); G8_WAIT_L(0); G8_BAR; if (!skip1) { G8_MMA(1, 0, At, B0); G8_MMA(1, 1, At, B1); } G8_BAR; G8_SCHED;
        }
        if constexpr (ALIGN_EPI) { if (wr == 0) G8_BAR; }
        if constexpr (!Epi::AFTER_DRAIN) { E(acc, cur, wr, wc, fr, fq); }
        if (!has_next) break;
#pragma unroll
        for (int a = 0; a < 2; ++a)
#pragma unroll
            for (int b = 0; b < 2; ++b)
#pragma unroll
                for (int m = 0; m < 4; ++m)
#pragma unroll
                    for (int n = 0; n < 2; ++n) acc[a][b][m][n] = (f32x4){0.f, 0.f, 0.f, 0.f};
        cur = nxt; cB = nB; ++ui;
#pragma unroll
        for (int h = 0; h < 2; ++h)
#pragma unroll
            for (int i = 0; i < 2; ++i) vAc[h][i] = vAn[h][i];
        if constexpr (ALIGN_EPI) { if (wr == 1) G8_BAR; }
    }
    G8_WAIT_V(0);
    if constexpr (!ALIGN_EPI) { if (wr == 0) G8_BAR; }
    G8_BAR;
    if constexpr (Epi::AFTER_DRAIN) { E.fused(acc, cur, wr, wc, fr, fq, lds, wid, lane); }
#undef G8_SA
#undef G8_SB
#undef G8_STAGE
#undef G8_LDA
#undef G8_LDB
#undef G8_MMA
#undef G8_WAIT_V
#undef G8_WAIT_L
#undef G8_BAR
#undef G8_SCHED
}
struct EpiH16 {
    static constexpr bool PERM = true, AFTER_DRAIN = false;
    h16* O; int ldc;
    __device__ __forceinline__ void operator()(const f32x4 (&acc)[2][2][4][2], const Unit& u, int wr, int wc, int fr, int fq) const {
        const int row0 = u.pm * BM + wr * 64 + fr, col0 = u.pn * BM + wc * 32 + 8 * fq;
#pragma unroll
        for (int ai = 0; ai < 2; ++ai)
#pragma unroll
            for (int m = 0; m < 4; ++m) { h16* rowp = O + (size_t)(row0 + ai * HALF + m * 16) * ldc + col0;
#pragma unroll
                for (int bj = 0; bj < 2; ++bj) { const f32x4 v0 = acc[ai][bj][m][0], v1 = acc[ai][bj][m][1];
                    u32x4 w; w.x = pk_h2(v0[0], v0[1]); w.y = pk_h2(v0[2], v0[3]); w.z = pk_h2(v1[0], v1[1]); w.w = pk_h2(v1[2], v1[3]);
                    *(u32x4*)(rowp + bj * HALF) = w; } }
    }
};
struct OneUnit { Unit u; __device__ __forceinline__ bool next(int i, Unit& o) const { if (i) return false; o = u; return true; } __device__ __forceinline__ void a_ready(const Unit&) const {} };
typedef unsigned u32x2 __attribute__((ext_vector_type(2)));
__device__ __forceinline__ float ssq8(const u32x4 w) {
    typedef _Float16 h2 __attribute__((ext_vector_type(2))); float s = 0.f;
#pragma unroll
    for (int i = 0; i < 4; ++i) { const unsigned ui = w[i]; const h2 v = __builtin_bit_cast(h2, ui); const float a = (float)v.x, b = (float)v.y; s += a * a + b * b; }
    return s;
}
struct EpiQ {
    static constexpr bool PERM = false, AFTER_DRAIN = true;
    const h16* PROJ; const float* qn_gain; const float* CS; h16* QF;
    __device__ __forceinline__ void fused(f32x4 (&acc)[2][2][4][2], const Unit& u, int wr, int wc, int fr, int fq, LAS unsigned char* lds, int wid, int lane) const {
        LAS float* P = (LAS float*)lds;
        LAS float* RS = (LAS float*)(lds + 8192);
        const int tid = wid * 64 + lane;
#pragma unroll
        for (int ai = 0; ai < 2; ++ai)
#pragma unroll
            for (int m = 0; m < 4; ++m)
#pragma unroll
                for (int bj = 0; bj < 2; ++bj) { float sq = 0.f;
#pragma unroll
                    for (int n = 0; n < 2; ++n) { const f32x4 x = acc[ai][bj][m][n]; sq += (x[0] * x[0] + x[1] * x[1]) + (x[2] * x[2] + x[3] * x[3]); }
                    sq += __shfl_xor(sq, 16); sq += __shfl_xor(sq, 32);
                    if (fq == 0) P[((ai * HALF + wr * 64 + m * 16 + fr) * 2 + bj) * 4 + wc] = sq; }
        { const int row = tid >> 1, half = tid & 1; const u32x4* ap = (const u32x4*)(PROJ + (size_t)(u.pm * BM + row) * NPROJ + PC_MQA + half * 128); float sq = 0.f;
#pragma unroll
          for (int i = 0; i < 16; ++i) sq += ssq8(ap[i]);
          sq += __shfl_xor(sq, 1);
          if (half == 0) RS[row] = rsqrtf(sq * (1.f / 256.f) + EPS); }
        LDS_WAIT(); __builtin_amdgcn_s_barrier(); asm volatile("" ::: "memory");
        if (wc == 3) return;
        const float QS = 0.10206207261596577f * 1.4426950408889634f;
#pragma unroll
        for (int ai = 0; ai < 2; ++ai)
#pragma unroll
            for (int m = 0; m < 4; ++m) { const int r = ai * HALF + wr * 64 + m * 16 + fr, gm = u.pm * BM + r, b = gm / SEQ, sp = gm % SEQ; const float rq = RS[r];
                f32x4 cs = {1.f, 1.f, 1.f, 1.f}, sn = {0.f, 0.f, 0.f, 0.f};
                if (wc == 2) { cs = *(const f32x4*)(CS + (size_t)gm * 32 + 4 * fq); sn = *(const f32x4*)(CS + (size_t)gm * 32 + 16 + 4 * fq); }
#pragma unroll
                for (int bj = 0; bj < 2; ++bj) { const f32x4 pp = *(const LAS f32x4*)(P + (r * 2 + bj) * 4); const float tot = (pp[0] + pp[1]) + (pp[2] + pp[3]);
                    const float sc = rq * rsqrtf(rq * rq * tot * (1.f / 96.f) + EPS) * QS;
                    const int d0 = wc * 32 + 4 * fq; const f32x4 g0 = *(const f32x4*)(qn_gain + d0), g1 = *(const f32x4*)(qn_gain + d0 + 16);
                    f32x4 v0 = acc[ai][bj][m][0] * g0 * sc, v1 = acc[ai][bj][m][1] * g1 * sc;
                    if (wc == 2) { const f32x4 t1 = v0, t2 = v1; v0 = t1 * cs - t2 * sn; v1 = t1 * sn + t2 * cs; }
                    h16* qp = QF + ((size_t)(b * 8 + u.pn * 2 + bj) * SEQ + sp) * 96 + d0;
                    u32x2 w0, w1; w0.x = pk_h2(v0[0], v0[1]); w0.y = pk_h2(v0[2], v0[3]); w1.x = pk_h2(v1[0], v1[1]); w1.y = pk_h2(v1[2], v1[3]);
                    *(u32x2*)qp = w0; *(u32x2*)(qp + 16) = w1; } }
    }
};
struct EpiKV {
    static constexpr bool PERM = false, AFTER_DRAIN = true;
    const h16* PROJ; const float* kn_gain; const float* CS; h16* KF; h16* VF;
    __device__ __forceinline__ void fused(f32x4 (&acc)[2][2][4][2], const Unit& u, int wr, int wc, int fr, int fq, LAS unsigned char* lds, int wid, int lane) const {
        LAS float* P = (LAS float*)lds;
        LAS float* RS = (LAS float*)(lds + 8192);
        LAS float* KR = (LAS float*)(lds + 8192 + 1024);
        const int tid = wid * 64 + lane;
        if (wc < 2) {
#pragma unroll
            for (int ai = 0; ai < 2; ++ai)
#pragma unroll
                for (int m = 0; m < 4; ++m)
#pragma unroll
                    for (int bj = 0; bj < 2; ++bj) { float sq = 0.f;
#pragma unroll
                        for (int n = 0; n < 2; ++n) { const f32x4 x = acc[ai][bj][m][n]; sq += (x[0] * x[0] + x[1] * x[1]) + (x[2] * x[2] + x[3] * x[3]); }
                        sq += __shfl_xor(sq, 16); sq += __shfl_xor(sq, 32);
                        if (fq == 0) P[((ai * HALF + wr * 64 + m * 16 + fr) * 2 + bj) * 2 + wc] = sq; }
        }
        { const int row = tid >> 1, half = tid & 1; const h16* rp = PROJ + (size_t)(u.pm * BM + row) * NPROJ;
          const u32x4* ap = (const u32x4*)(rp + PC_MKVA + half * 64); float sq = 0.f;
#pragma unroll
          for (int i = 0; i < 8; ++i) sq += ssq8(ap[i]);
          const u32x4* kp = (const u32x4*)(rp + PC_KROPE + half * 16); float kq = ssq8(kp[0]) + ssq8(kp[1]);
          sq += __shfl_xor(sq, 1); kq += __shfl_xor(kq, 1);
          if (half == 0) { RS[row] = rsqrtf(sq * (1.f / 128.f) + EPS); KR[row] = kq; } }
        LDS_WAIT(); __builtin_amdgcn_s_barrier(); asm volatile("" ::: "memory");
#pragma unroll
        for (int ai = 0; ai < 2; ++ai)
#pragma unroll
            for (int m = 0; m < 4; ++m) { const int r = ai * HALF + wr * 64 + m * 16 + fr, gm = u.pm * BM + r, b = gm / SEQ, sp = gm % SEQ; const float rkv = RS[r], krs = KR[r];
                if (wc < 2) {
#pragma unroll
                    for (int bj = 0; bj < 2; ++bj) { const float tot = (P[(r * 2 + bj) * 2] + P[(r * 2 + bj) * 2 + 1]) * rkv * rkv + krs;
                        const float sc = rkv * rsqrtf(tot * (1.f / 96.f) + EPS);
                        const int d0 = wc * 32 + 4 * fq; const f32x4 g0 = *(const f32x4*)(kn_gain + d0), g1 = *(const f32x4*)(kn_gain + d0 + 16);
                        const f32x4 v0 = acc[ai][bj][m][0] * g0 * sc, v1 = acc[ai][bj][m][1] * g1 * sc;
                        h16* kp = KF + ((((size_t)(b * 8 + u.pn * 2 + bj) * 32 + (sp >> 6)) * 12 + (d0 >> 3)) * 64 + (sp & 63)) * 8 + (d0 & 7);
                        u32x2 w0, w1; w0.x = pk_h2(v0[0], v0[1]); w0.y = pk_h2(v0[2], v0[3]); w1.x = pk_h2(v1[0], v1[1]); w1.y = pk_h2(v1[2], v1[3]);
                        *(u32x2*)kp = w0; *(u32x2*)(kp + 2 * 512) = w1; }
                } else {
#pragma unroll
                    for (int bj = 0; bj < 2; ++bj) { const int e0 = (wc - 2) * 32 + 4 * fq; const f32x4 v0 = acc[ai][bj][m][0] * rkv, v1 = acc[ai][bj][m][1] * rkv;
                        { int rr = r; asm volatile("" : "+v"(rr)); const int t16 = rr & 15, pos = (rr & 48) + (t16 < 4 ? t16 : t16 < 8 ? t16 + 4 : t16 < 12 ? t16 - 4 : t16);
                          LAS h16* vp = (LAS h16*)(lds + 16384) + (((bj * 4 + (rr >> 6)) * 8 + (pos >> 3)) * 64 + e0) * 8 + (pos & 7);
#pragma unroll
                          for (int j = 0; j < 4; ++j) { vp[j * 8] = (h16)v0[j]; vp[(16 + j) * 8] = (h16)v1[j]; } }
                        }
                    { const int bj = wc - 2; const float tot = (P[(r * 2 + bj) * 2] + P[(r * 2 + bj) * 2 + 1]) * rkv * rkv + krs; const float ri = rsqrtf(tot * (1.f / 96.f) + EPS);
                      typedef _Float16 h4 __attribute__((ext_vector_type(4)));
                      const h16* rp = PROJ + (size_t)gm * NPROJ + PC_KROPE + 4 * fq; const h4 a1 = *(const h4*)rp, a2 = *(const h4*)(rp + 16);
                      const f32x4 g1 = *(const f32x4*)(kn_gain + 64 + 4 * fq), g2 = *(const f32x4*)(kn_gain + 80 + 4 * fq);
                      const f32x4 cs = *(const f32x4*)(CS + (size_t)gm * 32 + 4 * fq), sn = *(const f32x4*)(CS + (size_t)gm * 32 + 16 + 4 * fq);
                      f32x4 t1, t2;
#pragma unroll
                      for (int j = 0; j < 4; ++j) { t1[j] = (float)a1[j] * ri * g1[j]; t2[j] = (float)a2[j] * ri * g2[j]; }
                      const f32x4 o1 = t1 * cs - t2 * sn, o2 = t1 * sn + t2 * cs;
                      h16* kp = KF + ((((size_t)(b * 8 + u.pn * 2 + bj) * 32 + (sp >> 6)) * 12 + ((64 + 4 * fq) >> 3)) * 64 + (sp & 63)) * 8 + ((4 * fq) & 7);
                      u32x2 w0, w1; w0.x = pk_h2(o1[0], o1[1]); w0.y = pk_h2(o1[2], o1[3]); w1.x = pk_h2(o2[0], o2[1]); w1.y = pk_h2(o2[2], o2[3]);
                      *(u32x2*)kp = w0; *(u32x2*)(kp + 2 * 512) = w1; }
                } }
        LDS_WAIT(); __builtin_amdgcn_s_barrier(); asm volatile("" ::: "memory");
        { const int b0 = (u.pm * BM) / SEQ, t0 = ((u.pm * BM) % SEQ) >> 6;
#pragma unroll
          for (int i = 0; i < 8; ++i) { const int ch = i * 512 + tid, blk = ch >> 9, off = ch & 511;
              const u32x4 v = *(const LAS u32x4*)(lds + 16384 + ch * 16);
              *(u32x4*)(VF + (((size_t)(b0 * 8 + u.pn * 2 + (blk >> 2)) * 32 + t0 + (blk & 3)) * 4096) + off * 8) = v; } }
    }
};
struct EpiResid {
    static constexpr bool PERM = true, AFTER_DRAIN = false;
    const float* X; h16* O; float* SSQ;
    __device__ __forceinline__ void operator()(const f32x4 (&acc)[2][2][4][2], const Unit& u, int wr, int wc, int fr, int fq) const {
        const int row0 = u.pm * BM + wr * 64 + fr, col0 = u.pn * BM + wc * 32 + 8 * fq;
#pragma unroll
        for (int ai = 0; ai < 2; ++ai)
#pragma unroll
            for (int m = 0; m < 4; ++m) { const int row = row0 + ai * HALF + m * 16; float sq = 0.f;
#pragma unroll
                for (int bj = 0; bj < 2; ++bj) { const float* xp = X + (size_t)row * DM + col0 + bj * HALF; const f32x4 x0 = *(const f32x4*)xp, x1 = *(const f32x4*)(xp + 4);
                    const f32x4 v0 = acc[ai][bj][m][0] + x0, v1 = acc[ai][bj][m][1] + x1;
                    sq += (v0[0] * v0[0] + v0[1] * v0[1]) + (v0[2] * v0[2] + v0[3] * v0[3]) + (v1[0] * v1[0] + v1[1] * v1[1]) + (v1[2] * v1[2] + v1[3] * v1[3]);
                    u32x4 w; w.x = pk_h2(v0[0], v0[1]); w.y = pk_h2(v0[2], v0[3]); w.z = pk_h2(v1[0], v1[1]); w.w = pk_h2(v1[2], v1[3]);
                    *(u32x4*)(O + (size_t)row * DM + col0 + bj * HALF) = w; }
                sq += __shfl_xor(sq, 16); sq += __shfl_xor(sq, 32);
                if (fq == 0) SSQ[(size_t)row * 16 + u.pn * 4 + wc] = sq; }
    }
};
struct DynGroupSched {
    const volatile LAS int* GT; int ncol; unsigned* ctr; volatile LAS unsigned* slot;
    __device__ __forceinline__ bool next(int i, Unit& u) const {
        if (threadIdx.x == 0) slot[i & 1] = __hip_atomic_fetch_add(ctr, 1u, __ATOMIC_RELAXED, __HIP_MEMORY_SCOPE_AGENT);
        asm volatile("s_waitcnt vmcnt(0) lgkmcnt(0)" ::: "memory"); __builtin_amdgcn_s_barrier(); asm volatile("" ::: "memory");
        const int L = (int)slot[i & 1], total = GT[32] * ncol; if (L >= total) return false;
        const int g = L / ncol, nfull = GT[192 + 32]; int e = 0, pm;
        if (g < nfull) { while (GT[192 + e + 1] <= g) ++e; pm = g - GT[192 + e]; }
        else { e = GT[232 + (g - nfull)]; pm = GT[128 + e] >> 8; }
        u.e = e; u.pm = pm; u.pn = L - g * ncol; u.half = (GT[128 + e] - pm * 256) <= 128; return true;
    }
    __device__ __forceinline__ void a_ready(const Unit&) const {}
};
struct DynGroupSchedDep : DynGroupSched {
    unsigned* DONE; unsigned need;
    __device__ __forceinline__ void a_ready(const Unit& u) const {
        if (threadIdx.x < 64) {
            unsigned* p = DONE + 16 * (GT[u.e] + u.pm); unsigned sp = 0;
            while ((unsigned)__builtin_amdgcn_readfirstlane(__hip_atomic_load(p, __ATOMIC_RELAXED, __HIP_MEMORY_SCOPE_AGENT)) < need) { __builtin_amdgcn_s_sleep(2); if (++sp > (1u << 22)) break; }
            __builtin_amdgcn_fence(__ATOMIC_ACQUIRE, "agent");
            asm volatile("s_waitcnt vmcnt(0)" ::: "memory");
        }
        asm volatile("" ::: "memory"); __builtin_amdgcn_s_barrier(); asm volatile("" ::: "memory");
    }
};
struct GatherProb {
    const h16* X; const h16* W; const int* ETOK; const volatile LAS int* GT; int lda, ldb, K;
    __device__ __forceinline__ const char* a_base() const { return (const char*)X; }
    __device__ __forceinline__ unsigned a_row_off(const Unit& u, int h, int R) const { int pos = u.pm * BM + h * HALF + R; const int n = GT[128 + u.e]; pos = pos < n ? pos : n - 1;
        return (unsigned)ETOK[u.e * ECAP + pos] * (unsigned)lda; }
    __device__ __forceinline__ const char* b_base(const Unit& u) const { return (const char*)(W + ((size_t)u.e * 512 + (size_t)u.pn * BM) * ldb); }
};
struct SlotProb {
    const h16* H; const h16* W; const volatile LAS int* GT; int lda, ldb, K;
    __device__ __forceinline__ const char* a_base() const { return (const char*)H; }
    __device__ __forceinline__ unsigned a_row_off(const Unit& u, int h, int R) const { return (unsigned)((GT[64 + u.e] + u.pm * BM + h * HALF + R) * lda); }
    __device__ __forceinline__ const char* b_base(const Unit& u) const { return (const char*)(W + ((size_t)u.e * 1024 + (size_t)u.pn * BM) * ldb); }
};
struct EpiHid {
    static constexpr bool PERM = true, AFTER_DRAIN = false;
    const float* ESC; const volatile LAS int* GT; h16* HID; unsigned* DONE;
    __device__ __forceinline__ void operator()(const f32x4 (&acc)[2][2][4][2], const Unit& u, int wr, int wc, int fr, int fq) const {
        const int n = GT[128 + u.e], base = GT[64 + u.e];
#pragma unroll
        for (int ai = 0; ai < 2; ++ai) { if (ai == 1 && u.half) break;
#pragma unroll
            for (int m = 0; m < 4; ++m) { const int pos = u.pm * BM + ai * HALF + wr * 64 + m * 16 + fr; const bool ok = pos < n;
                float rs = 0.f, w = 0.f; if (ok) { const float* ep = ESC + ((size_t)u.e * ECAP + pos) * 2; rs = ep[0]; w = ep[1]; }
#pragma unroll
                for (int bj = 0; bj < 2; ++bj) { const f32x4 v0 = acc[ai][bj][m][0] * rs, v1 = acc[ai][bj][m][1] * rs;
                    const float h0 = v0[0] / (1.f + __expf(-v0[0])) * v0[1] * w, h1 = v0[2] / (1.f + __expf(-v0[2])) * v0[3] * w;
                    const float h2 = v1[0] / (1.f + __expf(-v1[0])) * v1[1] * w, h3 = v1[2] / (1.f + __expf(-v1[2])) * v1[3] * w;
                    const unsigned long long o = (unsigned long long)pk_h2(h0, h1) | ((unsigned long long)pk_h2(h2, h3) << 32);
                    __hip_atomic_store((unsigned long long*)(HID + (size_t)(base + pos) * DEXP + u.pn * 128 + bj * 64 + wc * 16 + 4 * fq), o, __ATOMIC_RELAXED, __HIP_MEMORY_SCOPE_AGENT); } } }
        asm volatile("s_waitcnt vmcnt(0)" ::: "memory");
        if (fr == 0 && fq == 0) __hip_atomic_fetch_add(DONE + 16 * (GT[u.e] + u.pm), 1u, __ATOMIC_RELAXED, __HIP_MEMORY_SCOPE_AGENT);
    }
};
struct EpiY {
    static constexpr bool PERM = true, AFTER_DRAIN = false;
    const volatile LAS int* GT; h16* Y;
    __device__ __forceinline__ void operator()(const f32x4 (&acc)[2][2][4][2], const Unit& u, int wr, int wc, int fr, int fq) const {
        const int row0 = GT[64 + u.e] + u.pm * BM + wr * 64 + fr, col0 = u.pn * BM + wc * 32 + 8 * fq;
#pragma unroll
        for (int ai = 0; ai < 2; ++ai) { if (ai == 1 && u.half) break;
#pragma unroll
            for (int m = 0; m < 4; ++m) { h16* rowp = Y + (size_t)(row0 + ai * HALF + m * 16) * DM + col0;
#pragma unroll
                for (int bj = 0; bj < 2; ++bj) { const f32x4 v0 = acc[ai][bj][m][0], v1 = acc[ai][bj][m][1];
                    u32x4 w; w.x = pk_h2(v0[0], v0[1]); w.y = pk_h2(v0[2], v0[3]); w.z = pk_h2(v1[0], v1[1]); w.w = pk_h2(v1[2], v1[3]);
                    *(u32x4*)(rowp + bj * HALF) = w; } } }
    }
};
}

__device__ __forceinline__ void gla_combine_rows(const h16* OGLA, const h16* PROJ, const float* og_gain, h16* MIX, int m0, int m1, int mstep, int lane) {
    typedef _Float16 h8 __attribute__((ext_vector_type(8)));
    const int c = lane * 8;
    const f32x4 g0 = *(const f32x4*)(og_gain + (c & 127)), g1 = *(const f32x4*)(og_gain + (c & 127) + 4);
    for (int mb = m0; mb < m1; mb += 4 * mstep) {
        h8 a[4], b2[4], g[4];
#pragma unroll
        for (int q = 0; q < 4; ++q) { const int m = mb + q * mstep < m1 ? mb + q * mstep : mb;
            a[q] = *(const h8*)(OGLA + (size_t)m * 512 + c); b2[q] = *(const h8*)(OGLA + ((size_t)T + m) * 512 + c); g[q] = *(const h8*)(PROJ + (size_t)m * NPROJ + PC_GATE + c); }
#pragma unroll
        for (int q = 0; q < 4; ++q) { const int m = mb + q * mstep; if (m >= m1) break;
            float o[8]; float sq = 0.f;
#pragma unroll
            for (int k = 0; k < 8; ++k) { o[k] = (float)a[q][k] + (float)b2[q][k]; sq += o[k] * o[k]; }
            sq += __shfl_xor(sq, 1); sq += __shfl_xor(sq, 2); sq += __shfl_xor(sq, 4); sq += __shfl_xor(sq, 8);
            const float rs = rsqrtf(sq * (1.f / 128.f) + EPS);
            float r[8];
#pragma unroll
            for (int k = 0; k < 8; ++k) { const float gg = (float)g[q][k]; r[k] = o[k] * rs * (k < 4 ? g0[k] : g1[k - 4]) * (gg / (1.f + __expf(-gg))); }
            u32x4 w; w.x = pk_h2(r[0], r[1]); w.y = pk_h2(r[2], r[3]); w.z = pk_h2(r[4], r[5]); w.w = pk_h2(r[6], r[7]);
            *(u32x4*)(MIX + (size_t)m * DM + c) = w; }
    }
}

namespace at {
typedef _Float16 f16x8 __attribute__((ext_vector_type(8)));
typedef float f32x16 __attribute__((ext_vector_type(16)));
typedef __fp16 fp16x2 __attribute__((ext_vector_type(2)));
constexpr int KB_BYTES = 12288, VB_BYTES = 8192, TILE_BYTES = KB_BYTES + VB_BYTES, BUF_BYTES = 2 * TILE_BYTES, NT2 = SEQ / 128;
constexpr float THR = 8.f;
__device__ __forceinline__ int crow(int r, int hi) { return (r & 3) + 8 * (r >> 2) + 4 * hi; }
#define AT_DMA(gsrc, ldsoff) __builtin_amdgcn_global_load_lds((const unsigned*)(gsrc), (LAS unsigned*)(lds + (ldsoff)), 16, 0, 0)
__device__ __forceinline__ void attn_unit(LAS unsigned char* lds, const h16* __restrict__ QF, const h16* __restrict__ KF, const h16* __restrict__ VT, h16* __restrict__ MIX, int bh, int qb) {
    int tid = threadIdx.x; asm volatile("" : "+v"(tid));
    const int lane = tid & 63, wid = __builtin_amdgcn_readfirstlane(tid >> 6), r32 = lane & 31, hi = lane >> 5;
    f16x8 qf[6];
    { const h16* qp = QF + ((size_t)bh * SEQ + qb * 256 + wid * 32 + r32) * 96 + hi * 8;
#pragma unroll
      for (int ks = 0; ks < 6; ++ks) qf[ks] = *(const f16x8*)(qp + 16 * ks); }
    LAS float* wsf = (LAS float*)(lds + 2 * BUF_BYTES) + wid * 64;
    const h16* kg = KF + (size_t)bh * SEQ * 96 + wid * 512 + lane * 8;
    const h16* vg = VT + (size_t)bh * SEQ * 64 + wid * 512 + lane * 8;
    const int kdst = wid * 1024, vdst = KB_BYTES + wid * 1024;
#define AT_ISSUE1(t, off) do { AT_DMA(kg + (size_t)(t) * 6144, (off) + kdst); if (wid < 4) AT_DMA(kg + (size_t)(t) * 6144 + 8 * 512, (off) + kdst + 8192); AT_DMA(vg + (size_t)(t) * 4096, (off) + vdst); } while (0)
#define AT_ISSUE(t2, b) do { AT_ISSUE1(2 * (t2), (b) * BUF_BYTES); AT_ISSUE1(2 * (t2) + 1, (b) * BUF_BYTES + TILE_BYTES); } while (0)
    f32x16 o0, o1;
#pragma unroll
    for (int r = 0; r < 16; ++r) { o0[r] = 0.f; o1[r] = 0.f; }
    float m_run = 0.f, l_run = 0.f;
    AT_ISSUE(0, 0);
    asm volatile("s_waitcnt vmcnt(0)" ::: "memory"); __builtin_amdgcn_s_barrier(); asm volatile("" ::: "memory");
    for (int t = 0; t < NT2; ++t) {
        const int cur = t & 1;
        if (t + 1 < NT2) AT_ISSUE(t + 1, cur ^ 1);
        LAS unsigned char* Kb = lds + cur * BUF_BYTES; LAS unsigned char* Vb = Kb + KB_BYTES;
        f32x16 s[4];
        { const float nm = -m_run;
#pragma unroll
          for (int q = 0; q < 4; ++q)
#pragma unroll
              for (int r = 0; r < 16; ++r) s[q][r] = nm; }
#pragma unroll
        for (int tl = 0; tl < 2; ++tl) {
            f16x8 kf[12];
#pragma unroll
            for (int ks = 0; ks < 6; ++ks) { kf[2 * ks] = *(const LAS f16x8*)(Kb + tl * TILE_BYTES + (2 * ks + hi) * 1024 + r32 * 16); kf[2 * ks + 1] = *(const LAS f16x8*)(Kb + tl * TILE_BYTES + (2 * ks + hi) * 1024 + (32 + r32) * 16); }
            asm volatile("s_waitcnt lgkmcnt(0)" ::: "memory"); __builtin_amdgcn_sched_barrier(0);
            __builtin_amdgcn_s_setprio(1);
#pragma unroll
            for (int ks = 0; ks < 6; ++ks) {
                s[2 * tl] = __builtin_amdgcn_mfma_f32_32x32x16_f16(kf[2 * ks], qf[ks], s[2 * tl], 0, 0, 0);
                s[2 * tl + 1] = __builtin_amdgcn_mfma_f32_32x32x16_f16(kf[2 * ks + 1], qf[ks], s[2 * tl + 1], 0, 0, 0);
            }
            __builtin_amdgcn_s_setprio(0);
        }
        float mx = fmaxf(fmaxf(s[0][0], s[1][0]), fmaxf(s[2][0], s[3][0]));
#pragma unroll
        for (int r = 1; r < 16; ++r) mx = fmaxf(mx, fmaxf(fmaxf(s[0][r], s[1][r]), fmaxf(s[2][r], s[3][r])));
        mx = fmaxf(mx, __shfl_xor(mx, 32));
        if (t == 0 || __any(mx > THR)) {
            const float d = (t == 0) ? mx : fmaxf(mx, 0.f), f = __builtin_amdgcn_exp2f(-d);
            m_run += d;
#pragma unroll
            for (int q = 0; q < 4; ++q)
#pragma unroll
                for (int r = 0; r < 16; ++r) s[q][r] -= d;
            if (t != 0) { l_run *= f;
                if (hi == 0) wsf[r32] = f;
                asm volatile("s_waitcnt lgkmcnt(0)" ::: "memory");
#pragma unroll
                for (int r = 0; r < 16; ++r) { const float ff = wsf[crow(r, hi)]; o0[r] *= ff; o1[r] *= ff; } }
        }
#pragma unroll
        for (int tl = 0; tl < 2; ++tl) {
            float ps = 0.f;
#pragma unroll
            for (int r = 0; r < 16; ++r) { s[2 * tl][r] = __builtin_amdgcn_exp2f(s[2 * tl][r]); s[2 * tl + 1][r] = __builtin_amdgcn_exp2f(s[2 * tl + 1][r]); ps += s[2 * tl][r] + s[2 * tl + 1][r]; }
            l_run += ps;
            f16x8 vf[8], pa[4];
#pragma unroll
            for (int g = 0; g < 4; ++g) { vf[2 * g] = *(const LAS f16x8*)(Vb + tl * TILE_BYTES + (2 * g + hi) * 1024 + r32 * 16); vf[2 * g + 1] = *(const LAS f16x8*)(Vb + tl * TILE_BYTES + (2 * g + hi) * 1024 + (32 + r32) * 16); }
#pragma unroll
            for (int g = 0; g < 4; ++g)
#pragma unroll
                for (int j = 0; j < 4; ++j) { const int base = 8 * (g & 1) + 2 * j; const fp16x2 pk = __builtin_amdgcn_cvt_pkrtz(s[2 * tl + (g >> 1)][base], s[2 * tl + (g >> 1)][base + 1]); pa[g][2 * j] = (h16)pk[0]; pa[g][2 * j + 1] = (h16)pk[1]; }
            asm volatile("s_waitcnt lgkmcnt(0)" ::: "memory"); __builtin_amdgcn_sched_barrier(0);
            __builtin_amdgcn_s_setprio(1);
#pragma unroll
            for (int g = 0; g < 4; ++g) {
                o0 = __builtin_amdgcn_mfma_f32_32x32x16_f16(pa[g], vf[2 * g], o0, 0, 0, 0);
                o1 = __builtin_amdgcn_mfma_f32_32x32x16_f16(pa[g], vf[2 * g + 1], o1, 0, 0, 0);
            }
            __builtin_amdgcn_s_setprio(0);
        }
        asm volatile("s_waitcnt vmcnt(0) lgkmcnt(0)" ::: "memory"); __builtin_amdgcn_s_barrier(); asm volatile("" ::: "memory");
    }
    l_run += __shfl_xor(l_run, 32);
    if (hi == 0) wsf[r32] = 1.f / l_run;
    asm volatile("s_waitcnt lgkmcnt(0)" ::: "memory");
    const int b = bh >> 3, h = bh & 7;
    h16* op = MIX + ((size_t)b * SEQ + qb * 256 + wid * 32) * DM + 512 + h * 64 + r32;
#pragma unroll
    for (int r = 0; r < 16; ++r) { const int q = crow(r, hi); const float il = wsf[q]; op[(size_t)q * DM] = (h16)(o0[r] * il); op[(size_t)q * DM + 32] = (h16)(o1[r] * il); }
    asm volatile("s_waitcnt lgkmcnt(0)" ::: "memory"); __builtin_amdgcn_s_barrier(); asm volatile("" ::: "memory");
#undef AT_ISSUE
#undef AT_ISSUE1
}
#undef AT_DMA
}

namespace gl {
typedef _Float16 f16x8 __attribute__((ext_vector_type(8)));
typedef _Float16 f16x4 __attribute__((ext_vector_type(4)));
typedef short v4i16_t __attribute__((ext_vector_type(4)));
constexpr int RAW_Q = 0, RAW_K = 8192, RAW_V = 16384, RAW_LR = 32768, RAW_BYTES = 34816;
constexpr int OFF_QREL = 2 * RAW_BYTES, RS = 144  , IMG = 64 * RS;
constexpr int OFF_KREL = OFF_QREL + IMG, OFF_QDEC = OFF_KREL + IMG, OFF_KDECT = OFF_QDEC + IMG, OFF_SC = OFF_KDECT + IMG, OFF_TOT = OFF_SC + IMG, OFF_EBL = OFF_TOT + 2048, GLA_LDS = OFF_EBL + 256;
static_assert(GLA_LDS <= RING_BYTES, "GLA LDS map");
__device__ __forceinline__ int vswz(int token) { return 2 * ((token & 3) | (((token >> 3) & 1) << 2)); }
#define GL_DMA(gsrc, ldsoff) __builtin_amdgcn_global_load_lds((const unsigned*)(gsrc), (LAS unsigned*)(lds + (ldsoff)), 16, 0, 0)
#define GL_BAR() do { asm volatile("s_waitcnt lgkmcnt(0)" ::: "memory"); __builtin_amdgcn_s_barrier(); asm volatile("" ::: "memory"); } while (0)
__device__ __forceinline__ void gla_unit(LAS unsigned char* lds, const h16* __restrict__ PROJ, const float* __restrict__ GW, const float* __restrict__ GB, h16* __restrict__ OG, int b, int h, int dir) {
    int tid = threadIdx.x; asm volatile("" : "+v"(tid));
    const int lane = tid & 63, w = __builtin_amdgcn_readfirstlane(tid >> 6), l15 = lane & 15, kg = lane >> 4;
    typedef _Float16 h2v __attribute__((ext_vector_type(2)));
    h2v gwp[8];
#pragma unroll
    for (int r = 0; r < 8; ++r) gwp[r] = (h2v){(h16)GW[(2 * r) * 256 + h * 64 + lane], (h16)GW[(2 * r + 1) * 256 + h * 64 + lane]};
    const float gb = GB[h * 64 + lane];
    const h16* pb = PROJ + (size_t)b * SEQ * NPROJ;
    f32x4 Sacc[4];
#pragma unroll
    for (int k = 0; k < 4; ++k) Sacc[k] = (f32x4){0.f, 0.f, 0.f, 0.f};
#define GL_TOK(c, i) (dir ? (SEQ - 1 - ((c) * 64 + (i))) : ((c) * 64 + (i)))
#define GL_ISSUE(c, buf) do { const int _rb = (buf) * RAW_BYTES; \
        { const int row = 8 * w + (lane >> 3); const h16* src = pb + (size_t)GL_TOK(c, row) * NPROJ + h * 64 + (lane & 7) * 8; GL_DMA(src + PC_Q, _rb + RAW_Q + w * 1024); GL_DMA(src + PC_K, _rb + RAW_K + w * 1024); } \
        _Pragma("unroll") for (int _j = 0; _j < 2; ++_j) { const int row = 8 * w + 4 * _j + (lane >> 4); const int cc = (lane & 15) ^ vswz(row); \
            GL_DMA(pb + (size_t)GL_TOK(c, row) * NPROJ + PC_V + h * 128 + cc * 8, _rb + RAW_V + (2 * w + _j) * 1024); } \
        if (lane < 16) { const int row = 8 * w + (lane >> 1); GL_DMA(pb + (size_t)GL_TOK(c, row) * NPROJ + (dir ? PC_LRB : PC_LRF) + (lane & 1) * 8, _rb + RAW_LR + w * 256); } } while (0)
    f32x4 opend[4];
    float bl[8];
#define GL_GATES(rb_) do { float run = 0.f; const LAS unsigned char* lrp_ = lds + (rb_) * RAW_BYTES + RAW_LR; \
        _Pragma("unroll") for (int k = 0; k < 8; ++k) { const int i = 8 * w + k; const f16x8 l0 = *(const LAS f16x8*)(lrp_ + i * 32), l1 = *(const LAS f16x8*)(lrp_ + i * 32 + 16); \
            float z = gb, z1 = 0.f; \
            _Pragma("unroll") for (int r = 0; r < 4; ++r) { z = __builtin_amdgcn_fdot2((h2v){l0[2 * r], l0[2 * r + 1]}, gwp[r], z, false); z1 = __builtin_amdgcn_fdot2((h2v){l1[2 * r], l1[2 * r + 1]}, gwp[4 + r], z1, false); } \
            z += z1; \
            const float z2 = z * 1.4426950408889634f; \
            const float ls2 = fminf(z2, 0.f) - __builtin_amdgcn_logf(1.f + __builtin_amdgcn_exp2f(-fabsf(z2))); \
            run += ls2 * (1.f / 16.f); bl[k] = run; } \
        ((LAS float*)(lds + OFF_TOT))[w * 64 + lane] = run; } while (0)
    GL_ISSUE(0, 0);
    asm volatile("s_waitcnt vmcnt(0)" ::: "memory");
    GL_GATES(0);
    GL_BAR();
    for (int c = 0; c < SEQ / 64; ++c) {
        const int cur = c & 1; LAS unsigned char* raw = lds + cur * RAW_BYTES;
        if (c + 1 < SEQ / 64) GL_ISSUE(c + 1, cur ^ 1);
        float pre = 0.f, bref = 0.f, blast = 0.f;
#pragma unroll
        for (int ww = 0; ww < 8; ++ww) { const float tv = ((const LAS float*)(lds + OFF_TOT))[ww * 64 + lane]; if (ww < w) pre += tv; if (ww < 4) bref += tv; blast += tv; }
        { const int d = lane; const int dperm = (d & 32) + 8 * ((d >> 2) & 3) + 4 * ((d >> 4) & 1) + (d & 3);
          f16x8 kd; const float eref = __builtin_amdgcn_exp2f(bref), elr = __builtin_amdgcn_exp2f(blast - bref);
#pragma unroll
          for (int k = 0; k < 8; ++k) { const int i = 8 * w + k; const float bb = pre + bl[k];
              const float qv = (float)*(const LAS h16*)(raw + RAW_Q + i * 128 + d * 2), kv = (float)*(const LAS h16*)(raw + RAW_K + i * 128 + d * 2);
              const float dd = fminf(fmaxf(bb - bref, -14.f), 14.f); const float e1 = __builtin_amdgcn_exp2f(dd), e1i = __builtin_amdgcn_rcpf(e1);
              const float qr = qv * e1, kr = kv * e1i;
              *(LAS h16*)(lds + OFF_QREL + i * RS + d * 2) = (h16)qr;
              *(LAS h16*)(lds + OFF_KREL + i * RS + d * 2) = (h16)kr;
              *(LAS h16*)(lds + OFF_QDEC + i * RS + dperm * 2) = (h16)(qr * eref);
              kd[k] = (h16)(kr * elr); }
          *(LAS f16x8*)(lds + OFF_KDECT + d * RS + (8 * w) * 2) = kd;
          if (w == 0) ((LAS float*)(lds + OFF_EBL))[d] = __builtin_amdgcn_exp2f(blast); }
        GL_BAR();
#pragma unroll
        for (int q = 0; q < 2; ++q) { const int blk = 2 * w + q, ib = blk >> 2, jb = blk & 3;
            f32x4 sc = {0.f, 0.f, 0.f, 0.f};
            if (jb <= ib) {
#pragma unroll
                for (int ks = 0; ks < 2; ++ks) { const f16x8 a = *(const LAS f16x8*)(lds + OFF_KREL + (16 * jb + l15) * RS + (32 * ks + 8 * kg) * 2), bq = *(const LAS f16x8*)(lds + OFF_QREL + (16 * ib + l15) * RS + (32 * ks + 8 * kg) * 2);
                    sc = __builtin_amdgcn_mfma_f32_16x16x32_f16(a, bq, sc, 0, 0, 0); }
                if (jb == ib) {
#pragma unroll
                    for (int r = 0; r < 4; ++r) { const int j = 4 * kg + r, i = l15; const bool keep = dir ? (j < i) : (j <= i); if (!keep) sc[r] = 0.f; }
                }
            }
            f16x4 o; o[0] = (h16)sc[0]; o[1] = (h16)sc[1]; o[2] = (h16)sc[2]; o[3] = (h16)sc[3];
            *(LAS f16x4*)(lds + OFF_SC + (16 * ib + l15) * RS + (16 * jb + 4 * kg) * 2) = o; }
        f16x8 Vf[2], Sf[2];
#pragma unroll
        for (int ks = 0; ks < 2; ++ks) {
            v4i16_t t0, t1;
            { const int q = l15 >> 2, p = l15 & 3;
              const int tk0 = 32 * ks + 8 * kg + q, tk1 = tk0 + 4;
              const int c0 = (2 * w + (p >> 1)) ^ vswz(tk0), c1 = (2 * w + (p >> 1)) ^ vswz(tk1);
              t0 = __builtin_amdgcn_ds_read_tr16_b64_v4i16((LAS v4i16_t*)(raw + RAW_V + tk0 * 256 + c0 * 16 + (p & 1) * 8));
              t1 = __builtin_amdgcn_ds_read_tr16_b64_v4i16((LAS v4i16_t*)(raw + RAW_V + tk1 * 256 + c1 * 16 + (p & 1) * 8)); }
            const f16x4 a = __builtin_bit_cast(f16x4, t0), bq = __builtin_bit_cast(f16x4, t1);
            Vf[ks] = (f16x8){a[0], a[1], a[2], a[3], bq[0], bq[1], bq[2], bq[3]};
            Sf[ks] = (f16x8){(h16)Sacc[2 * ks][0], (h16)Sacc[2 * ks][1], (h16)Sacc[2 * ks][2], (h16)Sacc[2 * ks][3], (h16)Sacc[2 * ks + 1][0], (h16)Sacc[2 * ks + 1][1], (h16)Sacc[2 * ks + 1][2], (h16)Sacc[2 * ks + 1][3]};
        }
        GL_BAR();
        { f16x8 fsc[4][2], fqd[4][2], fkd[4][2]; f32x4 feb[4];
#pragma unroll
          for (int ib = 0; ib < 4; ++ib)
#pragma unroll
              for (int ks = 0; ks < 2; ++ks) { if (32 * ks <= 16 * ib + 15) fsc[ib][ks] = *(const LAS f16x8*)(lds + OFF_SC + (16 * ib + l15) * RS + (32 * ks + 8 * kg) * 2);
                  fqd[ib][ks] = *(const LAS f16x8*)(lds + OFF_QDEC + (16 * ib + l15) * RS + (32 * ks + 8 * kg) * 2); }
#pragma unroll
          for (int blk = 0; blk < 4; ++blk) { feb[blk] = *(const LAS f32x4*)(lds + OFF_EBL + (16 * blk + 4 * kg) * 4);
#pragma unroll
              for (int ks = 0; ks < 2; ++ks) fkd[blk][ks] = *(const LAS f16x8*)(lds + OFF_KDECT + (16 * blk + l15) * RS + (32 * ks + 8 * kg) * 2); }
          asm volatile("s_waitcnt lgkmcnt(0)" ::: "memory"); __builtin_amdgcn_sched_barrier(0);
          f32x4 oa[4];
#pragma unroll
          for (int ib = 0; ib < 4; ++ib) oa[ib] = (f32x4){0.f, 0.f, 0.f, 0.f};
#pragma unroll
          for (int ks = 0; ks < 2; ++ks)
#pragma unroll
              for (int ib = 0; ib < 4; ++ib) { if (32 * ks <= 16 * ib + 15) oa[ib] = __builtin_amdgcn_mfma_f32_16x16x32_f16(fsc[ib][ks], Vf[ks], oa[ib], 0, 0, 0); }
#pragma unroll
          for (int ks = 0; ks < 2; ++ks)
#pragma unroll
              for (int ib = 0; ib < 4; ++ib) oa[ib] = __builtin_amdgcn_mfma_f32_16x16x32_f16(fqd[ib][ks], Sf[ks], oa[ib], 0, 0, 0);
#pragma unroll
          for (int blk = 0; blk < 4; ++blk) Sacc[blk] = Sacc[blk] * feb[blk];
#pragma unroll
          for (int ks = 0; ks < 2; ++ks)
#pragma unroll
              for (int blk = 0; blk < 4; ++blk) Sacc[blk] = __builtin_amdgcn_mfma_f32_16x16x32_f16(fkd[blk][ks], Vf[ks], Sacc[blk], 0, 0, 0);
#pragma unroll
          for (int ib = 0; ib < 4; ++ib) opend[ib] = oa[ib]; }
        asm volatile("s_waitcnt vmcnt(0)" ::: "memory");
        if (c + 1 < SEQ / 64) GL_GATES(cur ^ 1);
        { LAS unsigned char* stg = lds + OFF_QREL + w * 2048;
#pragma unroll
          for (int ib = 0; ib < 4; ++ib)
#pragma unroll
              for (int r = 0; r < 4; ++r) *(LAS h16*)(stg + (16 * ib + 4 * kg + r) * 32 + l15 * 2) = (h16)opend[ib][r];
          asm volatile("s_waitcnt lgkmcnt(0)" ::: "memory");
#pragma unroll
          for (int q = 0; q < 2; ++q) { const int p = q * 64 + lane, i = p >> 1; const u32x4 v = *(const LAS u32x4*)(stg + p * 16);
              *(u32x4*)(OG + ((size_t)dir * T + (size_t)b * SEQ + GL_TOK(c, i)) * 512 + h * 128 + 16 * w + (p & 1) * 8) = v; } }
        GL_BAR();
    }
#undef GL_ISSUE
#undef GL_TOK
#undef GL_GATES
}
#undef GL_DMA
#undef GL_BAR
}

namespace rt {
typedef _Float16 f16x8 __attribute__((ext_vector_type(8)));
__device__ __forceinline__ void route_block(LAS unsigned char* lds, const h16* __restrict__ X1H, const h16* __restrict__ W16, const float* __restrict__ SSQ, const float* __restrict__ bg, const float* __restrict__ be,
                                            float* RS2, int* TOKE, int* TOKP, float* TOKW, int* ETOK, float* ESC, int* cnt, int row0) {
    int tid = threadIdx.x; asm volatile("" : "+v"(tid));
    const int lane = tid & 63, w = __builtin_amdgcn_readfirstlane(tid >> 6), l15 = lane & 15, kg = lane >> 4;
    f32x4 acc[4][3];
#pragma unroll
    for (int i = 0; i < 4; ++i)
#pragma unroll
        for (int j = 0; j < 3; ++j) acc[i][j] = (f32x4){0.f, 0.f, 0.f, 0.f};
    f16x8 af[4][4], bf[3][4];
#pragma unroll
    for (int ks = 0; ks < 4; ++ks) { const int k0 = 128 * w + 32 * ks + 8 * kg;
#pragma unroll
        for (int i = 0; i < 4; ++i) af[i][ks] = *(const f16x8*)(X1H + (size_t)(row0 + 16 * i + l15) * DM + k0);
#pragma unroll
        for (int j = 0; j < 3; ++j) bf[j][ks] = *(const f16x8*)(W16 + (size_t)(16 * j + l15) * DM + k0); }
#pragma unroll
    for (int ks = 0; ks < 4; ++ks)
#pragma unroll
        for (int i = 0; i < 4; ++i)
#pragma unroll
            for (int j = 0; j < 3; ++j) acc[i][j] = __builtin_amdgcn_mfma_f32_16x16x32_f16(bf[j][ks], af[i][ks], acc[i][j], 0, 0, 0);
    LAS float* PS = (LAS float*)lds;
#pragma unroll
    for (int i = 0; i < 4; ++i)
#pragma unroll
        for (int j = 0; j < 3; ++j) *(LAS f32x4*)(PS + (w * 64 + 16 * i + l15) * 48 + 16 * j + 4 * kg) = acc[i][j];
    LDS_WAIT(); __builtin_amdgcn_s_barrier(); asm volatile("" ::: "memory");
    LAS float* L = (LAS float*)(lds + 8 * 64 * 48 * 4);
    for (int t = tid; t < 64 * 12; t += NTHREADS) { const int r = t / 12, c4 = (t % 12) * 4; f32x4 sum = {0.f, 0.f, 0.f, 0.f};
#pragma unroll
        for (int ww = 0; ww < 8; ++ww) sum += *(const LAS f32x4*)(PS + (ww * 64 + r) * 48 + c4);
        *(LAS f32x4*)(L + r * 48 + c4) = sum; }
    LDS_WAIT(); __builtin_amdgcn_s_barrier(); asm volatile("" ::: "memory");
    if (tid < 64) { const int r = tid, m = row0 + r; LAS float* l = L + r * 48;
        float ss = 0.f; { const f32x4* sp = (const f32x4*)(SSQ + (size_t)m * 16);
#pragma unroll
            for (int i = 0; i < 4; ++i) { const f32x4 t4 = sp[i]; ss += (t4[0] + t4[1]) + (t4[2] + t4[3]); } }
        const float rs = rsqrtf(ss * (1.f / DM) + EPS);
        float mx = l[0] * rs + bg[0]; int gi = 0;
        for (int g = 1; g < 4; ++g) { const float v = l[g] * rs + bg[g]; if (v > mx) { mx = v; gi = g; } }
        float den = 0.f;
        for (int g = 0; g < 4; ++g) den += expf(l[g] * rs + bg[g] - mx);
        const float ptop = 1.f / den;
        LAS float* l8 = l + 4 + gi * 8;
        for (int j = 0; j < 8; ++j) l8[j] = l8[j] * rs + be[gi * 8 + j];
        float b0 = l8[0]; int i0 = 0;
        for (int j = 1; j < 8; ++j) if (l8[j] > b0) { b0 = l8[j]; i0 = j; }
        float b1 = -3.0e38f; int i1 = 0;
        for (int j = 0; j < 8; ++j) if (j != i0 && l8[j] > b1) { b1 = l8[j]; i1 = j; }
        const float p1 = expf(b1 - b0);
        const float w0 = ptop / (1.f + p1), w1 = ptop * p1 / (1.f + p1);
        const int e0 = gi * 8 + i0, e1 = gi * 8 + i1;
        LAS int* H = (LAS int*)(lds + 8 * 64 * 48 * 4 + 64 * 48 * 4);
        if (tid < 32) H[tid] = 0;
        __builtin_amdgcn_wave_barrier(); asm volatile("s_waitcnt lgkmcnt(0)" ::: "memory");
        const int r0 = __hip_atomic_fetch_add(H + e0, 1, __ATOMIC_RELAXED, __HIP_MEMORY_SCOPE_WORKGROUP), r1 = __hip_atomic_fetch_add(H + e1, 1, __ATOMIC_RELAXED, __HIP_MEMORY_SCOPE_WORKGROUP);
        __builtin_amdgcn_wave_barrier(); asm volatile("s_waitcnt lgkmcnt(0)" ::: "memory");
        if (tid < 32) { const int c = H[tid]; H[32 + tid] = c ? atomicAdd(&cnt[tid], c) : 0; }
        __builtin_amdgcn_wave_barrier(); asm volatile("s_waitcnt vmcnt(0) lgkmcnt(0)" ::: "memory");
        const int q0 = H[32 + e0] + r0, q1 = H[32 + e1] + r1;
        ETOK[e0 * ECAP + q0] = m; ETOK[e1 * ECAP + q1] = m;
        ESC[((size_t)e0 * ECAP + q0) * 2] = rs; ESC[((size_t)e0 * ECAP + q0) * 2 + 1] = w0;
        ESC[((size_t)e1 * ECAP + q1) * 2] = rs; ESC[((size_t)e1 * ECAP + q1) * 2 + 1] = w1;
        RS2[m] = rs; TOKE[m * 2] = e0; TOKE[m * 2 + 1] = e1; TOKP[m * 2] = q0; TOKP[m * 2 + 1] = q1; TOKW[m * 2] = w0; TOKW[m * 2 + 1] = w1;
    }
    __syncthreads();
}
}

__global__ void __launch_bounds__(NTHREADS, 2) mega_fwd(MArgs args) {
    extern __shared__ __attribute__((aligned(16))) unsigned char lds_raw[];
    LAS unsigned char* lds = (LAS unsigned char*)lds_raw;
    volatile LAS unsigned* MISC = (volatile LAS unsigned*)(lds + MISC_OFF);
    const int tid = threadIdx.x, lane = tid & 63, wave = __builtin_amdgcn_readfirstlane(tid >> 6);
    const int G = gridDim.x, bx = blockIdx.x;
    const int vcu = (G % 8 == 0) ? (bx % 8) * (G / 8) + bx / 8 : bx;
    unsigned* ctl = (unsigned*)(args.ws + WS_CTL);
    for (int u = tid; u < (LDS_BYTES - RING_BYTES) / 4; u += NTHREADS) ((LAS unsigned*)(lds + RING_BYTES))[u] = 0u;
    __syncthreads();
    XcdBarrier bar = xcd_barrier_post(ctl + CW_BAR + args.li * XCD_BAR_WORDS, MISC + 8);
    const int gw = vcu * NWAVES + wave, NGW = G * NWAVES;
    const int lo = args.ph_lo, hi = args.ph_hi;
#ifndef DUP_PHASE
#define DUP_PHASE -1
#endif
#define REPS(k) ((k) == DUP_PHASE ? 3 : 1)
#define IN(k) (lo <= (k) && (k) < hi)
#define BOTH(k) (IN(k) && IN((k) + 1))
    if (IN(0)) for (int rep = 0; rep < REPS(0); ++rep) { p0_prologue(args, lds, gw, NGW, lane, wave); if (BOTH(0) || rep + 1 < REPS(0)) xcd_barrier(bar); }
    if (IN(1)) for (int rep = 0; rep < REPS(1); ++rep) {
        g8::PlainProb p{(const h16*)(args.ws + WS_H1), (const h16*)(args.ws + WS_WINT), DM, DM, DM};
        g8::StaticOrder S; S.init(T / 256, NPROJ / 256, G, bx);
        g8::EpiH16 E{(h16*)(args.ws + WS_PROJ), NPROJ};
        g8::gemm_phase<g8::PlainProb, g8::EpiH16, g8::StaticOrder, true>(lds, p, S, E);
        if (BOTH(1) || rep + 1 < REPS(1)) xcd_barrier(bar);
    }
    if (IN(2)) for (int rep = 0; rep < REPS(2); ++rep) {
        const h16* PROJ = (const h16*)(args.ws + WS_PROJ); const float* CS = (const float*)(args.ws + WS_CS);
        g8::StaticOrder S; S.init(T / 256, 8, G, bx);
        g8::Unit u;
        for (int i = 0; S.next(i, u); ++i) {
            if (u.pn < 4) {
                g8::PlainProb p{PROJ + PC_MQA, (const h16*)(args.ws + WS_WQBT), NPROJ, 256, 256};
                g8::EpiQ E{PROJ, (const float*)args.in[13], CS, (h16*)(args.ws + WS_QF)};
                g8::OneUnit O{u};
                g8::gemm_phase<g8::PlainProb, g8::EpiQ, g8::OneUnit, false>(lds, p, O, E);
            } else {
                g8::PlainProb p{PROJ + PC_MKVA, (const h16*)(args.ws + WS_WKVBT), NPROJ, 256, 256};
                g8::EpiKV E{PROJ, (const float*)args.in[14], CS, (h16*)(args.ws + WS_KF), (h16*)(args.ws + WS_VF)};
                g8::Unit u2 = u; u2.pn = u.pn - 4;
                g8::OneUnit O{u2};
                g8::gemm_phase<g8::PlainProb, g8::EpiKV, g8::OneUnit, false>(lds, p, O, E);
            }
            __syncthreads();
        }
        if (BOTH(2) || rep + 1 < REPS(2)) xcd_barrier(bar);
    }
    if (IN(PH_MIX)) for (int rep = 0; rep < REPS(PH_MIX); ++rep) {
        const h16* PROJ = (const h16*)(args.ws + WS_PROJ);
        { const int x0 = (int)(xb_xcc_id() & 7u);
          for (int k = 0; k < 8; ++k) { const int x = (x0 + k) & 7;
              for (;;) {
                  if (tid == 0) MISC[16] = xb_add(ctl + CW_Q + 64 * (rep * 8 + x), 1u);
                  __syncthreads();
                  const int idx = (int)MISC[16];
                  __syncthreads();
                  if (idx >= 152) break;
                  if (idx < 8) { const int dir = idx & 1, hh = idx >> 1; gl::gla_unit(lds, PROJ, (const float*)args.in[dir ? 6 : 4], (const float*)args.in[dir ? 7 : 5], (h16*)(args.ws + WS_OGLA), x, hh, dir);
                      VM_WAIT(); __syncthreads();
                      if (wave == 0) { __builtin_amdgcn_fence(__ATOMIC_RELEASE, "agent"); VM_WAIT(); xb_add(ctl + CW_GLADONE + 64 * (rep * 8 + x), lane == 0 ? 1u : 0u); } }
                  else if (idx < 120 && ((idx - 8) % 7) < 4) { const int a = ((idx - 8) / 7) * 4 + ((idx - 8) % 7); at::attn_unit(lds, (const h16*)(args.ws + WS_QF), (const h16*)(args.ws + WS_KF), (const h16*)(args.ws + WS_VF), (h16*)(args.ws + WS_MIX), x * 8 + (a >> 3), a & 7); }
                  else if (idx < 120) {
                      int ln = lane; asm volatile("" : "+v"(ln));
                      const int bj = ((idx - 8) / 7) * 3 + ((idx - 8) % 7) - 4;
                      const int base = (x * 48 + bj) * 32 + wave * 4; LAS float* scr = (LAS float*)(lds + wave * 16384);
                      if (rep == 0) expert_items4(args, base, scr, ln);
                      __syncthreads(); }
                  else {
                      const int j = idx - 120;
                      if (wave == 0) { unsigned sp = 0; while ((unsigned)__builtin_amdgcn_readfirstlane(xb_ld(ctl + CW_GLADONE + 64 * (rep * 8 + x))) < 8u) { __builtin_amdgcn_s_sleep(4); if (++sp > (1u << 16)) break; }
                          __builtin_amdgcn_fence(__ATOMIC_ACQUIRE, "agent"); VM_WAIT(); }
                      __syncthreads();
                      int ln = lane; asm volatile("" : "+v"(ln));
                      const int m0 = x * SEQ + j * 64 + wave * 8;
                      gla_combine_rows((const h16*)(args.ws + WS_OGLA), PROJ, (const float*)args.in[8], (h16*)(args.ws + WS_MIX), m0, m0 + 8, 1, ln);
                      __syncthreads(); }
              } } }
        if (BOTH(PH_MIX) || rep + 1 < REPS(PH_MIX)) xcd_barrier(bar);
    }
    if (IN(PH_COMB)) for (int rep = 0; rep < REPS(PH_COMB); ++rep) {
    }
    if (IN(PH_OUT)) for (int rep = 0; rep < REPS(PH_OUT); ++rep) {
        g8::PlainProb p{(const h16*)(args.ws + WS_MIX), (const h16*)(args.ws + WS_WOUTT), DM, DM, DM};
        g8::StaticOrder S; S.init(T / 256, DM / 256, G, bx);
        g8::EpiResid E{(const float*)args.in[0], (h16*)(args.ws + WS_X1H), (float*)(args.ws + WS_SSQ)};
        g8::gemm_phase<g8::PlainProb, g8::EpiResid, g8::StaticOrder, true>(lds, p, S, E);
        if (BOTH(PH_OUT) || rep + 1 < REPS(PH_OUT)) xcd_barrier(bar);
    }
    if (IN(PH_ROUTE)) {
        for (int blk = bx; blk < T / 64; blk += G)
            rt::route_block(lds, (const h16*)(args.ws + WS_X1H), (const h16*)(args.ws + WS_WRT16), (const float*)(args.ws + WS_SSQ), (const float*)args.in[18], (const float*)args.in[20],
                            (float*)(args.ws + WS_RS2), (int*)(args.ws + WS_TOKE), (int*)(args.ws + WS_TOKP), (float*)(args.ws + WS_TOKW), (int*)(args.ws + WS_ETOK), (float*)(args.ws + WS_ESC), (int*)(ctl + CW_CNT), blk * 64);
        if (BOTH(PH_ROUTE)) xcd_barrier(bar);
    }
    volatile LAS int* GT = (volatile LAS int*)(lds + MISC_OFF + 128);
    if (IN(PH_UP) || IN(PH_DOWN) || IN(PH_FIN)) {
        if (tid == 0) { int tp = 0, rb = 0; for (int e = 0; e < NEXP; ++e) { const int n = __hip_atomic_load((int*)(ctl + CW_CNT) + e, __ATOMIC_RELAXED, __HIP_MEMORY_SCOPE_AGENT); const int t = (n + 255) >> 8;
            GT[e] = tp; GT[64 + e] = rb; GT[128 + e] = n; tp += t; rb += t * 256; } GT[32] = tp; GT[64 + 32] = rb;
            int pf = 0, np = 0; for (int e = 0; e < NEXP; ++e) { const int n = GT[128 + e]; GT[192 + e] = pf; pf += n >> 8; if (n & 255) { GT[232 + np] = e; ++np; } } GT[192 + 32] = pf; }
        __syncthreads();
    }
    if (IN(PH_UP)) for (int rep = 0; rep < REPS(PH_UP); ++rep) {
        g8::GatherProb p{(const h16*)(args.ws + WS_X1H), (const h16*)(args.ws + WS_WGUT), (const int*)(args.ws + WS_ETOK), GT, DM, DM, DM};
        g8::DynGroupSched S{GT, 2, ctl + CW_MOEQ, MISC + 20};
        g8::EpiHid E{(const float*)(args.ws + WS_ESC), GT, (h16*)(args.ws + WS_HID), ctl + CW_DONE};
        g8::gemm_phase<g8::GatherProb, g8::EpiHid, g8::DynGroupSched, true, true>(lds, p, S, E);
        if (!IN(PH_DOWN)) { if (BOTH(PH_UP) || rep + 1 < REPS(PH_UP)) xcd_barrier(bar); }
        else __syncthreads();
    }
    if (IN(PH_DOWN)) for (int rep = 0; rep < REPS(PH_DOWN); ++rep) {
        g8::SlotProb p{(const h16*)(args.ws + WS_HID), (const h16*)(args.ws + WS_WDT), GT, DEXP, DEXP, DEXP};
        g8::DynGroupSchedDep S{{GT, 4, ctl + CW_MOEQ + 64, MISC + 22}, ctl + CW_DONE, 16u};
        g8::EpiY E{GT, (h16*)(args.ws + WS_Y)};
        g8::gemm_phase<g8::SlotProb, g8::EpiY, g8::DynGroupSchedDep, true, true>(lds, p, S, E);
        if (BOTH(PH_DOWN) || rep + 1 < REPS(PH_DOWN)) xcd_barrier(bar);
    }
    if (IN(PH_FIN)) {
        const h16* X1H = (const h16*)(args.ws + WS_X1H); const h16* Y = (const h16*)(args.ws + WS_Y);
        const int* TOKE = (const int*)(args.ws + WS_TOKE); const int* TOKP = (const int*)(args.ws + WS_TOKP);
        typedef _Float16 h8 __attribute__((ext_vector_type(8)));
        for (int q0 = 0; gw + NGW * q0 < T; q0 += 8) {
        int myslot = 0;
        { const int q = lane >> 1, r = lane & 1, m = gw + NGW * (q0 + q); if (lane < 16 && m < T) myslot = GT[64 + TOKE[m * 2 + r]] + TOKP[m * 2 + r]; }
        for (int q = 0; q < 8; q += 2) {
            const int mA = gw + NGW * (q0 + q), mB = mA + NGW; if (mA >= T) break;
            const bool hasB = mB < T;
            const int sA0 = __shfl(myslot, 2 * q), sA1 = __shfl(myslot, 2 * q + 1), sB0 = __shfl(myslot, 2 * q + 2), sB1 = __shfl(myslot, 2 * q + 3);
            h8 a[2][2], y0[2][2], y1[2][2];
#pragma unroll
            for (int j = 0; j < 2; ++j) { const int c = j * 512 + lane * 8;
                a[0][j] = *(const h8*)(X1H + (size_t)mA * DM + c); y0[0][j] = *(const h8*)(Y + (size_t)sA0 * DM + c); y1[0][j] = *(const h8*)(Y + (size_t)sA1 * DM + c);
                a[1][j] = *(const h8*)(X1H + (size_t)(hasB ? mB : mA) * DM + c); y0[1][j] = *(const h8*)(Y + (size_t)(hasB ? sB0 : sA0) * DM + c); y1[1][j] = *(const h8*)(Y + (size_t)(hasB ? sB1 : sA1) * DM + c); }
#pragma unroll
            for (int t2 = 0; t2 < 2; ++t2) { if (t2 == 1 && !hasB) break; const int m = t2 ? mB : mA;
#pragma unroll
                for (int j = 0; j < 2; ++j) { const int c = j * 512 + lane * 8; f32x4 o0, o1;
#pragma unroll
                    for (int k = 0; k < 4; ++k) { o0[k] = (float)a[t2][j][k] + ((float)y0[t2][j][k] + (float)y1[t2][j][k]); o1[k] = (float)a[t2][j][4 + k] + ((float)y0[t2][j][4 + k] + (float)y1[t2][j][4 + k]); }
                    *(f32x4*)(args.out + (size_t)m * DM + c) = o0; *(f32x4*)(args.out + (size_t)m * DM + c + 4) = o1; } }
        }
        }
    }
#undef IN
#undef BOTH
#undef REPS
}

extern "C" void kernel_launch(void* const* d_in, const int* in_sizes, int n_in, void* d_out, int out_size, void* d_ws, size_t ws_size, hipStream_t stream) {
    if (n_in != 24 || out_size != T * DM || ws_size < WS_END) { fprintf(stderr, "kernel_launch: unexpected shapes (n_in %d out %d ws %zu)\n", n_in, out_size, ws_size); return; }
    static int grid = 0;
    if (grid == 0) {
        int dev = 0, cus = 0;
        if (hipGetDevice(&dev) != hipSuccess || hipDeviceGetAttribute(&cus, hipDeviceAttributeMultiprocessorCount, dev) != hipSuccess) { fprintf(stderr, "kernel_launch: device query failed\n"); grid = -1; return; }
        if (hipFuncSetAttribute((const void*)mega_fwd, hipFuncAttributeMaxDynamicSharedMemorySize, LDS_BYTES) != hipSuccess) { fprintf(stderr, "kernel_launch: hipFuncSetAttribute failed\n"); grid = -1; return; }
        int per_cu = 0; (void)hipOccupancyMaxActiveBlocksPerMultiprocessor(&per_cu, (const void*)mega_fwd, NTHREADS, LDS_BYTES); (void)hipGetLastError();
        if (per_cu < 1) fprintf(stderr, "kernel_launch: note: occupancy query reports %d\n", per_cu);
        grid = cus;
    }
    if (grid < 0) return;
    char* ws = (char*)d_ws; float* out = (float*)d_out;
    (void)hipMemsetAsync(ws + WS_CTL, 0, CTL_ZERO_BYTES, stream);
    MArgs a{};
    for (int i = 0; i < 24; ++i) a.in[i] = d_in[i];
    a.out = out; a.ws = (unsigned char*)d_ws; a.ph_lo = 0; a.ph_hi = PH_END; a.li = 0;
    hipLaunchKernelGGL(mega_fwd, dim3(grid), dim3(NTHREADS), LDS_BYTES, stream, a);
}
```

```cpp
#include <hip/hip_runtime.h>
#include <cstdio>
#include <cstdint>

typedef _Float16 h16;

constexpr int BATCH = 8, SEQ = 2048, T = BATCH * SEQ, DM = 1024;
constexpr int NPROJ = 2048;
constexpr int PC_Q = 0, PC_K = 256, PC_V = 512, PC_GATE = 1024, PC_MQA = 1536, PC_MKVA = 1792, PC_KROPE = 1920, PC_LRF = 1952, PC_LRB = 1968;
constexpr int NEXP = 32, DEXP = 256;
constexpr int ECAP = 16384;
constexpr int SLOT_ROWS = 32768 + 32 * 256;
constexpr float EPS = 1e-6f;

constexpr size_t MiB = 1u << 20;
constexpr size_t WS_CTL = 0;
constexpr size_t WS_WINT = 1 * MiB;
constexpr size_t WS_WQBT = 5 * MiB;
constexpr size_t WS_WKVBT = 5 * MiB + 512 * 1024;
constexpr size_t WS_WOUTT = 6 * MiB;
constexpr size_t WS_WGUT = 8 * MiB;
constexpr size_t WS_WDT = 40 * MiB;
constexpr size_t WS_ROUTE = 56 * MiB;
constexpr size_t WS_RS2 = WS_ROUTE + 256 * 1024;
constexpr size_t WS_TOKE = WS_RS2 + 64 * 1024;
constexpr size_t WS_TOKP = WS_TOKE + 128 * 1024;
constexpr size_t WS_TOKW = WS_TOKP + 128 * 1024;
constexpr size_t WS_ETOK = WS_ROUTE + 1 * MiB;
constexpr size_t WS_A = 60 * MiB;
constexpr size_t WS_H1 = WS_A, WS_PROJ = WS_A + 32 * MiB, WS_MIX = WS_A, WS_Y = WS_A;
constexpr size_t WS_B = 156 * MiB;
constexpr size_t WS_QF = WS_B, WS_KF = WS_B + 24 * MiB, WS_VF = WS_B + 48 * MiB, WS_HID = WS_B;
constexpr size_t WS_OGLA = 220 * MiB;
constexpr size_t WS_X1H = WS_OGLA;
constexpr size_t WS_WRT16 = WS_ROUTE + 3 * MiB;
constexpr size_t WS_SSQ = 254 * MiB;
constexpr size_t WS_ESC = 200 * MiB;
constexpr size_t WS_CS = 252 * MiB;
constexpr size_t WS_END = 256 * MiB;

__device__ __forceinline__ int win_src_col(int n) {
    if (n < 1536) return n;
    if (n < 1792) return 1568 + (n - 1536);
    if (n < 1920) return 1824 + (n - 1792);
    if (n < 1952) return 1952 + (n - 1920);
    if (n < 1968) return 1536 + (n - 1952);
    if (n < 1984) return 1552 + (n - 1968);
    return -1;
}

#define LAS __attribute__((address_space(3)))
#define GAS __attribute__((address_space(1)))
typedef unsigned u32x4 __attribute__((ext_vector_type(4)));
typedef float f32x4 __attribute__((ext_vector_type(4)));
#define LDS_WAIT() asm volatile("s_waitcnt lgkmcnt(0)" ::: "memory")
#define VM_WAIT() asm volatile("s_waitcnt vmcnt(0)" ::: "memory")
constexpr int NWAVES = 8, NTHREADS = 512;
constexpr int RING_BYTES = 131072, MISC_OFF = RING_BYTES + 320, LDS_BYTES = 147456;
constexpr int CW_CNT = 0;
constexpr int CW_BAR = 4096;
constexpr int CW_GLADONE = 10240;
constexpr int CW_Q = 12288;
constexpr size_t CTL_ZERO_BYTES = 131072;
constexpr int CW_MOEQ = 14336;
constexpr int CW_DONE = 16384;
constexpr int PH_MIX = 3, PH_COMB = 4, PH_OUT = 5, PH_ROUTE = 6, PH_UP = 7, PH_DOWN = 8, PH_FIN = 9, PH_END = 10;

__device__ __forceinline__ unsigned pk_h2(float a, float b) { typedef _Float16 h2 __attribute__((ext_vector_type(2))); h2 v = {(h16)a, (h16)b}; return __builtin_bit_cast(unsigned, v); }

#define XB_TMO      128
#define XB_XCNT(j)  (256  + 64 * (j))
#define XB_XSUB(j)  (1280 + 64 * (j))
#define XB_XGEN(j)  (2304 + 64 * (j))
#define XB_TOP      3328
#define XB_TOPGEN   3392
#define XCD_BAR_WORDS 3456
#define XB_SPIN_CAP (1u << 18)
__device__ __forceinline__ unsigned xb_ld(unsigned* p)              { return __hip_atomic_load(p, __ATOMIC_RELAXED, __HIP_MEMORY_SCOPE_AGENT); }
__device__ __forceinline__ unsigned xb_add(unsigned* p, unsigned v) { return __hip_atomic_fetch_add(p, v, __ATOMIC_RELAXED, __HIP_MEMORY_SCOPE_AGENT); }
__device__ __forceinline__ unsigned xb_xcc_id() { return (unsigned)__builtin_amdgcn_s_getreg((3 << 11) | 20) & 0xFu; }
#define XB_SPIN(cond, bar) do { unsigned _sp = 0; while (cond) { __builtin_amdgcn_s_sleep(1); \
    if ((++_sp & 255u) == 0u) { if (xb_ld(&(bar)[XB_TMO])) break; if (_sp > XB_SPIN_CAP) { atomicAdd(&(bar)[XB_TMO], 1u); break; } } } } while (0)
struct XcdBarrier { unsigned* bar; unsigned x; volatile LAS unsigned* st; };
__device__ __forceinline__ XcdBarrier xcd_barrier_post(unsigned* bar, volatile LAS unsigned* st) {
    XcdBarrier b; b.bar = bar; b.x = xb_xcc_id(); b.st = st;
    if (threadIdx.x == 0) (void)xb_add(&bar[XB_XCNT(b.x)], 1u);
    return b;
}
__device__ __forceinline__ void xcd_barrier_complete(unsigned* bar, unsigned x, unsigned& nloc, unsigned& nx) {
    const unsigned G = gridDim.x * gridDim.y * gridDim.z;
    unsigned sum, cnt, mine, sp = 0u;
    for (;;) {
        sum = 0u; cnt = 0u; mine = 0u;
#pragma unroll
        for (unsigned j = 0; j < 16; ++j) { const unsigned c = xb_ld(&bar[XB_XCNT(j)]); sum += c; cnt += (c > 0u) ? 1u : 0u; mine = (j == x) ? c : mine; }
        if (sum == G) break;
        __builtin_amdgcn_s_sleep(1);
        if ((++sp & 255u) == 0u) { if (xb_ld(&bar[XB_TMO])) break; if (sp > XB_SPIN_CAP) { atomicAdd(&bar[XB_TMO], 1u); break; } }
    }
    nloc = mine > 0u ? mine : 1u; nx = cnt > 0u ? cnt : 1u;
}
__device__ __forceinline__ void xcd_barrier(const XcdBarrier& b) {
    asm volatile("s_waitcnt vmcnt(0)" ::: "memory");
    __syncthreads();
    if (threadIdx.x == 0) {
        unsigned* bar = b.bar;
        __builtin_amdgcn_s_waitcnt(0);
        unsigned nloc = b.st[0], nx = b.st[1];
        if (nloc == 0u) { xcd_barrier_complete(bar, b.x, nloc, nx); b.st[0] = nloc; b.st[1] = nx; }
        const unsigned old = xb_add(&bar[XB_XSUB(b.x)], 1u);
        const unsigned gen = old / nloc;
        if (old + 1u == (gen + 1u) * nloc) {
            __builtin_amdgcn_fence(__ATOMIC_RELEASE, "agent");
            asm volatile("s_waitcnt vmcnt(0)" ::: "memory");
            const unsigned og = xb_add(&bar[XB_TOP], 1u);
            const unsigned tg = og / nx;
            if (og + 1u == (tg + 1u) * nx) xb_add(&bar[XB_TOPGEN], 1u);
            else XB_SPIN(xb_ld(&bar[XB_TOPGEN]) == tg, bar);
            __builtin_amdgcn_fence(__ATOMIC_ACQUIRE, "agent");
            xb_add(&bar[XB_XGEN(b.x)], 1u);
            asm volatile("s_waitcnt vmcnt(0)" ::: "memory");
        } else {
            XB_SPIN(xb_ld(&bar[XB_XGEN(b.x)]) == gen, bar);
            __builtin_amdgcn_fence(__ATOMIC_ACQUIRE, "agent");
            asm volatile("s_waitcnt vmcnt(0)" ::: "memory");
        }
    }
    __syncthreads();
}

template <int NBATCH>
__device__ __forceinline__ void tr_item(const float* __restrict__ src, int src_ld, int k0, int c0, h16* __restrict__ dst, int dst_ld, long row0, int rstride,
                                        const float* __restrict__ kg, float scale, LAS float* scr, int lane) {
#pragma unroll
    for (int bt = 0; bt < 32 / NBATCH; ++bt) {
        float tv[NBATCH];
#pragma unroll
        for (int i = 0; i < NBATCH; ++i) { const int kk = 2 * (bt * NBATCH + i) + (lane >> 5); tv[i] = src[(size_t)(k0 + kk) * src_ld + c0 + (lane & 31)]; }
#pragma unroll
        for (int i = 0; i < NBATCH; ++i) { const int kk = 2 * (bt * NBATCH + i) + (lane >> 5); float v = tv[i] * scale; if (kg) v *= kg[k0 + kk]; scr[kk * 33 + (lane & 31)] = v; }
    }
    LDS_WAIT(); asm volatile("" ::: "memory");
    const int c = lane & 7;
#pragma unroll
    for (int j = 0; j < 4; ++j) { const int n = (lane >> 3) + 8 * j; const LAS float* s = scr + (8 * c) * 33 + n;
        u32x4 o; o.x = pk_h2(s[0 * 33], s[1 * 33]); o.y = pk_h2(s[2 * 33], s[3 * 33]); o.z = pk_h2(s[4 * 33], s[5 * 33]); o.w = pk_h2(s[6 * 33], s[7 * 33]);
        *(u32x4*)(dst + (size_t)(row0 + (long)n * rstride) * dst_ld + k0 + 8 * c) = o; }
    LDS_WAIT(); asm volatile("" ::: "memory");
}
struct TrP { const float* src; int src_ld, k0, c0; h16* dst; int dst_ld; long row0; int rstride; const float* kg; };
__device__ __forceinline__ void tr_load(const TrP& p, float (&tv)[32], int lane) {
#pragma unroll
    for (int i = 0; i < 32; ++i) { const int kk = 2 * i + (lane >> 5); tv[i] = p.src[(size_t)(p.k0 + kk) * p.src_ld + p.c0 + (lane & 31)]; }
}
__device__ __forceinline__ void tr_finish(const TrP& p, const float (&tv)[32], LAS float* scr, int lane) {
#pragma unroll
    for (int i = 0; i < 32; ++i) { const int kk = 2 * i + (lane >> 5); float v = tv[i]; if (p.kg) v *= p.kg[p.k0 + kk]; scr[kk * 33 + (lane & 31)] = v; }
    LDS_WAIT(); asm volatile("" ::: "memory");
    const int c = lane & 7;
#pragma unroll
    for (int j = 0; j < 4; ++j) { const int n = (lane >> 3) + 8 * j; const LAS float* s = scr + (8 * c) * 33 + n;
        u32x4 o; o.x = pk_h2(s[0 * 33], s[1 * 33]); o.y = pk_h2(s[2 * 33], s[3 * 33]); o.z = pk_h2(s[4 * 33], s[5 * 33]); o.w = pk_h2(s[6 * 33], s[7 * 33]);
        *(u32x4*)(p.dst + (size_t)(p.row0 + (long)n * p.rstride) * p.dst_ld + p.k0 + 8 * c) = o; }
    LDS_WAIT(); asm volatile("" ::: "memory");
}
__device__ __forceinline__ float wave_sum(float v) {
#pragma unroll
    for (int o = 1; o < 64; o <<= 1) v += __shfl_xor(v, o);
    return v;
}
struct MArgs { const void* in[24]; float* out; unsigned char* ws; int ph_lo, ph_hi, li, pad; };

__device__ __forceinline__ TrP expert_params(const MArgs& a, int r) {
    unsigned char* ws = a.ws;
    const float* wg = (const float*)a.in[21]; const float* wu = (const float*)a.in[22]; const float* wd = (const float*)a.in[23]; const float* gain2 = (const float*)a.in[16];
    h16* WguT = (h16*)(ws + WS_WGUT); h16* WdT = (h16*)(ws + WS_WDT);
    if (r < 8192) { const int e = r >> 8, sx = (r >> 7) & 1, kb = (r >> 3) & 15, nb = r & 7;
        return TrP{(sx ? wu : wg) + (size_t)e * 1024 * 256, 256, 64 * kb, 32 * nb, WguT, 1024, (long)e * 512 + 64 * nb + sx, 2, gain2}; }
    r -= 8192; const int e = r >> 7, kb = (r >> 5) & 3, nb = r & 31;
    return TrP{wd + (size_t)e * 256 * 1024, 1024, 64 * kb, 32 * nb, WdT, 256, (long)e * 1024 + 32 * nb, 1, nullptr};
}
__device__ __forceinline__ void expert_items4(const MArgs& a, int r0, LAS float* scr, int lane) {
    float ta[32], tb[32];
    const TrP p0 = expert_params(a, r0), p1 = expert_params(a, r0 + 1), p2 = expert_params(a, r0 + 2), p3 = expert_params(a, r0 + 3);
    tr_load(p0, ta, lane); tr_load(p1, tb, lane);
    tr_finish(p0, ta, scr, lane); tr_load(p2, ta, lane);
    tr_finish(p1, tb, scr, lane); tr_load(p3, tb, lane);
    tr_finish(p2, ta, scr, lane); tr_finish(p3, tb, scr, lane);
}

__device__ __forceinline__ void p0_prologue(const MArgs& a, LAS unsigned char* lds, int gw, int NGW, int lane, int wave) {
    unsigned char* ws = a.ws;
    LAS float* scr = (LAS float*)(lds + wave * 16384);
    const float* w_in = (const float*)a.in[3]; const float* w_qb = (const float*)a.in[10]; const float* w_kvb = (const float*)a.in[12]; const float* w_out = (const float*)a.in[15];
    const float* wg = (const float*)a.in[21]; const float* wu = (const float*)a.in[22]; const float* wd = (const float*)a.in[23];
    const float* q_gain = (const float*)a.in[9]; const float* kv_gain = (const float*)a.in[11]; const float* gain2 = (const float*)a.in[16];
    h16* WinT = (h16*)(ws + WS_WINT); h16* WqbT = (h16*)(ws + WS_WQBT); h16* WkvbT = (h16*)(ws + WS_WKVBT); h16* WoutT = (h16*)(ws + WS_WOUTT);
    h16* WguT = (h16*)(ws + WS_WGUT); h16* WdT = (h16*)(ws + WS_WDT);
    constexpr int I_IN = 16 * 62, I_OUT = 16 * 32, I_QB = 4 * 24, I_KVB = 2 * 32;
    constexpr int NITEMS = I_IN + I_OUT + I_QB + I_KVB;
    for (int it = gw; it < NITEMS; it += NGW) {
        int r = it;
        if (r < I_IN) { const int kb = r / 62, nb = r % 62, n0 = 32 * nb;
            tr_item<32>(w_in, 1984, 64 * kb, win_src_col(n0), WinT, 1024, n0, 1, nullptr, n0 < 256 ? 0.125f : 1.f, scr, lane); continue; }
        r -= I_IN;
        if (r < I_OUT) { const int kb = r >> 5, nb = r & 31;
            tr_item<32>(w_out, 1024, 64 * kb, 32 * nb, WoutT, 1024, 32 * nb, 1, nullptr, 1.f, scr, lane); continue; }
        r -= I_OUT;
        if (r < I_QB) { const int kb = r / 24, nb = r % 24, c0 = 32 * nb, h = c0 / 96, d0 = c0 % 96;
            tr_item<32>(w_qb, 768, 64 * kb, c0, WqbT, 256, h * 128 + d0, 1, q_gain, 1.f, scr, lane); continue; }
        r -= I_QB;
        { const int kb = r >> 5, nb = r & 31;
            tr_item<32>(w_kvb, 1024, 64 * kb, 32 * nb, WkvbT, 256, 32 * nb, 1, kv_gain, 1.f, scr, lane); }
    }
    const u32x4 z4 = {0u, 0u, 0u, 0u};
    for (int i = gw; i < 128; i += NGW) *(u32x4*)((char*)(WinT + (size_t)1984 * 1024) + (size_t)i * 1024 + lane * 16) = z4;
    for (int i = gw; i < 128; i += NGW) { const int row = (i >> 4) * 128 + 96 + 2 * (i & 15) + (lane >> 5);
        *(u32x4*)((char*)(WqbT + (size_t)row * 256) + (lane & 31) * 16) = z4; }
    for (int i = gw; i < 256; i += NGW) { const int row = i * 4 + (lane >> 4);
        *(u32x4*)((char*)(WkvbT + (size_t)row * 256 + 128) + (lane & 15) * 16) = z4; }
    { const float* wrg = (const float*)a.in[17]; const float* wre = (const float*)a.in[19]; h16* W16 = (h16*)(ws + WS_WRT16);
      for (int i = gw; i < 256 * 1024 / 64; i += NGW) { const int idx = i * 64 + lane, k = idx & 1023, j = idx >> 10; float v = 0.f;
          if (j < 4) v = wrg[k * 4 + j] * gain2[k]; else if (j < 36) v = wre[k * 32 + (j - 4)] * gain2[k];
          W16[idx] = (h16)v; } }
    { const int* positions = (const int*)a.in[1]; float* CS = (float*)(ws + WS_CS);
      for (int i = gw; i < T * 16 / 64; i += NGW) { const int idx = i * 64 + lane, m = idx >> 4, fi = idx & 15;
          const float inv = exp2f(-(float)fi * (13.287712379549449f / 16.0f)); const float ang = (float)positions[m] * inv;
          CS[m * 32 + fi] = cosf(ang); CS[m * 32 + 16 + fi] = sinf(ang); } }
    { const float* x = (const float*)a.in[0]; const float* g1 = (const float*)a.in[2]; h16* H1 = (h16*)(ws + WS_H1);
      f32x4 g[4];
#pragma unroll
      for (int j = 0; j < 4; ++j) g[j] = ((const f32x4*)g1)[lane + 64 * j];
      for (int m = gw; m < T; m += 2 * NGW) {
          const int m2 = m + NGW;
          const f32x4* xr = (const f32x4*)(x + (size_t)m * DM) + lane; const f32x4* xr2 = (const f32x4*)(x + (size_t)(m2 < T ? m2 : m) * DM) + lane;
          f32x4 v[4], v2[4]; float s = 0.f, s2 = 0.f;
#pragma unroll
          for (int j = 0; j < 4; ++j) { v[j] = xr[64 * j]; v2[j] = xr2[64 * j]; }
#pragma unroll
          for (int j = 0; j < 4; ++j) { s += (v[j].x * v[j].x + v[j].y * v[j].y) + (v[j].z * v[j].z + v[j].w * v[j].w); s2 += (v2[j].x * v2[j].x + v2[j].y * v2[j].y) + (v2[j].z * v2[j].z + v2[j].w * v2[j].w); }
          const float rs = rsqrtf(wave_sum(s) * (1.f / DM) + EPS), rs2 = rsqrtf(wave_sum(s2) * (1.f / DM) + EPS);
          unsigned long long* o8 = (unsigned long long*)(H1 + (size_t)m * DM) + lane;
#pragma unroll
          for (int j = 0; j < 4; ++j) o8[64 * j] = (unsigned long long)pk_h2(v[j].x * rs * g[j].x, v[j].y * rs * g[j].y) | ((unsigned long long)pk_h2(v[j].z * rs * g[j].z, v[j].w * rs * g[j].w) << 32);
          if (m2 < T) { unsigned long long* p8 = (unsigned long long*)(H1 + (size_t)m2 * DM) + lane;
#pragma unroll
              for (int j = 0; j < 4; ++j) p8[64 * j] = (unsigned long long)pk_h2(v2[j].x * rs2 * g[j].x, v2[j].y * rs2 * g[j].y) | ((unsigned long long)pk_h2(v2[j].z * rs2 * g[j].z, v2[j].w * rs2 * g[j].w) << 32); }
      } }
}

namespace g8 {
typedef _Float16 f16x8 __attribute__((ext_vector_type(8)));
constexpr int BM = 256, BK = 64, HALF = 128, HTB = HALF * BK * 2, STAGE_BYTES = 8 * HTB, NXCD = 8, WGM = 8;
__host__ __device__ __forceinline__ int lds_byte(int r, int c) { const int st = (r >> 4) * 2 + (c >> 5), rr = r & 15, cc = c & 31, ob = rr * 64 + cc * 2; return st * 1024 + (ob ^ (((ob >> 9) & 1) << 5)); }
__host__ __device__ __forceinline__ void stage_rc(int b, int& R, int& C) { const int st = b / 1024, sb = b % 1024, swz = sb ^ (((sb >> 9) & 1) << 5); R = (st >> 1) * 16 + swz / 64; C = (st & 1) * 32 + (swz % 64) / 2; }
__host__ __device__ __forceinline__ int perm32(int rho) { const int n = rho >> 4, i = rho & 15; return 8 * (i >> 2) + 4 * n + (i & 3); }
struct Unit { int pm, pn, e, half; };
struct StaticOrder {
    int nM, nN, nwg, G, c;
    __device__ __forceinline__ void init(int nM_, int nN_, int G_, int c_) { nM = nM_; nN = nN_; nwg = nM * nN; G = G_; c = c_; }
    __device__ __forceinline__ bool next(int i, Unit& u) const {
        const long L = (long)i * G + c; if (L >= nwg) return false;
        int wgid = (int)L; { const int q = nwg / NXCD, r = nwg % NXCD, xcd = wgid % NXCD, off = wgid / NXCD; wgid = (xcd < r ? xcd * (q + 1) : r * (q + 1) + (xcd - r) * q) + off; }
        const int nig = WGM * nN, gid = wgid / nig, fm = gid * WGM, gsz = (nM - fm) < WGM ? (nM - fm) : WGM;
        u.pm = fm + ((wgid % nig) % gsz); u.pn = (wgid % nig) / gsz; u.e = 0; u.half = 0; return true;
    }
    __device__ __forceinline__ void a_ready(const Unit&) const {}
};
struct PlainProb {
    const h16* A; const h16* Bt; int lda, ldb, K;
    __device__ __forceinline__ const char* a_base() const { return (const char*)A; }
    __device__ __forceinline__ unsigned a_row_off(const Unit& u, int h, int R) const { return (unsigned)((u.pm * BM + h * HALF + R) * lda); }
    __device__ __forceinline__ const char* b_base(const Unit& u) const { return (const char*)(Bt + (size_t)u.pn * BM * ldb); }
};

template <class P, class Epi, class Sched, bool ALIGN_EPI, bool HALFSKIP = false>
__device__ __forceinline__ void gemm_phase(LAS unsigned char* lds, const P& p, const Sched& S, const Epi& E) {
    const int tid = threadIdx.x, wid = __builtin_amdgcn_readfirstlane(tid >> 6), lane = tid & 63, wr = wid >> 2, wc = wid & 3, fr = lane & 15, fq = lane >> 4;
    const int K = p.K, nt = K / BK;
    int Rs[2], Cs[2]; unsigned voffB[2];
#pragma unroll
    for (int i = 0; i < 2; ++i) { int R, C; stage_rc(tid * 16 + i * 8192, R, C); Rs[i] = R; Cs[i] = C; const int Rb = Epi::PERM ? ((R & ~31) + perm32(R & 31)) : R; voffB[i] = (unsigned)(Rb * p.ldb + C) * 2u; }
    const size_t kstep = (size_t)(BK * 2);
    const size_t hstepB = (size_t)HALF * p.ldb * 2;
    const unsigned ldsw = (unsigned)wid * 1024u;
    const int aoff = lds_byte(wr * 64 + fr, fq * 8), boff = lds_byte(wc * 32 + fr, fq * 8);
#define G8_SA(b, h) (((b) * 2 + (h)) * HTB)
#define G8_SB(b, h) ((4 + (b) * 2 + (h)) * HTB)
#define G8_STAGE(bufoff, gbase, voff) do { _Pragma("unroll") for (int _i = 0; _i < 2; ++_i) \
        __builtin_amdgcn_global_load_lds((const unsigned*)((const char*)(gbase) + (voff)[_i]), (LAS unsigned*)(lds + (bufoff) + ldsw + _i * 8192), 16, 0, 0); } while (0)
#define G8_LDA(dst, b, h) do { _Pragma("unroll") for (int m = 0; m < 4; ++m) _Pragma("unroll") for (int k = 0; k < 2; ++k) dst[m][k] = *(const LAS f16x8*)(lds + G8_SA(b, h) + aoff + m * 2048 + k * 1024); } while (0)
#define G8_LDB(dst, b, h) do { _Pragma("unroll") for (int n = 0; n < 2; ++n) _Pragma("unroll") for (int k = 0; k < 2; ++k) dst[n][k] = *(const LAS f16x8*)(lds + G8_SB(b, h) + boff + n * 2048 + k * 1024); } while (0)
#define G8_MMA(ai, bj, At, Bt) do { __builtin_amdgcn_s_setprio(1); _Pragma("unroll") for (int m = 0; m < 4; ++m) _Pragma("unroll") for (int n = 0; n < 2; ++n) _Pragma("unroll") for (int k = 0; k < 2; ++k) \
        acc[ai][bj][m][n] = __builtin_amdgcn_mfma_f32_16x16x32_f16(Bt[n][k], At[m][k], acc[ai][bj][m][n], 0, 0, 0); __builtin_amdgcn_s_setprio(0); } while (0)
#define G8_WAIT_V(n) asm volatile("s_waitcnt vmcnt(" #n ")" ::: "memory")
#define G8_WAIT_L(n) asm volatile("s_waitcnt lgkmcnt(" #n ")" ::: "memory")
#define G8_BAR __builtin_amdgcn_s_barrier()
#define G8_SCHED __builtin_amdgcn_sched_barrier(0)
    Unit cur, nxt; int ui = 0;
    if (!S.next(0, cur)) return;
    f32x4 acc[2][2][4][2];
#pragma unroll
    for (int a = 0; a < 2; ++a)
#pragma unroll
        for (int b = 0; b < 2; ++b)
#pragma unroll
            for (int m = 0; m < 4; ++m)
#pragma unroll
                for (int n = 0; n < 2; ++n) acc[a][b][m][n] = (f32x4){0.f, 0.f, 0.f, 0.f};
    f16x8 At[4][2], B0[2][2], B1[2][2];
    const char* const A0 = p.a_base();
    unsigned vAc[2][2], vAn[2][2];
#pragma unroll
    for (int h = 0; h < 2; ++h)
#pragma unroll
        for (int i = 0; i < 2; ++i) vAc[h][i] = (p.a_row_off(cur, h, Rs[i]) + (unsigned)Cs[i]) * 2u;
    const char* cB = p.b_base(cur);
    S.a_ready(cur);
    G8_STAGE(G8_SB(0, 0), cB, voffB); G8_STAGE(G8_SB(0, 1), cB + hstepB, voffB); G8_STAGE(G8_SA(0, 0), A0, vAc[0]); G8_STAGE(G8_SA(0, 1), A0, vAc[1]);
    if (wr == 1) G8_BAR;
    G8_WAIT_V(2); G8_BAR;
    G8_STAGE(G8_SB(1, 0), cB + kstep, voffB); G8_STAGE(G8_SA(1, 0), A0 + kstep, vAc[0]); G8_STAGE(G8_SB(1, 1), cB + hstepB + kstep, voffB);
    G8_WAIT_V(6); G8_BAR;
    for (;;) {
        const bool has_next = S.next(ui + 1, nxt);
        if (has_next) {
#pragma unroll
            for (int h = 0; h < 2; ++h)
#pragma unroll
                for (int i = 0; i < 2; ++i) vAn[h][i] = (p.a_row_off(nxt, h, Rs[i]) + (unsigned)Cs[i]) * 2u;
        } else {
#pragma unroll
            for (int h = 0; h < 2; ++h)
#pragma unroll
                for (int i = 0; i < 2; ++i) vAn[h][i] = vAc[h][i];
        }
        const char* nB = has_next ? p.b_base(nxt) : cB;
        const bool skip1 = HALFSKIP && cur.half != 0;
        for (int t = 0; t < nt; t += 2) {
            const bool last = (t == nt - 2);
            if (last && has_next) S.a_ready(nxt);
            const char* a1 = A0 + (size_t)(t + 1) * kstep;
            const char* a2 = last ? A0 : A0 + (size_t)(t + 2) * kstep; const char* b2 = last ? nB : cB + (size_t)(t + 2) * kstep;
            const char* a3 = a2 + kstep; const char* b3 = b2 + kstep;
            unsigned v2[2][2];
#pragma unroll
            for (int h = 0; h < 2; ++h)
#pragma unroll
                for (int i = 0; i < 2; ++i) v2[h][i] = last ? vAn[h][i] : vAc[h][i];
            G8_LDB(B0, 0, 0); G8_LDB(B1, 0, 1); G8_SCHED; G8_LDA(At, 0, 0); G8_STAGE(G8_SA(1, 1), a1, vAc[1]);
            G8_WAIT_V(8); G8_WAIT_L(0); G8_BAR; G8_MMA(0, 0, At, B0); G8_MMA(0, 1, At, B1); G8_BAR; G8_SCHED;
            if (!skip1) G8_LDA(At, 0, 1); G8_STAGE(G8_SB(0, 0), b2, voffB); G8_STAGE(G8_SB(0, 1), b2 + hstepB, voffB); G8_STAGE(G8_SA(0, 0), a2, v2[0]);
            G8_WAIT_V(8); G8_WAIT_L(0); G8_BAR; if (!skip1) { G8_MMA(1, 0, At, B0); G8_MMA(1, 1, At, B1); } G8_BAR; G8_SCHED;
            G8_LDB(B0, 1, 0); G8_LDB(B1, 1, 1); G8_SCHED; G8_LDA(At, 1, 0); G8_STAGE(G8_SA(0, 1), a2, v2[1]);
            G8_WAIT_V(8); G8_WAIT_L(0); G8_BAR; G8_MMA(0, 0, At, B0); G8_MMA(0, 1, At, B1); G8_BAR; G8_SCHED;
            if (!skip1) G8_LDA(At, 1, 1); G8_STAGE(G8_SB(1, 0), b3, voffB); G8_STAGE(G8_SB(1, 1), b3 + hstepB, voffB); G8_STAGE(G8_SA(1, 0), a3, v2[0]);
            G8_WAIT_V(8); G8_WAIT_L(0); G8_BAR; if (!skip1) { G8_MMA(1, 0, At, B0); G8_MMA(1, 1, At, B1); } G8_BAR; G8_SCHED;
        }
        if constexpr (ALIGN_EPI) { if (wr == 0) G8_BAR; }
        if constexpr (!Epi::AFTER_DRAIN) { E(acc, cur, wr, wc, fr, fq); }
        if (!has_next) break;
#pragma unroll
        for (int a = 0; a < 2; ++a)
#pragma unroll
            for (int b = 0; b < 2; ++b)
#pragma unroll
                for (int m = 0; m < 4; ++m)
#pragma unroll
                    for (int n = 0; n < 2; ++n) acc[a][b][m][n] = (f32x4){0.f, 0.f, 0.f, 0.f};
        cur = nxt; cB = nB; ++ui;
#pragma unroll
        for (int h = 0; h < 2; ++h)
#pragma unroll
            for (int i = 0; i < 2; ++i) vAc[h][i] = vAn[h][i];
        if constexpr (ALIGN_EPI) { if (wr == 1) G8_BAR; }
    }
    G8_WAIT_V(0);
    if constexpr (!ALIGN_EPI) { if (wr == 0) G8_BAR; }
    G8_BAR;
    if constexpr (Epi::AFTER_DRAIN) { E.fused(acc, cur, wr, wc, fr, fq, lds, wid, lane); }
#undef G8_SA
#undef G8_SB
#undef G8_STAGE
#undef G8_LDA
#undef G8_LDB
#undef G8_MMA
#undef G8_WAIT_V
#undef G8_WAIT_L
#undef G8_BAR
#undef G8_SCHED
}
struct EpiH16 {
    static constexpr bool PERM = true, AFTER_DRAIN = false;
    h16* O; int ldc;
    __device__ __forceinline__ void operator()(const f32x4 (&acc)[2][2][4][2], const Unit& u, int wr, int wc, int fr, int fq) const {
        const int row0 = u.pm * BM + wr * 64 + fr, col0 = u.pn * BM + wc * 32 + 8 * fq;
#pragma unroll
        for (int ai = 0; ai < 2; ++ai)
#pragma unroll
            for (int m = 0; m < 4; ++m) { h16* rowp = O + (size_t)(row0 + ai * HALF + m * 16) * ldc + col0;
#pragma unroll
                for (int bj = 0; bj < 2; ++bj) { const f32x4 v0 = acc[ai][bj][m][0], v1 = acc[ai][bj][m][1];
                    u32x4 w; w.x = pk_h2(v0[0], v0[1]); w.y = pk_h2(v0[2], v0[3]); w.z = pk_h2(v1[0], v1[1]); w.w = pk_h2(v1[2], v1[3]);
                    *(u32x4*)(rowp + bj * HALF) = w; } }
    }
};
struct OneUnit { Unit u; __device__ __forceinline__ bool next(int i, Unit& o) const { if (i) return false; o = u; return true; } __device__ __forceinline__ void a_ready(const Unit&) const {} };
typedef unsigned u32x2 __attribute__((ext_vector_type(2)));
__device__ __forceinline__ float ssq8(const u32x4 w) {
    typedef _Float16 h2 __attribute__((ext_vector_type(2))); float s = 0.f;
#pragma unroll
    for (int i = 0; i < 4; ++i) { const unsigned ui = w[i]; const h2 v = __builtin_bit_cast(h2, ui); const float a = (float)v.x, b = (float)v.y; s += a * a + b * b; }
    return s;
}
struct EpiQ {
    static constexpr bool PERM = false, AFTER_DRAIN = true;
    const h16* PROJ; const float* qn_gain; const float* CS; h16* QF;
    __device__ __forceinline__ void fused(f32x4 (&acc)[2][2][4][2], const Unit& u, int wr, int wc, int fr, int fq, LAS unsigned char* lds, int wid, int lane) const {
        LAS float* P = (LAS float*)lds;
        LAS float* RS = (LAS float*)(lds + 8192);
        const int tid = wid * 64 + lane;
#pragma unroll
        for (int ai = 0; ai < 2; ++ai)
#pragma unroll
            for (int m = 0; m < 4; ++m)
#pragma unroll
                for (int bj = 0; bj < 2; ++bj) { float sq = 0.f;
#pragma unroll
                    for (int n = 0; n < 2; ++n) { const f32x4 x = acc[ai][bj][m][n]; sq += (x[0] * x[0] + x[1] * x[1]) + (x[2] * x[2] + x[3] * x[3]); }
                    sq += __shfl_xor(sq, 16); sq += __shfl_xor(sq, 32);
                    if (fq == 0) P[((ai * HALF + wr * 64 + m * 16 + fr) * 2 + bj) * 4 + wc] = sq; }
        { const int row = tid >> 1, half = tid & 1; const u32x4* ap = (const u32x4*)(PROJ + (size_t)(u.pm * BM + row) * NPROJ + PC_MQA + half * 128); float sq = 0.f;
#pragma unroll
          for (int i = 0; i < 16; ++i) sq += ssq8(ap[i]);
          sq += __shfl_xor(sq, 1);
          if (half == 0) RS[row] = rsqrtf(sq * (1.f / 256.f) + EPS); }
        LDS_WAIT(); __builtin_amdgcn_s_barrier(); asm volatile("" ::: "memory");
        if (wc == 3) return;
        const float QS = 0.10206207261596577f * 1.4426950408889634f;
#pragma unroll
        for (int ai = 0; ai < 2; ++ai)
#pragma unroll
            for (int m = 0; m < 4; ++m) { const int r = ai * HALF + wr * 64 + m * 16 + fr, gm = u.pm * BM + r, b = gm / SEQ, sp = gm % SEQ; const float rq = RS[r];
                f32x4 cs = {1.f, 1.f, 1.f, 1.f}, sn = {0.f, 0.f, 0.f, 0.f};
                if (wc == 2) { cs = *(const f32x4*)(CS + (size_t)gm * 32 + 4 * fq); sn = *(const f32x4*)(CS + (size_t)gm * 32 + 16 + 4 * fq); }
#pragma unroll
                for (int bj = 0; bj < 2; ++bj) { const f32x4 pp = *(const LAS f32x4*)(P + (r * 2 + bj) * 4); const float tot = (pp[0] + pp[1]) + (pp[2] + pp[3]);
                    const float sc = rq * rsqrtf(rq * rq * tot * (1.f / 96.f) + EPS) * QS;
                    const int d0 = wc * 32 + 4 * fq; const f32x4 g0 = *(const f32x4*)(qn_gain + d0), g1 = *(const f32x4*)(qn_gain + d0 + 16);
                    f32x4 v0 = acc[ai][bj][m][0] * g0 * sc, v1 = acc[ai][bj][m][1] * g1 * sc;
                    if (wc == 2) { const f32x4 t1 = v0, t2 = v1; v0 = t1 * cs - t2 * sn; v1 = t1 * sn + t2 * cs; }
                    h16* qp = QF + ((size_t)(b * 8 + u.pn * 2 + bj) * SEQ + sp) * 96 + d0;
                    u32x2 w0, w1; w0.x = pk_h2(v0[0], v0[1]); w0.y = pk_h2(v0[2], v0[3]); w1.x = pk_h2(v1[0], v1[1]); w1.y = pk_h2(v1[2], v1[3]);
                    *(u32x2*)qp = w0; *(u32x2*)(qp + 16) = w1; } }
    }
};
struct EpiKV {
    static constexpr bool PERM = false, AFTER_DRAIN = true;
    const h16* PROJ; const float* kn_gain; const float* CS; h16* KF; h16* VF;
    __device__ __forceinline__ void fused(f32x4 (&acc)[2][2][4][2], const Unit& u, int wr, int wc, int fr, int fq, LAS unsigned char* lds, int wid, int lane) const {
        LAS float* P = (LAS float*)lds;
        LAS float* RS = (LAS float*)(lds + 8192);
        LAS float* KR = (LAS float*)(lds + 8192 + 1024);
        const int tid = wid * 64 + lane;
        if (wc < 2) {
#pragma unroll
            for (int ai = 0; ai < 2; ++ai)
#pragma unroll
                for (int m = 0; m < 4; ++m)
#pragma unroll
                    for (int bj = 0; bj < 2; ++bj) { float sq = 0.f;
#pragma unroll
                        for (int n = 0; n < 2; ++n) { const f32x4 x = acc[ai][bj][m][n]; sq += (x[0] * x[0] + x[1] * x[1]) + (x[2] * x[2] + x[3] * x[3]); }
                        sq += __shfl_xor(sq, 16); sq += __shfl_xor(sq, 32);
                        if (fq == 0) P[((ai * HALF + wr * 64 + m * 16 + fr) * 2 + bj) * 2 + wc] = sq; }
        }
        { const int row = tid >> 1, half = tid & 1; const h16* rp = PROJ + (size_t)(u.pm * BM + row) * NPROJ;
          const u32x4* ap = (const u32x4*)(rp + PC_MKVA + half * 64); float sq = 0.f;
#pragma unroll
          for (int i = 0; i < 8; ++i) sq += ssq8(ap[i]);
          const u32x4* kp = (const u32x4*)(rp + PC_KROPE + half * 16); float kq = ssq8(kp[0]) + ssq8(kp[1]);
          sq += __shfl_xor(sq, 1); kq += __shfl_xor(kq, 1);
          if (half == 0) { RS[row] = rsqrtf(sq * (1.f / 128.f) + EPS); KR[row] = kq; } }
        LDS_WAIT(); __builtin_amdgcn_s_barrier(); asm volatile("" ::: "memory");
#pragma unroll
        for (int ai = 0; ai < 2; ++ai)
#pragma unroll
            for (int m = 0; m < 4; ++m) { const int r = ai * HALF + wr * 64 + m * 16 + fr, gm = u.pm * BM + r, b = gm / SEQ, sp = gm % SEQ; const float rkv = RS[r], krs = KR[r];
                if (wc < 2) {
#pragma unroll
                    for (int bj = 0; bj < 2; ++bj) { const float tot = (P[(r * 2 + bj) * 2] + P[(r * 2 + bj) * 2 + 1]) * rkv * rkv + krs;
                        const float sc = rkv * rsqrtf(tot * (1.f / 96.f) + EPS);
                        const int d0 = wc * 32 + 4 * fq; const f32x4 g0 = *(const f32x4*)(kn_gain + d0), g1 = *(const f32x4*)(kn_gain + d0 + 16);
                        const f32x4 v0 = acc[ai][bj][m][0] * g0 * sc, v1 = acc[ai][bj][m][1] * g1 * sc;
                        h16* kp = KF + ((((size_t)(b * 8 + u.pn * 2 + bj) * 32 + (sp >> 6)) * 12 + (d0 >> 3)) * 64 + (sp & 63)) * 8 + (d0 & 7);
                        u32x2 w0, w1; w0.x = pk_h2(v0[0], v0[1]); w0.y = pk_h2(v0[2], v0[3]); w1.x = pk_h2(v1[0], v1[1]); w1.y = pk_h2(v1[2], v1[3]);
                        *(u32x2*)kp = w0; *(u32x2*)(kp + 2 * 512) = w1; }
                } else {
#pragma unroll
                    for (int bj = 0; bj < 2; ++bj) { const int e0 = (wc - 2) * 32 + 4 * fq; const f32x4 v0 = acc[ai][bj][m][0] * rkv, v1 = acc[ai][bj][m][1] * rkv;
                        { int rr = r; asm volatile("" : "+v"(rr)); const int t16 = rr & 15, pos = (rr & 48) + (t16 < 4 ? t16 : t16 < 8 ? t16 + 4 : t16 < 12 ? t16 - 4 : t16);
                          LAS h16* vp = (LAS h16*)(lds + 16384) + (((bj * 4 + (rr >> 6)) * 8 + (pos >> 3)) * 64 + e0) * 8 + (pos & 7);
#pragma unroll
                          for (int j = 0; j < 4; ++j) { vp[j * 8] = (h16)v0[j]; vp[(16 + j) * 8] = (h16)v1[j]; } }
                        }
                    { const int bj = wc - 2; const float tot = (P[(r * 2 + bj) * 2] + P[(r * 2 + bj) * 2 + 1]) * rkv * rkv + krs; const float ri = rsqrtf(tot * (1.f / 96.f) + EPS);
                      typedef _Float16 h4 __attribute__((ext_vector_type(4)));
                      const h16* rp = PROJ + (size_t)gm * NPROJ + PC_KROPE + 4 * fq; const h4 a1 = *(const h4*)rp, a2 = *(const h4*)(rp + 16);
                      const f32x4 g1 = *(const f32x4*)(kn_gain + 64 + 4 * fq), g2 = *(const f32x4*)(kn_gain + 80 + 4 * fq);
                      const f32x4 cs = *(const f32x4*)(CS + (size_t)gm * 32 + 4 * fq), sn = *(const f32x4*)(CS + (size_t)gm * 32 + 16 + 4 * fq);
                      f32x4 t1, t2;
#pragma unroll
                      for (int j = 0; j < 4; ++j) { t1[j] = (float)a1[j] * ri * g1[j]; t2[j] = (float)a2[j] * ri * g2[j]; }
                      const f32x4 o1 = t1 * cs - t2 * sn, o2 = t1 * sn + t2 * cs;
                      h16* kp = KF + ((((size_t)(b * 8 + u.pn * 2 + bj) * 32 + (sp >> 6)) * 12 + ((64 + 4 * fq) >> 3)) * 64 + (sp & 63)) * 8 + ((4 * fq) & 7);
                      u32x2 w0, w1; w0.x = pk_h2(o1[0], o1[1]); w0.y = pk_h2(o1[2], o1[3]); w1.x = pk_h2(o2[0], o2[1]); w1.y = pk_h2(o2[2], o2[3]);
                      *(u32x2*)kp = w0; *(u32x2*)(kp + 2 * 512) = w1; }
                } }
        LDS_WAIT(); __builtin_amdgcn_s_barrier(); asm volatile("" ::: "memory");
        { const int b0 = (u.pm * BM) / SEQ, t0 = ((u.pm * BM) % SEQ) >> 6;
#pragma unroll
          for (int i = 0; i < 8; ++i) { const int ch = i * 512 + tid, blk = ch >> 9, off = ch & 511;
              const u32x4 v = *(const LAS u32x4*)(lds + 16384 + ch * 16);
              *(u32x4*)(VF + (((size_t)(b0 * 8 + u.pn * 2 + (blk >> 2)) * 32 + t0 + (blk & 3)) * 4096) + off * 8) = v; } }
    }
};
struct EpiResid {
    static constexpr bool PERM = true, AFTER_DRAIN = false;
    const float* X; h16* O; float* SSQ;
    __device__ __forceinline__ void operator()(const f32x4 (&acc)[2][2][4][2], const Unit& u, int wr, int wc, int fr, int fq) const {
        const int row0 = u.pm * BM + wr * 64 + fr, col0 = u.pn * BM + wc * 32 + 8 * fq;
#pragma unroll
        for (int ai = 0; ai < 2; ++ai)
#pragma unroll
            for (int m = 0; m < 4; ++m) { const int row = row0 + ai * HALF + m * 16; float sq = 0.f;
#pragma unroll
                for (int bj = 0; bj < 2; ++bj) { const float* xp = X + (size_t)row * DM + col0 + bj * HALF; const f32x4 x0 = *(const f32x4*)xp, x1 = *(const f32x4*)(xp + 4);
                    const f32x4 v0 = acc[ai][bj][m][0] + x0, v1 = acc[ai][bj][m][1] + x1;
                    sq += (v0[0] * v0[0] + v0[1] * v0[1]) + (v0[2] * v0[2] + v0[3] * v0[3]) + (v1[0] * v1[0] + v1[1] * v1[1]) + (v1[2] * v1[2] + v1[3] * v1[3]);
                    u32x4 w; w.x = pk_h2(v0[0], v0[1]); w.y = pk_h2(v0[2], v0[3]); w.z = pk_h2(v1[0], v1[1]); w.w = pk_h2(v1[2], v1[3]);
                    *(u32x4*)(O + (size_t)row * DM + col0 + bj * HALF) = w; }
                sq += __shfl_xor(sq, 16); sq += __shfl_xor(sq, 32);
                if (fq == 0) SSQ[(size_t)row * 16 + u.pn * 4 + wc] = sq; }
    }
};
struct DynGroupSched {
    const volatile LAS int* GT; int ncol; unsigned* ctr; volatile LAS unsigned* slot;
    __device__ __forceinline__ bool next(int i, Unit& u) const {
        if (threadIdx.x == 0) slot[i & 1] = __hip_atomic_fetch_add(ctr, 1u, __ATOMIC_RELAXED, __HIP_MEMORY_SCOPE_AGENT);
        asm volatile("s_waitcnt vmcnt(0) lgkmcnt(0)" ::: "memory"); __builtin_amdgcn_s_barrier(); asm volatile("" ::: "memory");
        const int L = (int)slot[i & 1], total = GT[32] * ncol; if (L >= total) return false;
        const int g = L / ncol, nfull = GT[192 + 32]; int e = 0, pm;
        if (g < nfull) { while (GT[192 + e + 1] <= g) ++e; pm = g - GT[192 + e]; }
        else { e = GT[232 + (g - nfull)]; pm = GT[128 + e] >> 8; }
        u.e = e; u.pm = pm; u.pn = L - g * ncol; u.half = (GT[128 + e] - pm * 256) <= 128; return true;
    }
    __device__ __forceinline__ void a_ready(const Unit&) const {}
};
struct DynGroupSchedDep : DynGroupSched {
    unsigned* DONE; unsigned need;
    __device__ __forceinline__ void a_ready(const Unit& u) const {
        if (threadIdx.x < 64) {
            unsigned* p = DONE + 16 * (GT[u.e] + u.pm); unsigned sp = 0;
            while ((unsigned)__builtin_amdgcn_readfirstlane(__hip_atomic_load(p, __ATOMIC_RELAXED, __HIP_MEMORY_SCOPE_AGENT)) < need) { __builtin_amdgcn_s_sleep(2); if (++sp > (1u << 22)) break; }
            __builtin_amdgcn_fence(__ATOMIC_ACQUIRE, "agent");
            asm volatile("s_waitcnt vmcnt(0)" ::: "memory");
        }
        asm volatile("" ::: "memory"); __builtin_amdgcn_s_barrier(); asm volatile("" ::: "memory");
    }
};
struct GatherProb {
    const h16* X; const h16* W; const int* ETOK; const volatile LAS int* GT; int lda, ldb, K;
    __device__ __forceinline__ const char* a_base() const { return (const char*)X; }
    __device__ __forceinline__ unsigned a_row_off(const Unit& u, int h, int R) const { int pos = u.pm * BM + h * HALF + R; const int n = GT[128 + u.e]; pos = pos < n ? pos : n - 1;
        return (unsigned)ETOK[u.e * ECAP + pos] * (unsigned)lda; }
    __device__ __forceinline__ const char* b_base(const Unit& u) const { return (const char*)(W + ((size_t)u.e * 512 + (size_t)u.pn * BM) * ldb); }
};
struct SlotProb {
    const h16* H; const h16* W; const volatile LAS int* GT; int lda, ldb, K;
    __device__ __forceinline__ const char* a_base() const { return (const char*)H; }
    __device__ __forceinline__ unsigned a_row_off(const Unit& u, int h, int R) const { return (unsigned)((GT[64 + u.e] + u.pm * BM + h * HALF + R) * lda); }
    __device__ __forceinline__ const char* b_base(const Unit& u) const { return (const char*)(W + ((size_t)u.e * 1024 + (size_t)u.pn * BM) * ldb); }
};
struct EpiHid {
    static constexpr bool PERM = true, AFTER_DRAIN = false;
    const float* ESC; const volatile LAS int* GT; h16* HID; unsigned* DONE;
    __device__ __forceinline__ void operator()(const f32x4 (&acc)[2][2][4][2], const Unit& u, int wr, int wc, int fr, int fq) const {
        const int n = GT[128 + u.e], base = GT[64 + u.e];
#pragma unroll
        for (int ai = 0; ai < 2; ++ai) { if (ai == 1 && u.half) break;
#pragma unroll
            for (int m = 0; m < 4; ++m) { const int pos = u.pm * BM + ai * HALF + wr * 64 + m * 16 + fr; const bool ok = pos < n;
                float rs = 0.f, w = 0.f; if (ok) { const float* ep = ESC + ((size_t)u.e * ECAP + pos) * 2; rs = ep[0]; w = ep[1]; }
#pragma unroll
                for (int bj = 0; bj < 2; ++bj) { const f32x4 v0 = acc[ai][bj][m][0] * rs, v1 = acc[ai][bj][m][1] * rs;
                    const float h0 = v0[0] / (1.f + __expf(-v0[0])) * v0[1] * w, h1 = v0[2] / (1.f + __expf(-v0[2])) * v0[3] * w;
                    const float h2 = v1[0] / (1.f + __expf(-v1[0])) * v1[1] * w, h3 = v1[2] / (1.f + __expf(-v1[2])) * v1[3] * w;
                    const unsigned long long o = (unsigned long long)pk_h2(h0, h1) | ((unsigned long long)pk_h2(h2, h3) << 32);
                    __hip_atomic_store((unsigned long long*)(HID + (size_t)(base + pos) * DEXP + u.pn * 128 + bj * 64 + wc * 16 + 4 * fq), o, __ATOMIC_RELAXED, __HIP_MEMORY_SCOPE_AGENT); } } }
        asm volatile("s_waitcnt vmcnt(0)" ::: "memory");
        if (fr == 0 && fq == 0) __hip_atomic_fetch_add(DONE + 16 * (GT[u.e] + u.pm), 1u, __ATOMIC_RELAXED, __HIP_MEMORY_SCOPE_AGENT);
    }
};
struct EpiY {
    static constexpr bool PERM = true, AFTER_DRAIN = false;
    const volatile LAS int* GT; h16* Y;
    __device__ __forceinline__ void operator()(const f32x4 (&acc)[2][2][4][2], const Unit& u, int wr, int wc, int fr, int fq) const {
        const int row0 = GT[64 + u.e] + u.pm * BM + wr * 64 + fr, col0 = u.pn * BM + wc * 32 + 8 * fq;
#pragma unroll
        for (int ai = 0; ai < 2; ++ai) { if (ai == 1 && u.half) break;
#pragma unroll
            for (int m = 0; m < 4; ++m) { h16* rowp = Y + (size_t)(row0 + ai * HALF + m * 16) * DM + col0;
#pragma unroll
                for (int bj = 0; bj < 2; ++bj) { const f32x4 v0 = acc[ai][bj][m][0], v1 = acc[ai][bj][m][1];
                    u32x4 w; w.x = pk_h2(v0[0], v0[1]); w.y = pk_h2(v0[2], v0[3]); w.z = pk_h2(v1[0], v1[1]); w.w = pk_h2(v1[2], v1[3]);
                    *(u32x4*)(rowp + bj * HALF) = w; } } }
    }
};
}

__device__ __forceinline__ void gla_combine_rows(const h16* OGLA, const h16* PROJ, const float* og_gain, h16* MIX, int m0, int m1, int mstep, int lane) {
    typedef _Float16 h8 __attribute__((ext_vector_type(8)));
    const int c = lane * 8;
    const f32x4 g0 = *(const f32x4*)(og_gain + (c & 127)), g1 = *(const f32x4*)(og_gain + (c & 127) + 4);
    for (int mb = m0; mb < m1; mb += 4 * mstep) {
        h8 a[4], b2[4], g[4];
#pragma unroll
        for (int q = 0; q < 4; ++q) { const int m = mb + q * mstep < m1 ? mb + q * mstep : mb;
            a[q] = *(const h8*)(OGLA + (size_t)m * 512 + c); b2[q] = *(const h8*)(OGLA + ((size_t)T + m) * 512 + c); g[q] = *(const h8*)(PROJ + (size_t)m * NPROJ + PC_GATE + c); }
#pragma unroll
        for (int q = 0; q < 4; ++q) { const int m = mb + q * mstep; if (m >= m1) break;
            float o[8]; float sq = 0.f;
#pragma unroll
            for (int k = 0; k < 8; ++k) { o[k] = (float)a[q][k] + (float)b2[q][k]; sq += o[k] * o[k]; }
            sq += __shfl_xor(sq, 1); sq += __shfl_xor(sq, 2); sq += __shfl_xor(sq, 4); sq += __shfl_xor(sq, 8);
            const float rs = rsqrtf(sq * (1.f / 128.f) + EPS);
            float r[8];
#pragma unroll
            for (int k = 0; k < 8; ++k) { const float gg = (float)g[q][k]; r[k] = o[k] * rs * (k < 4 ? g0[k] : g1[k - 4]) * (gg / (1.f + __expf(-gg))); }
            u32x4 w; w.x = pk_h2(r[0], r[1]); w.y = pk_h2(r[2], r[3]); w.z = pk_h2(r[4], r[5]); w.w = pk_h2(r[6], r[7]);
            *(u32x4*)(MIX + (size_t)m * DM + c) = w; }
    }
}

namespace at {
typedef _Float16 f16x8 __attribute__((ext_vector_type(8)));
typedef float f32x16 __attribute__((ext_vector_type(16)));
typedef __fp16 fp16x2 __attribute__((ext_vector_type(2)));
constexpr int KB_BYTES = 12288, VB_BYTES = 8192, TILE_BYTES = KB_BYTES + VB_BYTES, BUF_BYTES = 2 * TILE_BYTES, NT2 = SEQ / 128;
constexpr float THR = 8.f;
__device__ __forceinline__ int crow(int r, int hi) { return (r & 3) + 8 * (r >> 2) + 4 * hi; }
#define AT_DMA(gsrc, ldsoff) __builtin_amdgcn_global_load_lds((const unsigned*)(gsrc), (LAS unsigned*)(lds + (ldsoff)), 16, 0, 0)
__device__ __forceinline__ void attn_unit(LAS unsigned char* lds, const h16* __restrict__ QF, const h16* __restrict__ KF, const h16* __restrict__ VT, h16* __restrict__ MIX, int bh, int qb) {
    int tid = threadIdx.x; asm volatile("" : "+v"(tid));
    const int lane = tid & 63, wid = __builtin_amdgcn_readfirstlane(tid >> 6), r32 = lane & 31, hi = lane >> 5;
    f16x8 qf[6];
    { const h16* qp = QF + ((size_t)bh * SEQ + qb * 256 + wid * 32 + r32) * 96 + hi * 8;
#pragma unroll
      for (int ks = 0; ks < 6; ++ks) qf[ks] = *(const f16x8*)(qp + 16 * ks); }
    LAS float* wsf = (LAS float*)(lds + 2 * BUF_BYTES) + wid * 64;
    const h16* kg = KF + (size_t)bh * SEQ * 96 + wid * 512 + lane * 8;
    const h16* vg = VT + (size_t)bh * SEQ * 64 + wid * 512 + lane * 8;
    const int kdst = wid * 1024, vdst = KB_BYTES + wid * 1024;
#define AT_ISSUE1(t, off) do { AT_DMA(kg + (size_t)(t) * 6144, (off) + kdst); if (wid < 4) AT_DMA(kg + (size_t)(t) * 6144 + 8 * 512, (off) + kdst + 8192); AT_DMA(vg + (size_t)(t) * 4096, (off) + vdst); } while (0)
#define AT_ISSUE(t2, b) do { AT_ISSUE1(2 * (t2), (b) * BUF_BYTES); AT_ISSUE1(2 * (t2) + 1, (b) * BUF_BYTES + TILE_BYTES); } while (0)
    f32x16 o0, o1;
#pragma unroll
    for (int r = 0; r < 16; ++r) { o0[r] = 0.f; o1[r] = 0.f; }
    float m_run = 0.f, l_run = 0.f;
    AT_ISSUE(0, 0);
    asm volatile("s_waitcnt vmcnt(0)" ::: "memory"); __builtin_amdgcn_s_barrier(); asm volatile("" ::: "memory");
    for (int t = 0; t < NT2; ++t) {
        const int cur = t & 1;
        if (t + 1 < NT2) AT_ISSUE(t + 1, cur ^ 1);
        LAS unsigned char* Kb = lds + cur * BUF_BYTES; LAS unsigned char* Vb = Kb + KB_BYTES;
        f32x16 s[4];
        { const float nm = -m_run;
#pragma unroll
          for (int q = 0; q < 4; ++q)
#pragma unroll
              for (int r = 0; r < 16; ++r) s[q][r] = nm; }
#pragma unroll
        for (int tl = 0; tl < 2; ++tl) {
            f16x8 kf[12];
#pragma unroll
            for (int ks = 0; ks < 6; ++ks) { kf[2 * ks] = *(const LAS f16x8*)(Kb + tl * TILE_BYTES + (2 * ks + hi) * 1024 + r32 * 16); kf[2 * ks + 1] = *(const LAS f16x8*)(Kb + tl * TILE_BYTES + (2 * ks + hi) * 1024 + (32 + r32) * 16); }
            asm volatile("s_waitcnt lgkmcnt(0)" ::: "memory"); __builtin_amdgcn_sched_barrier(0);
            __builtin_amdgcn_s_setprio(1);
#pragma unroll
            for (int ks = 0; ks < 6; ++ks) {
                s[2 * tl] = __builtin_amdgcn_mfma_f32_32x32x16_f16(kf[2 * ks], qf[ks], s[2 * tl], 0, 0, 0);
                s[2 * tl + 1] = __builtin_amdgcn_mfma_f32_32x32x16_f16(kf[2 * ks + 1], qf[ks], s[2 * tl + 1], 0, 0, 0);
            }
            __builtin_amdgcn_s_setprio(0);
        }
        float mx = fmaxf(fmaxf(s[0][0], s[1][0]), fmaxf(s[2][0], s[3][0]));
#pragma unroll
        for (int r = 1; r < 16; ++r) mx = fmaxf(mx, fmaxf(fmaxf(s[0][r], s[1][r]), fmaxf(s[2][r], s[3][r])));
        mx = fmaxf(mx, __shfl_xor(mx, 32));
        if (t == 0 || __any(mx > THR)) {
            const float d = (t == 0) ? mx : fmaxf(mx, 0.f), f = __builtin_amdgcn_exp2f(-d);
            m_run += d;
#pragma unroll
            for (int q = 0; q < 4; ++q)
#pragma unroll
                for (int r = 0; r < 16; ++r) s[q][r] -= d;
            if (t != 0) { l_run *= f;
                if (hi == 0) wsf[r32] = f;
                asm volatile("s_waitcnt lgkmcnt(0)" ::: "memory");
#pragma unroll
                for (int r = 0; r < 16; ++r) { const float ff = wsf[crow(r, hi)]; o0[r] *= ff; o1[r] *= ff; } }
        }
#pragma unroll
        for (int tl = 0; tl < 2; ++tl) {
            float ps = 0.f;
#pragma unroll
            for (int r = 0; r < 16; ++r) { s[2 * tl][r] = __builtin_amdgcn_exp2f(s[2 * tl][r]); s[2 * tl + 1][r] = __builtin_amdgcn_exp2f(s[2 * tl + 1][r]); ps += s[2 * tl][r] + s[2 * tl + 1][r]; }
            l_run += ps;
            f16x8 vf[8], pa[4];
#pragma unroll
            for (int g = 0; g < 4; ++g) { vf[2 * g] = *(const LAS f16x8*)(Vb + tl * TILE_BYTES + (2 * g + hi) * 1024 + r32 * 16); vf[2 * g + 1] = *(const LAS f16x8*)(Vb + tl * TILE_BYTES + (2 * g + hi) * 1024 + (32 + r32) * 16); }
#pragma unroll
            for (int g = 0; g < 4; ++g)
#pragma unroll
                for (int j = 0; j < 4; ++j) { const int base = 8 * (g & 1) + 2 * j; const fp16x2 pk = __builtin_amdgcn_cvt_pkrtz(s[2 * tl + (g >> 1)][base], s[2 * tl + (g >> 1)][base + 1]); pa[g][2 * j] = (h16)pk[0]; pa[g][2 * j + 1] = (h16)pk[1]; }
            asm volatile("s_waitcnt lgkmcnt(0)" ::: "memory"); __builtin_amdgcn_sched_barrier(0);
            __builtin_amdgcn_s_setprio(1);
#pragma unroll
            for (int g = 0; g < 4; ++g) {
                o0 = __builtin_amdgcn_mfma_f32_32x32x16_f16(pa[g], vf[2 * g], o0, 0, 0, 0);
                o1 = __builtin_amdgcn_mfma_f32_32x32x16_f16(pa[g], vf[2 * g + 1], o1, 0, 0, 0);
            }
            __builtin_amdgcn_s_setprio(0);
        }
        asm volatile("s_waitcnt vmcnt(0) lgkmcnt(0)" ::: "memory"); __builtin_amdgcn_s_barrier(); asm volatile("" ::: "memory");
    }
    l_run += __shfl_xor(l_run, 32);
    if (hi == 0) wsf[r32] = 1.f / l_run;
    asm volatile("s_waitcnt lgkmcnt(0)" ::: "memory");
    const int b = bh >> 3, h = bh & 7;
    h16* op = MIX + ((size_t)b * SEQ + qb * 256 + wid * 32) * DM + 512 + h * 64 + r32;
#pragma unroll
    for (int r = 0; r < 16; ++r) { const int q = crow(r, hi); const float il = wsf[q]; op[(size_t)q * DM] = (h16)(o0[r] * il); op[(size_t)q * DM + 32] = (h16)(o1[r] * il); }
    asm volatile("s_waitcnt lgkmcnt(0)" ::: "memory"); __builtin_amdgcn_s_barrier(); asm volatile("" ::: "memory");
#undef AT_ISSUE
#undef AT_ISSUE1
}
#undef AT_DMA
}

namespace gl {
typedef _Float16 f16x8 __attribute__((ext_vector_type(8)));
typedef _Float16 f16x4 __attribute__((ext_vector_type(4)));
typedef short v4i16_t __attribute__((ext_vector_type(4)));
constexpr int RAW_Q = 0, RAW_K = 8192, RAW_V = 16384, RAW_LR = 32768, RAW_BYTES = 34816;
constexpr int OFF_QREL = 2 * RAW_BYTES, RS = 144  , IMG = 64 * RS;
constexpr int OFF_KREL = OFF_QREL + IMG, OFF_QDEC = OFF_KREL + IMG, OFF_KDECT = OFF_QDEC + IMG, OFF_SC = OFF_KDECT + IMG, OFF_TOT = OFF_SC + IMG, OFF_EBL = OFF_TOT + 2048, GLA_LDS = OFF_EBL + 256;
static_assert(GLA_LDS <= RING_BYTES, "GLA LDS map");
__device__ __forceinline__ int vswz(int token) { return 2 * ((token & 3) | (((token >> 3) & 1) << 2)); }
#define GL_DMA(gsrc, ldsoff) __builtin_amdgcn_global_load_lds((const unsigned*)(gsrc), (LAS unsigned*)(lds + (ldsoff)), 16, 0, 0)
#define GL_BAR() do { asm volatile("s_waitcnt lgkmcnt(0)" ::: "memory"); __builtin_amdgcn_s_barrier(); asm volatile("" ::: "memory"); } while (0)
__device__ __forceinline__ void gla_unit(LAS unsigned char* lds, const h16* __restrict__ PROJ, const float* __restrict__ GW, const float* __restrict__ GB, h16* __restrict__ OG, int b, int h, int dir) {
    int tid = threadIdx.x; asm volatile("" : "+v"(tid));
    const int lane = tid & 63, w = __builtin_amdgcn_readfirstlane(tid >> 6), l15 = lane & 15, kg = lane >> 4;
    typedef _Float16 h2v __attribute__((ext_vector_type(2)));
    h2v gwp[8];
#pragma unroll
    for (int r = 0; r < 8; ++r) gwp[r] = (h2v){(h16)GW[(2 * r) * 256 + h * 64 + lane], (h16)GW[(2 * r + 1) * 256 + h * 64 + lane]};
    const float gb = GB[h * 64 + lane];
    const h16* pb = PROJ + (size_t)b * SEQ * NPROJ;
    f32x4 Sacc[4];
#pragma unroll
    for (int k = 0; k < 4; ++k) Sacc[k] = (f32x4){0.f, 0.f, 0.f, 0.f};
#define GL_TOK(c, i) (dir ? (SEQ - 1 - ((c) * 64 + (i))) : ((c) * 64 + (i)))
#define GL_ISSUE(c, buf) do { const int _rb = (buf) * RAW_BYTES; \
        { const int row = 8 * w + (lane >> 3); const h16* src = pb + (size_t)GL_TOK(c, row) * NPROJ + h * 64 + (lane & 7) * 8; GL_DMA(src + PC_Q, _rb + RAW_Q + w * 1024); GL_DMA(src + PC_K, _rb + RAW_K + w * 1024); } \
        _Pragma("unroll") for (int _j = 0; _j < 2; ++_j) { const int row = 8 * w + 4 * _j + (lane >> 4); const int cc = (lane & 15) ^ vswz(row); \
            GL_DMA(pb + (size_t)GL_TOK(c, row) * NPROJ + PC_V + h * 128 + cc * 8, _rb + RAW_V + (2 * w + _j) * 1024); } \
        if (lane < 16) { const int row = 8 * w + (lane >> 1); GL_DMA(pb + (size_t)GL_TOK(c, row) * NPROJ + (dir ? PC_LRB : PC_LRF) + (lane & 1) * 8, _rb + RAW_LR + w * 256); } } while (0)
    f32x4 opend[4];
    float bl[8];
#define GL_GATES(rb_) do { float run = 0.f; const LAS unsigned char* lrp_ = lds + (rb_) * RAW_BYTES + RAW_LR; \
        _Pragma("unroll") for (int k = 0; k < 8; ++k) { const int i = 8 * w + k; const f16x8 l0 = *(const LAS f16x8*)(lrp_ + i * 32), l1 = *(const LAS f16x8*)(lrp_ + i * 32 + 16); \
            float z = gb, z1 = 0.f; \
            _Pragma("unroll") for (int r = 0; r < 4; ++r) { z = __builtin_amdgcn_fdot2((h2v){l0[2 * r], l0[2 * r + 1]}, gwp[r], z, false); z1 = __builtin_amdgcn_fdot2((h2v){l1[2 * r], l1[2 * r + 1]}, gwp[4 + r], z1, false); } \
            z += z1; \
            const float z2 = z * 1.4426950408889634f; \
            const float ls2 = fminf(z2, 0.f) - __builtin_amdgcn_logf(1.f + __builtin_amdgcn_exp2f(-fabsf(z2))); \
            run += ls2 * (1.f / 16.f); bl[k] = run; } \
        ((LAS float*)(lds + OFF_TOT))[w * 64 + lane] = run; } while (0)
    GL_ISSUE(0, 0);
    asm volatile("s_waitcnt vmcnt(0)" ::: "memory");
    GL_GATES(0);
    GL_BAR();
    for (int c = 0; c < SEQ / 64; ++c) {
        const int cur = c & 1; LAS unsigned char* raw = lds + cur * RAW_BYTES;
        if (c + 1 < SEQ / 64) GL_ISSUE(c + 1, cur ^ 1);
        float pre = 0.f, bref = 0.f, blast = 0.f;
#pragma unroll
        for (int ww = 0; ww < 8; ++ww) { const float tv = ((const LAS float*)(lds + OFF_TOT))[ww * 64 + lane]; if (ww < w) pre += tv; if (ww < 4) bref += tv; blast += tv; }
        { const int d = lane; const int dperm = (d & 32) + 8 * ((d >> 2) & 3) + 4 * ((d >> 4) & 1) + (d & 3);
          f16x8 kd; const float eref = __builtin_amdgcn_exp2f(bref), elr = __builtin_amdgcn_exp2f(blast - bref);
#pragma unroll
          for (int k = 0; k < 8; ++k) { const int i = 8 * w + k; const float bb = pre + bl[k];
              const float qv = (float)*(const LAS h16*)(raw + RAW_Q + i * 128 + d * 2), kv = (float)*(const LAS h16*)(raw + RAW_K + i * 128 + d * 2);
              const float dd = fminf(fmaxf(bb - bref, -14.f), 14.f); const float e1 = __builtin_amdgcn_exp2f(dd), e1i = __builtin_amdgcn_rcpf(e1);
              const float qr = qv * e1, kr = kv * e1i;
              *(LAS h16*)(lds + OFF_QREL + i * RS + d * 2) = (h16)qr;
              *(LAS h16*)(lds + OFF_KREL + i * RS + d * 2) = (h16)kr;
              *(LAS h16*)(lds + OFF_QDEC + i * RS + dperm * 2) = (h16)(qr * eref);
              kd[k] = (h16)(kr * elr); }
          *(LAS f16x8*)(lds + OFF_KDECT + d * RS + (8 * w) * 2) = kd;
          if (w == 0) ((LAS float*)(lds + OFF_EBL))[d] = __builtin_amdgcn_exp2f(blast); }
        GL_BAR();
#pragma unroll
        for (int q = 0; q < 2; ++q) { const int blk = 2 * w + q, ib = blk >> 2, jb = blk & 3;
            f32x4 sc = {0.f, 0.f, 0.f, 0.f};
            if (jb <= ib) {
#pragma unroll
                for (int ks = 0; ks < 2; ++ks) { const f16x8 a = *(const LAS f16x8*)(lds + OFF_KREL + (16 * jb + l15) * RS + (32 * ks + 8 * kg) * 2), bq = *(const LAS f16x8*)(lds + OFF_QREL + (16 * ib + l15) * RS + (32 * ks + 8 * kg) * 2);
                    sc = __builtin_amdgcn_mfma_f32_16x16x32_f16(a, bq, sc, 0, 0, 0); }
                if (jb == ib) {
#pragma unroll
                    for (int r = 0; r < 4; ++r) { const int j = 4 * kg + r, i = l15; const bool keep = dir ? (j < i) : (j <= i); if (!keep) sc[r] = 0.f; }
                }
            }
            f16x4 o; o[0] = (h16)sc[0]; o[1] = (h16)sc[1]; o[2] = (h16)sc[2]; o[3] = (h16)sc[3];
            *(LAS f16x4*)(lds + OFF_SC + (16 * ib + l15) * RS + (16 * jb + 4 * kg) * 2) = o; }
        f16x8 Vf[2], Sf[2];
#pragma unroll
        for (int ks = 0; ks < 2; ++ks) {
            v4i16_t t0, t1;
            { const int q = l15 >> 2, p = l15 & 3;
              const int tk0 = 32 * ks + 8 * kg + q, tk1 = tk0 + 4;
              const int c0 = (2 * w + (p >> 1)) ^ vswz(tk0), c1 = (2 * w + (p >> 1)) ^ vswz(tk1);
              t0 = __builtin_amdgcn_ds_read_tr16_b64_v4i16((LAS v4i16_t*)(raw + RAW_V + tk0 * 256 + c0 * 16 + (p & 1) * 8));
              t1 = __builtin_amdgcn_ds_read_tr16_b64_v4i16((LAS v4i16_t*)(raw + RAW_V + tk1 * 256 + c1 * 16 + (p & 1) * 8)); }
            const f16x4 a = __builtin_bit_cast(f16x4, t0), bq = __builtin_bit_cast(f16x4, t1);
            Vf[ks] = (f16x8){a[0], a[1], a[2], a[3], bq[0], bq[1], bq[2], bq[3]};
            Sf[ks] = (f16x8){(h16)Sacc[2 * ks][0], (h16)Sacc[2 * ks][1], (h16)Sacc[2 * ks][2], (h16)Sacc[2 * ks][3], (h16)Sacc[2 * ks + 1][0], (h16)Sacc[2 * ks + 1][1], (h16)Sacc[2 * ks + 1][2], (h16)Sacc[2 * ks + 1][3]};
        }
        GL_BAR();
        { f16x8 fsc[4][2], fqd[4][2], fkd[4][2]; f32x4 feb[4];
#pragma unroll
          for (int ib = 0; ib < 4; ++ib)
#pragma unroll
              for (int ks = 0; ks < 2; ++ks) { if (32 * ks <= 16 * ib + 15) fsc[ib][ks] = *(const LAS f16x8*)(lds + OFF_SC + (16 * ib + l15) * RS + (32 * ks + 8 * kg) * 2);
                  fqd[ib][ks] = *(const LAS f16x8*)(lds + OFF_QDEC + (16 * ib + l15) * RS + (32 * ks + 8 * kg) * 2); }
#pragma unroll
          for (int blk = 0; blk < 4; ++blk) { feb[blk] = *(const LAS f32x4*)(lds + OFF_EBL + (16 * blk + 4 * kg) * 4);
#pragma unroll
              for (int ks = 0; ks < 2; ++ks) fkd[blk][ks] = *(const LAS f16x8*)(lds + OFF_KDECT + (16 * blk + l15) * RS + (32 * ks + 8 * kg) * 2); }
          asm volatile("s_waitcnt lgkmcnt(0)" ::: "memory"); __builtin_amdgcn_sched_barrier(0);
          f32x4 oa[4];
#pragma unroll
          for (int ib = 0; ib < 4; ++ib) oa[ib] = (f32x4){0.f, 0.f, 0.f, 0.f};
#pragma unroll
          for (int ks = 0; ks < 2; ++ks)
#pragma unroll
              for (int ib = 0; ib < 4; ++ib) { if (32 * ks <= 16 * ib + 15) oa[ib] = __builtin_amdgcn_mfma_f32_16x16x32_f16(fsc[ib][ks], Vf[ks], oa[ib], 0, 0, 0); }
#pragma unroll
          for (int ks = 0; ks < 2; ++ks)
#pragma unroll
              for (int ib = 0; ib < 4; ++ib) oa[ib] = __builtin_amdgcn_mfma_f32_16x16x32_f16(fqd[ib][ks], Sf[ks], oa[ib], 0, 0, 0);
#pragma unroll
          for (int blk = 0; blk < 4; ++blk) Sacc[blk] = Sacc[blk] * feb[blk];
#pragma unroll
          for (int ks = 0; ks < 2; ++ks)
#pragma unroll
              for (int blk = 0; blk < 4; ++blk) Sacc[blk] = __builtin_amdgcn_mfma_f32_16x16x32_f16(fkd[blk][ks], Vf[ks], Sacc[blk], 0, 0, 0);
#pragma unroll
          for (int ib = 0; ib < 4; ++ib) opend[ib] = oa[ib]; }
        asm volatile("s_waitcnt vmcnt(0)" ::: "memory");
        if (c + 1 < SEQ / 64) GL_GATES(cur ^ 1);
        { LAS unsigned char* stg = lds + OFF_QREL + w * 2048;
#pragma unroll
          for (int ib = 0; ib < 4; ++ib)
#pragma unroll
              for (int r = 0; r < 4; ++r) *(LAS h16*)(stg + (16 * ib + 4 * kg + r) * 32 + l15 * 2) = (h16)opend[ib][r];
          asm volatile("s_waitcnt lgkmcnt(0)" ::: "memory");
#pragma unroll
          for (int q = 0; q < 2; ++q) { const int p = q * 64 + lane, i = p >> 1; const u32x4 v = *(const LAS u32x4*)(stg + p * 16);
              *(u32x4*)(OG + ((size_t)dir * T + (size_t)b * SEQ + GL_TOK(c, i)) * 512 + h * 128 + 16 * w + (p & 1) * 8) = v; } }
        GL_BAR();
    }
#undef GL_ISSUE
#undef GL_TOK
#undef GL_GATES
}
#undef GL_DMA
#undef GL_BAR
}

namespace rt {
typedef _Float16 f16x8 __attribute__((ext_vector_type(8)));
__device__ __forceinline__ void route_block(LAS unsigned char* lds, const h16* __restrict__ X1H, const h16* __restrict__ W16, const float* __restrict__ SSQ, const float* __restrict__ bg, const float* __restrict__ be,
                                            float* RS2, int* TOKE, int* TOKP, float* TOKW, int* ETOK, float* ESC, int* cnt, int row0) {
    int tid = threadIdx.x; asm volatile("" : "+v"(tid));
    const int lane = tid & 63, w = __builtin_amdgcn_readfirstlane(tid >> 6), l15 = lane & 15, kg = lane >> 4;
    f32x4 acc[4][3];
#pragma unroll
    for (int i = 0; i < 4; ++i)
#pragma unroll
        for (int j = 0; j < 3; ++j) acc[i][j] = (f32x4){0.f, 0.f, 0.f, 0.f};
    f16x8 af[4][4], bf[3][4];
#pragma unroll
    for (int ks = 0; ks < 4; ++ks) { const int k0 = 128 * w + 32 * ks + 8 * kg;
#pragma unroll
        for (int i = 0; i < 4; ++i) af[i][ks] = *(const f16x8*)(X1H + (size_t)(row0 + 16 * i + l15) * DM + k0);
#pragma unroll
        for (int j = 0; j < 3; ++j) bf[j][ks] = *(const f16x8*)(W16 + (size_t)(16 * j + l15) * DM + k0); }
#pragma unroll
    for (int ks = 0; ks < 4; ++ks)
#pragma unroll
        for (int i = 0; i < 4; ++i)
#pragma unroll
            for (int j = 0; j < 3; ++j) acc[i][j] = __builtin_amdgcn_mfma_f32_16x16x32_f16(bf[j][ks], af[i][ks], acc[i][j], 0, 0, 0);
    LAS float* PS = (LAS float*)lds;
#pragma unroll
    for (int i = 0; i < 4; ++i)
#pragma unroll
        for (int j = 0; j < 3; ++j) *(LAS f32x4*)(PS + (w * 64 + 16 * i + l15) * 48 + 16 * j + 4 * kg) = acc[i][j];
    LDS_WAIT(); __builtin_amdgcn_s_barrier(); asm volatile("" ::: "memory");
    LAS float* L = (LAS float*)(lds + 8 * 64 * 48 * 4);
    for (int t = tid; t < 64 * 12; t += NTHREADS) { const int r = t / 12, c4 = (t % 12) * 4; f32x4 sum = {0.f, 0.f, 0.f, 0.f};
#pragma unroll
        for (int ww = 0; ww < 8; ++ww) sum += *(const LAS f32x4*)(PS + (ww * 64 + r) * 48 + c4);
        *(LAS f32x4*)(L + r * 48 + c4) = sum; }
    LDS_WAIT(); __builtin_amdgcn_s_barrier(); asm volatile("" ::: "memory");
    if (tid < 64) { const int r = tid, m = row0 + r; LAS float* l = L + r * 48;
        float ss = 0.f; { const f32x4* sp = (const f32x4*)(SSQ + (size_t)m * 16);
#pragma unroll
            for (int i = 0; i < 4; ++i) { const f32x4 t4 = sp[i]; ss += (t4[0] + t4[1]) + (t4[2] + t4[3]); } }
        const float rs = rsqrtf(ss * (1.f / DM) + EPS);
        float mx = l[0] * rs + bg[0]; int gi = 0;
        for (int g = 1; g < 4; ++g) { const float v = l[g] * rs + bg[g]; if (v > mx) { mx = v; gi = g; } }
        float den = 0.f;
        for (int g = 0; g < 4; ++g) den += expf(l[g] * rs + bg[g] - mx);
        const float ptop = 1.f / den;
        LAS float* l8 = l + 4 + gi * 8;
        for (int j = 0; j < 8; ++j) l8[j] = l8[j] * rs + be[gi * 8 + j];
        float b0 = l8[0]; int i0 = 0;
        for (int j = 1; j < 8; ++j) if (l8[j] > b0) { b0 = l8[j]; i0 = j; }
        float b1 = -3.0e38f; int i1 = 0;
        for (int j = 0; j < 8; ++j) if (j != i0 && l8[j] > b1) { b1 = l8[j]; i1 = j; }
        const float p1 = expf(b1 - b0);
        const float w0 = ptop / (1.f + p1), w1 = ptop * p1 / (1.f + p1);
        const int e0 = gi * 8 + i0, e1 = gi * 8 + i1;
        LAS int* H = (LAS int*)(lds + 8 * 64 * 48 * 4 + 64 * 48 * 4);
        if (tid < 32) H[tid] = 0;
        __builtin_amdgcn_wave_barrier(); asm volatile("s_waitcnt lgkmcnt(0)" ::: "memory");
        const int r0 = __hip_atomic_fetch_add(H + e0, 1, __ATOMIC_RELAXED, __HIP_MEMORY_SCOPE_WORKGROUP), r1 = __hip_atomic_fetch_add(H + e1, 1, __ATOMIC_RELAXED, __HIP_MEMORY_SCOPE_WORKGROUP);
        __builtin_amdgcn_wave_barrier(); asm volatile("s_waitcnt lgkmcnt(0)" ::: "memory");
        if (tid < 32) { const int c = H[tid]; H[32 + tid] = c ? atomicAdd(&cnt[tid], c) : 0; }
        __builtin_amdgcn_wave_barrier(); asm volatile("s_waitcnt vmcnt(0) lgkmcnt(0)" ::: "memory");
        const int q0 = H[32 + e0] + r0, q1 = H[32 + e1] + r1;
        ETOK[e0 * ECAP + q0] = m; ETOK[e1 * ECAP + q1] = m;
        ESC[((size_t)e0 * ECAP + q0) * 2] = rs; ESC[((size_t)e0 * ECAP + q0) * 2 + 1] = w0;
        ESC[((size_t)e1 * ECAP + q1) * 2] = rs; ESC[((size_t)e1 * ECAP + q1) * 2 + 1] = w1;
        RS2[m] = rs; TOKE[m * 2] = e0; TOKE[m * 2 + 1] = e1; TOKP[m * 2] = q0; TOKP[m * 2 + 1] = q1; TOKW[m * 2] = w0; TOKW[m * 2 + 1] = w1;
    }
    __syncthreads();
}
}

__global__ void __launch_bounds__(NTHREADS, 2) mega_fwd(MArgs args) {
    extern __shared__ __attribute__((aligned(16))) unsigned char lds_raw[];
    LAS unsigned char* lds = (LAS unsigned char*)lds_raw;
    volatile LAS unsigned* MISC = (volatile LAS unsigned*)(lds + MISC_OFF);
    const int tid = threadIdx.x, lane = tid & 63, wave = __builtin_amdgcn_readfirstlane(tid >> 6);
    const int G = gridDim.x, bx = blockIdx.x;
    const int vcu = (G % 8 == 0) ? (bx % 8) * (G / 8) + bx / 8 : bx;
    unsigned* ctl = (unsigned*)(args.ws + WS_CTL);
    for (int u = tid; u < (LDS_BYTES - RING_BYTES) / 4; u += NTHREADS) ((LAS unsigned*)(lds + RING_BYTES))[u] = 0u;
    __syncthreads();
    XcdBarrier bar = xcd_barrier_post(ctl + CW_BAR + args.li * XCD_BAR_WORDS, MISC + 8);
    const int gw = vcu * NWAVES + wave, NGW = G * NWAVES;
    const int lo = args.ph_lo, hi = args.ph_hi;
#ifndef DUP_PHASE
#define DUP_PHASE -1
#endif
#define REPS(k) ((k) == DUP_PHASE ? 3 : 1)
#define IN(k) (lo <= (k) && (k) < hi)
#define BOTH(k) (IN(k) && IN((k) + 1))
    if (IN(0)) for (int rep = 0; rep < REPS(0); ++rep) { p0_prologue(args, lds, gw, NGW, lane, wave); if (BOTH(0) || rep + 1 < REPS(0)) xcd_barrier(bar); }
    if (IN(1)) for (int rep = 0; rep < REPS(1); ++rep) {
        g8::PlainProb p{(const h16*)(args.ws + WS_H1), (const h16*)(args.ws + WS_WINT), DM, DM, DM};
        g8::StaticOrder S; S.init(T / 256, NPROJ / 256, G, bx);
        g8::EpiH16 E{(h16*)(args.ws + WS_PROJ), NPROJ};
        g8::gemm_phase<g8::PlainProb, g8::EpiH16, g8::StaticOrder, true>(lds, p, S, E);
        if (BOTH(1) || rep + 1 < REPS(1)) xcd_barrier(bar);
    }
    if (IN(2)) for (int rep = 0; rep < REPS(2); ++rep) {
        const h16* PROJ = (const h16*)(args.ws + WS_PROJ); const float* CS = (const float*)(args.ws + WS_CS);
        g8::StaticOrder S; S.init(T / 256, 8, G, bx);
        g8::Unit u;
        for (int i = 0; S.next(i, u); ++i) {
            if (u.pn < 4) {
                g8::PlainProb p{PROJ + PC_MQA, (const h16*)(args.ws + WS_WQBT), NPROJ, 256, 256};
                g8::EpiQ E{PROJ, (const float*)args.in[13], CS, (h16*)(args.ws + WS_QF)};
                g8::OneUnit O{u};
                g8::gemm_phase<g8::PlainProb, g8::EpiQ, g8::OneUnit, false>(lds, p, O, E);
            } else {
                g8::PlainProb p{PROJ + PC_MKVA, (const h16*)(args.ws + WS_WKVBT), NPROJ, 256, 256};
                g8::EpiKV E{PROJ, (const float*)args.in[14], CS, (h16*)(args.ws + WS_KF), (h16*)(args.ws + WS_VF)};
                g8::Unit u2 = u; u2.pn = u.pn - 4;
                g8::OneUnit O{u2};
                g8::gemm_phase<g8::PlainProb, g8::EpiKV, g8::OneUnit, false>(lds, p, O, E);
            }
            __syncthreads();
        }
        if (BOTH(2) || rep + 1 < REPS(2)) xcd_barrier(bar);
    }
    if (IN(PH_MIX)) for (int rep = 0; rep < REPS(PH_MIX); ++rep) {
        const h16* PROJ = (const h16*)(args.ws + WS_PROJ);
        { const int x0 = (int)(xb_xcc_id() & 7u);
          for (int k = 0; k < 8; ++k) { const int x = (x0 + k) & 7;
              for (;;) {
                  if (tid == 0) MISC[16] = xb_add(ctl + CW_Q + 64 * (rep * 8 + x), 1u);
                  __syncthreads();
                  const int idx = (int)MISC[16];
                  __syncthreads();
                  if (idx >= 152) break;
                  if (idx < 8) { const int dir = idx & 1, hh = idx >> 1; gl::gla_unit(lds, PROJ, (const float*)args.in[dir ? 6 : 4], (const float*)args.in[dir ? 7 : 5], (h16*)(args.ws + WS_OGLA), x, hh, dir);
                      VM_WAIT(); __syncthreads();
                      if (wave == 0) { __builtin_amdgcn_fence(__ATOMIC_RELEASE, "agent"); VM_WAIT(); xb_add(ctl + CW_GLADONE + 64 * (rep * 8 + x), lane == 0 ? 1u : 0u); } }
                  else if (idx < 72) { const int a = idx - 8; at::attn_unit(lds, (const h16*)(args.ws + WS_QF), (const h16*)(args.ws + WS_KF), (const h16*)(args.ws + WS_VF), (h16*)(args.ws + WS_MIX), x * 8 + (a >> 3), a & 7); }
                  else if (idx < 120) {
                      int ln = lane; asm volatile("" : "+v"(ln));
                      const int bj = idx - 72;
                      const int base = (x * 48 + bj) * 32 + wave * 4; LAS float* scr = (LAS float*)(lds + wave * 16384);
                      if (rep == 0) expert_items4(args, base, scr, ln);
                      __syncthreads(); }
                  else {
                      const int j = idx - 120;
                      if (wave == 0) { unsigned sp = 0; while ((unsigned)__builtin_amdgcn_readfirstlane(xb_ld(ctl + CW_GLADONE + 64 * (rep * 8 + x))) < 8u) { __builtin_amdgcn_s_sleep(4); if (++sp > (1u << 16)) break; }
                          __builtin_amdgcn_fence(__ATOMIC_ACQUIRE, "agent"); VM_WAIT(); }
                      __syncthreads();
                      int ln = lane; asm volatile("" : "+v"(ln));
                      const int m0 = x * SEQ + j * 64 + wave * 8;
                      gla_combine_rows((const h16*)(args.ws + WS_OGLA), PROJ, (const float*)args.in[8], (h16*)(args.ws + WS_MIX), m0, m0 + 8, 1, ln);
                      __syncthreads(); }
              } } }
        if (BOTH(PH_MIX) || rep + 1 < REPS(PH_MIX)) xcd_barrier(bar);
    }
    if (IN(PH_COMB)) for (int rep = 0; rep < REPS(PH_COMB); ++rep) {
    }
    if (IN(PH_OUT)) for (int rep = 0; rep < REPS(PH_OUT); ++rep) {
        g8::PlainProb p{(const h16*)(args.ws + WS_MIX), (const h16*)(args.ws + WS_WOUTT), DM, DM, DM};
        g8::StaticOrder S; S.init(T / 256, DM / 256, G, bx);
        g8::EpiResid E{(const float*)args.in[0], (h16*)(args.ws + WS_X1H), (float*)(args.ws + WS_SSQ)};
        g8::gemm_phase<g8::PlainProb, g8::EpiResid, g8::StaticOrder, true>(lds, p, S, E);
        if (BOTH(PH_OUT) || rep + 1 < REPS(PH_OUT)) xcd_barrier(bar);
    }
    if (IN(PH_ROUTE)) {
        for (int blk = bx; blk < T / 64; blk += G)
            rt::route_block(lds, (const h16*)(args.ws + WS_X1H), (const h16*)(args.ws + WS_WRT16), (const float*)(args.ws + WS_SSQ), (const float*)args.in[18], (const float*)args.in[20],
                            (float*)(args.ws + WS_RS2), (int*)(args.ws + WS_TOKE), (int*)(args.ws + WS_TOKP), (float*)(args.ws + WS_TOKW), (int*)(args.ws + WS_ETOK), (float*)(args.ws + WS_ESC), (int*)(ctl + CW_CNT), blk * 64);
        if (BOTH(PH_ROUTE)) xcd_barrier(bar);
    }
    volatile LAS int* GT = (volatile LAS int*)(lds + MISC_OFF + 128);
    if (IN(PH_UP) || IN(PH_DOWN) || IN(PH_FIN)) {
        if (tid == 0) { int tp = 0, rb = 0; for (int e = 0; e < NEXP; ++e) { const int n = __hip_atomic_load((int*)(ctl + CW_CNT) + e, __ATOMIC_RELAXED, __HIP_MEMORY_SCOPE_AGENT); const int t = (n + 255) >> 8;
            GT[e] = tp; GT[64 + e] = rb; GT[128 + e] = n; tp += t; rb += t * 256; } GT[32] = tp; GT[64 + 32] = rb;
            int pf = 0, np = 0; for (int e = 0; e < NEXP; ++e) { const int n = GT[128 + e]; GT[192 + e] = pf; pf += n >> 8; if (n & 255) { GT[232 + np] = e; ++np; } } GT[192 + 32] = pf; }
        __syncthreads();
    }
    if (IN(PH_UP)) for (int rep = 0; rep < REPS(PH_UP); ++rep) {
        g8::GatherProb p{(const h16*)(args.ws + WS_X1H), (const h16*)(args.ws + WS_WGUT), (const int*)(args.ws + WS_ETOK), GT, DM, DM, DM};
        g8::DynGroupSched S{GT, 2, ctl + CW_MOEQ, MISC + 20};
        g8::EpiHid E{(const float*)(args.ws + WS_ESC), GT, (h16*)(args.ws + WS_HID), ctl + CW_DONE};
        g8::gemm_phase<g8::GatherProb, g8::EpiHid, g8::DynGroupSched, true, true>(lds, p, S, E);
        if (!IN(PH_DOWN)) { if (BOTH(PH_UP) || rep + 1 < REPS(PH_UP)) xcd_barrier(bar); }
        else __syncthreads();
    }
    if (IN(PH_DOWN)) for (int rep = 0; rep < REPS(PH_DOWN); ++rep) {
        g8::SlotProb p{(const h16*)(args.ws + WS_HID), (const h16*)(args.ws + WS_WDT), GT, DEXP, DEXP, DEXP};
        g8::DynGroupSchedDep S{{GT, 4, ctl + CW_MOEQ + 64, MISC + 22}, ctl + CW_DONE, 16u};
        g8::EpiY E{GT, (h16*)(args.ws + WS_Y)};
        g8::gemm_phase<g8::SlotProb, g8::EpiY, g8::DynGroupSchedDep, true, true>(lds, p, S, E);
        if (BOTH(PH_DOWN) || rep + 1 < REPS(PH_DOWN)) xcd_barrier(bar);
    }
    if (IN(PH_FIN)) {
        const h16* X1H = (const h16*)(args.ws + WS_X1H); const h16* Y = (const h16*)(args.ws + WS_Y);
        const int* TOKE = (const int*)(args.ws + WS_TOKE); const int* TOKP = (const int*)(args.ws + WS_TOKP);
        typedef _Float16 h8 __attribute__((ext_vector_type(8)));
        for (int q0 = 0; gw + NGW * q0 < T; q0 += 8) {
        int myslot = 0;
        { const int q = lane >> 1, r = lane & 1, m = gw + NGW * (q0 + q); if (lane < 16 && m < T) myslot = GT[64 + TOKE[m * 2 + r]] + TOKP[m * 2 + r]; }
        for (int q = 0; q < 8; q += 2) {
            const int mA = gw + NGW * (q0 + q), mB = mA + NGW; if (mA >= T) break;
            const bool hasB = mB < T;
            const int sA0 = __shfl(myslot, 2 * q), sA1 = __shfl(myslot, 2 * q + 1), sB0 = __shfl(myslot, 2 * q + 2), sB1 = __shfl(myslot, 2 * q + 3);
            h8 a[2][2], y0[2][2], y1[2][2];
#pragma unroll
            for (int j = 0; j < 2; ++j) { const int c = j * 512 + lane * 8;
                a[0][j] = *(const h8*)(X1H + (size_t)mA * DM + c); y0[0][j] = *(const h8*)(Y + (size_t)sA0 * DM + c); y1[0][j] = *(const h8*)(Y + (size_t)sA1 * DM + c);
                a[1][j] = *(const h8*)(X1H + (size_t)(hasB ? mB : mA) * DM + c); y0[1][j] = *(const h8*)(Y + (size_t)(hasB ? sB0 : sA0) * DM + c); y1[1][j] = *(const h8*)(Y + (size_t)(hasB ? sB1 : sA1) * DM + c); }
#pragma unroll
            for (int t2 = 0; t2 < 2; ++t2) { if (t2 == 1 && !hasB) break; const int m = t2 ? mB : mA;
#pragma unroll
                for (int j = 0; j < 2; ++j) { const int c = j * 512 + lane * 8; f32x4 o0, o1;
#pragma unroll
                    for (int k = 0; k < 4; ++k) { o0[k] = (float)a[t2][j][k] + ((float)y0[t2][j][k] + (float)y1[t2][j][k]); o1[k] = (float)a[t2][j][4 + k] + ((float)y0[t2][j][4 + k] + (float)y1[t2][j][4 + k]); }
                    *(f32x4*)(args.out + (size_t)m * DM + c) = o0; *(f32x4*)(args.out + (size_t)m * DM + c + 4) = o1; } }
        }
        }
    }
#undef IN
#undef BOTH
#undef REPS
}

extern "C" void kernel_launch(void* const* d_in, const int* in_sizes, int n_in, void* d_out, int out_size, void* d_ws, size_t ws_size, hipStream_t stream) {
    if (n_in != 24 || out_size != T * DM || ws_size < WS_END) { fprintf(stderr, "kernel_launch: unexpected shapes (n_in %d out %d ws %zu)\n", n_in, out_size, ws_size); return; }
    static int grid = 0;
    if (grid == 0) {
        int dev = 0, cus = 0;
        if (hipGetDevice(&dev) != hipSuccess || hipDeviceGetAttribute(&cus, hipDeviceAttributeMultiprocessorCount, dev) != hipSuccess) { fprintf(stderr, "kernel_launch: device query failed\n"); grid = -1; return; }
        if (hipFuncSetAttribute((const void*)mega_fwd, hipFuncAttributeMaxDynamicSharedMemorySize, LDS_BYTES) != hipSuccess) { fprintf(stderr, "kernel_launch: hipFuncSetAttribute failed\n"); grid = -1; return; }
        int per_cu = 0; (void)hipOccupancyMaxActiveBlocksPerMultiprocessor(&per_cu, (const void*)mega_fwd, NTHREADS, LDS_BYTES); (void)hipGetLastError();
        if (per_cu < 1) fprintf(stderr, "kernel_launch: note: occupancy query reports %d\n", per_cu);
        grid = cus;
    }
    if (grid < 0) return;
    char* ws = (char*)d_ws; float* out = (float*)d_out;
    (void)hipMemsetAsync(ws + WS_CTL, 0, CTL_ZERO_BYTES, stream);
    MArgs a{};
    for (int i = 0; i < 24; ++i) a.in[i] = d_in[i];
    a.out = out; a.ws = (unsigned char*)d_ws; a.ph_lo = 0; a.ph_hi = PH_END; a.li = 0;
    hipLaunchKernelGGL(mega_fwd, dim3(grid), dim3(NTHREADS), LDS_BYTES, stream, a);
}
```

```cpp
#include <hip/hip_runtime.h>
#include <cstdio>
#include <cstdint>

typedef _Float16 h16;

constexpr int BATCH = 8, SEQ = 2048, T = BATCH * SEQ, DM = 1024;
constexpr int NPROJ = 2048;
constexpr int PC_Q = 0, PC_K = 256, PC_V = 512, PC_GATE = 1024, PC_MQA = 1536, PC_MKVA = 1792, PC_KROPE = 1920, PC_LRF = 1952, PC_LRB = 1968;
constexpr int NEXP = 32, DEXP = 256;
constexpr int ECAP = 16384;
constexpr int SLOT_ROWS = 32768 + 32 * 256;
constexpr float EPS = 1e-6f;

constexpr size_t MiB = 1u << 20;
constexpr size_t WS_CTL = 0;
constexpr size_t WS_WINT = 1 * MiB;
constexpr size_t WS_WQBT = 5 * MiB;
constexpr size_t WS_WKVBT = 5 * MiB + 512 * 1024;
constexpr size_t WS_WOUTT = 6 * MiB;
constexpr size_t WS_WGUT = 8 * MiB;
constexpr size_t WS_WDT = 40 * MiB;
constexpr size_t WS_ROUTE = 56 * MiB;
constexpr size_t WS_RS2 = WS_ROUTE + 256 * 1024;
constexpr size_t WS_TOKE = WS_RS2 + 64 * 1024;
constexpr size_t WS_TOKP = WS_TOKE + 128 * 1024;
constexpr size_t WS_TOKW = WS_TOKP + 128 * 1024;
constexpr size_t WS_ETOK = WS_ROUTE + 1 * MiB;
constexpr size_t WS_A = 60 * MiB;
constexpr size_t WS_H1 = WS_A, WS_PROJ = WS_A + 32 * MiB, WS_MIX = WS_A, WS_Y = WS_A;
constexpr size_t WS_B = 156 * MiB;
constexpr size_t WS_QF = WS_B, WS_KF = WS_B + 24 * MiB, WS_VF = WS_B + 48 * MiB, WS_HID = WS_B;
constexpr size_t WS_OGLA = 220 * MiB;
constexpr size_t WS_X1H = WS_OGLA;
constexpr size_t WS_WRT16 = WS_ROUTE + 3 * MiB;
constexpr size_t WS_SSQ = 254 * MiB;
constexpr size_t WS_ESC = 200 * MiB;
constexpr size_t WS_CS = 252 * MiB;
constexpr size_t WS_END = 256 * MiB;

__device__ __forceinline__ int win_src_col(int n) {
    if (n < 1536) return n;
    if (n < 1792) return 1568 + (n - 1536);
    if (n < 1920) return 1824 + (n - 1792);
    if (n < 1952) return 1952 + (n - 1920);
    if (n < 1968) return 1536 + (n - 1952);
    if (n < 1984) return 1552 + (n - 1968);
    return -1;
}

#define LAS __attribute__((address_space(3)))
#define GAS __attribute__((address_space(1)))
typedef unsigned u32x4 __attribute__((ext_vector_type(4)));
typedef float f32x4 __attribute__((ext_vector_type(4)));
#define LDS_WAIT() asm volatile("s_waitcnt lgkmcnt(0)" ::: "memory")
#define VM_WAIT() asm volatile("s_waitcnt vmcnt(0)" ::: "memory")
constexpr int NWAVES = 8, NTHREADS = 512;
constexpr int RING_BYTES = 131072, MISC_OFF = RING_BYTES + 320, LDS_BYTES = 147456;
constexpr int CW_CNT = 0;
constexpr int CW_BAR = 4096;
constexpr int CW_GLADONE = 10240;
constexpr int CW_Q = 12288;
constexpr size_t CTL_ZERO_BYTES = 131072;
constexpr int CW_MOEQ = 14336;
constexpr int CW_DONE = 16384;
constexpr int PH_MIX = 3, PH_COMB = 4, PH_OUT = 5, PH_ROUTE = 6, PH_UP = 7, PH_DOWN = 8, PH_FIN = 9, PH_END = 10;

__device__ __forceinline__ unsigned pk_h2(float a, float b) { typedef _Float16 h2 __attribute__((ext_vector_type(2))); h2 v = {(h16)a, (h16)b}; return __builtin_bit_cast(unsigned, v); }

#define XB_TMO      128
#define XB_XCNT(j)  (256  + 64 * (j))
#define XB_XSUB(j)  (1280 + 64 * (j))
#define XB_XGEN(j)  (2304 + 64 * (j))
#define XB_TOP      3328
#define XB_TOPGEN   3392
#define XCD_BAR_WORDS 3456
#define XB_SPIN_CAP (1u << 18)
__device__ __forceinline__ unsigned xb_ld(unsigned* p)              { return __hip_atomic_load(p, __ATOMIC_RELAXED, __HIP_MEMORY_SCOPE_AGENT); }
__device__ __forceinline__ unsigned xb_add(unsigned* p, unsigned v) { return __hip_atomic_fetch_add(p, v, __ATOMIC_RELAXED, __HIP_MEMORY_SCOPE_AGENT); }
__device__ __forceinline__ unsigned xb_xcc_id() { return (unsigned)__builtin_amdgcn_s_getreg((3 << 11) | 20) & 0xFu; }
#define XB_SPIN(cond, bar) do { unsigned _sp = 0; while (cond) { __builtin_amdgcn_s_sleep(1); \
    if ((++_sp & 255u) == 0u) { if (xb_ld(&(bar)[XB_TMO])) break; if (_sp > XB_SPIN_CAP) { atomicAdd(&(bar)[XB_TMO], 1u); break; } } } } while (0)
struct XcdBarrier { unsigned* bar; unsigned x; volatile LAS unsigned* st; };
__device__ __forceinline__ XcdBarrier xcd_barrier_post(unsigned* bar, volatile LAS unsigned* st) {
    XcdBarrier b; b.bar = bar; b.x = xb_xcc_id(); b.st = st;
    if (threadIdx.x == 0) (void)xb_add(&bar[XB_XCNT(b.x)], 1u);
    return b;
}
__device__ __forceinline__ void xcd_barrier_complete(unsigned* bar, unsigned x, unsigned& nloc, unsigned& nx) {
    const unsigned G = gridDim.x * gridDim.y * gridDim.z;
    unsigned sum, cnt, mine, sp = 0u;
    for (;;) {
        sum = 0u; cnt = 0u; mine = 0u;
#pragma unroll
        for (unsigned j = 0; j < 16; ++j) { const unsigned c = xb_ld(&bar[XB_XCNT(j)]); sum += c; cnt += (c > 0u) ? 1u : 0u; mine = (j == x) ? c : mine; }
        if (sum == G) break;
        __builtin_amdgcn_s_sleep(1);
        if ((++sp & 255u) == 0u) { if (xb_ld(&bar[XB_TMO])) break; if (sp > XB_SPIN_CAP) { atomicAdd(&bar[XB_TMO], 1u); break; } }
    }
    nloc = mine > 0u ? mine : 1u; nx = cnt > 0u ? cnt : 1u;
}
__device__ __forceinline__ void xcd_barrier(const XcdBarrier& b) {
    asm volatile("s_waitcnt vmcnt(0)" ::: "memory");
    __syncthreads();
    if (threadIdx.x == 0) {
        unsigned* bar = b.bar;
        __builtin_amdgcn_s_waitcnt(0);
        unsigned nloc = b.st[0], nx = b.st[1];
        if (nloc == 0u) { xcd_barrier_complete(bar, b.x, nloc, nx); b.st[0] = nloc; b.st[1] = nx; }
        const unsigned old = xb_add(&bar[XB_XSUB(b.x)], 1u);
        const unsigned gen = old / nloc;
        if (old + 1u == (gen + 1u) * nloc) {
            __builtin_amdgcn_fence(__ATOMIC_RELEASE, "agent");
            asm volatile("s_waitcnt vmcnt(0)" ::: "memory");
            const unsigned og = xb_add(&bar[XB_TOP], 1u);
            const unsigned tg = og / nx;
            if (og + 1u == (tg + 1u) * nx) xb_add(&bar[XB_TOPGEN], 1u);
            else XB_SPIN(xb_ld(&bar[XB_TOPGEN]) == tg, bar);
            __builtin_amdgcn_fence(__ATOMIC_ACQUIRE, "agent");
            xb_add(&bar[XB_XGEN(b.x)], 1u);
            asm volatile("s_waitcnt vmcnt(0)" ::: "memory");
        } else {
            XB_SPIN(xb_ld(&bar[XB_XGEN(b.x)]) == gen, bar);
            __builtin_amdgcn_fence(__ATOMIC_ACQUIRE, "agent");
            asm volatile("s_waitcnt vmcnt(0)" ::: "memory");
        }
    }
    __syncthreads();
}

template <int NBATCH>
__device__ __forceinline__ void tr_item(const float* __restrict__ src, int src_ld, int k0, int c0, h16* __restrict__ dst, int dst_ld, long row0, int rstride,
                                        const float* __restrict__ kg, float scale, LAS float* scr, int lane) {
#pragma unroll
    for (int bt = 0; bt < 32 / NBATCH; ++bt) {
        float tv[NBATCH];
#pragma unroll
        for (int i = 0; i < NBATCH; ++i) { const int kk = 2 * (bt * NBATCH + i) + (lane >> 5); tv[i] = src[(size_t)(k0 + kk) * src_ld + c0 + (lane & 31)]; }
#pragma unroll
        for (int i = 0; i < NBATCH; ++i) { const int kk = 2 * (bt * NBATCH + i) + (lane >> 5); float v = tv[i] * scale; if (kg) v *= kg[k0 + kk]; scr[kk * 33 + (lane & 31)] = v; }
    }
    LDS_WAIT(); asm volatile("" ::: "memory");
    const int c = lane & 7;
#pragma unroll
    for (int j = 0; j < 4; ++j) { const int n = (lane >> 3) + 8 * j; const LAS float* s = scr + (8 * c) * 33 + n;
        u32x4 o; o.x = pk_h2(s[0 * 33], s[1 * 33]); o.y = pk_h2(s[2 * 33], s[3 * 33]); o.z = pk_h2(s[4 * 33], s[5 * 33]); o.w = pk_h2(s[6 * 33], s[7 * 33]);
        *(u32x4*)(dst + (size_t)(row0 + (long)n * rstride) * dst_ld + k0 + 8 * c) = o; }
    LDS_WAIT(); asm volatile("" ::: "memory");
}
struct TrP { const float* src; int src_ld, k0, c0; h16* dst; int dst_ld; long row0; int rstride; const float* kg; };
__device__ __forceinline__ void tr_load(const TrP& p, float (&tv)[32], int lane) {
#pragma unroll
    for (int i = 0; i < 32; ++i) { const int kk = 2 * i + (lane >> 5); tv[i] = p.src[(size_t)(p.k0 + kk) * p.src_ld + p.c0 + (lane & 31)]; }
}
__device__ __forceinline__ void tr_finish(const TrP& p, const float (&tv)[32], LAS float* scr, int lane) {
#pragma unroll
    for (int i = 0; i < 32; ++i) { const int kk = 2 * i + (lane >> 5); float v = tv[i]; if (p.kg) v *= p.kg[p.k0 + kk]; scr[kk * 33 + (lane & 31)] = v; }
    LDS_WAIT(); asm volatile("" ::: "memory");
    const int c = lane & 7;
#pragma unroll
    for (int j = 0; j < 4; ++j) { const int n = (lane >> 3) + 8 * j; const LAS float* s = scr + (8 * c) * 33 + n;
        u32x4 o; o.x = pk_h2(s[0 * 33], s[1 * 33]); o.y = pk_h2(s[2 * 33], s[3 * 33]); o.z = pk_h2(s[4 * 33], s[5 * 33]); o.w = pk_h2(s[6 * 33], s[7 * 33]);
        *(u32x4*)(p.dst + (size_t)(p.row0 + (long)n * p.rstride) * p.dst_ld + p.k0 + 8 * c) = o; }
    LDS_WAIT(); asm volatile("" ::: "memory");
}
__device__ __forceinline__ float wave_sum(float v) {
#pragma unroll
    for (int o = 1; o < 64; o <<= 1) v += __shfl_xor(v, o);
    return v;
}
struct MArgs { const void* in[24]; float* out; unsigned char* ws; int ph_lo, ph_hi, li, pad; };

__device__ __forceinline__ TrP expert_params(const MArgs& a, int r) {
    unsigned char* ws = a.ws;
    const float* wg = (const float*)a.in[21]; const float* wu = (const float*)a.in[22]; const float* wd = (const float*)a.in[23]; const float* gain2 = (const float*)a.in[16];
    h16* WguT = (h16*)(ws + WS_WGUT); h16* WdT = (h16*)(ws + WS_WDT);
    if (r < 8192) { const int e = r >> 8, sx = (r >> 7) & 1, kb = (r >> 3) & 15, nb = r & 7;
        return TrP{(sx ? wu : wg) + (size_t)e * 1024 * 256, 256, 64 * kb, 32 * nb, WguT, 1024, (long)e * 512 + 64 * nb + sx, 2, gain2}; }
    r -= 8192; const int e = r >> 7, kb = (r >> 5) & 3, nb = r & 31;
    return TrP{wd + (size_t)e * 256 * 1024, 1024, 64 * kb, 32 * nb, WdT, 256, (long)e * 1024 + 32 * nb, 1, nullptr};
}
__device__ __forceinline__ void expert_items4(const MArgs& a, int r0, LAS float* scr, int lane) {
    float ta[32], tb[32];
    const TrP p0 = expert_params(a, r0), p1 = expert_params(a, r0 + 1), p2 = expert_params(a, r0 + 2), p3 = expert_params(a, r0 + 3);
    tr_load(p0, ta, lane); tr_load(p1, tb, lane);
    tr_finish(p0, ta, scr, lane); tr_load(p2, ta, lane);
    tr_finish(p1, tb, scr, lane); tr_load(p3, tb, lane);
    tr_finish(p2, ta, scr, lane); tr_finish(p3, tb, scr, lane);
}

__device__ __forceinline__ void p0_prologue(const MArgs& a, LAS unsigned char* lds, int gw, int NGW, int lane, int wave) {
    unsigned char* ws = a.ws;
    LAS float* scr = (LAS float*)(lds + wave * 16384);
    const float* w_in = (const float*)a.in[3]; const float* w_qb = (const float*)a.in[10]; const float* w_kvb = (const float*)a.in[12]; const float* w_out = (const float*)a.in[15];
    const float* wg = (const float*)a.in[21]; const float* wu = (const float*)a.in[22]; const float* wd = (const float*)a.in[23];
    const float* q_gain = (const float*)a.in[9]; const float* kv_gain = (const float*)a.in[11]; const float* gain2 = (const float*)a.in[16];
    h16* WinT = (h16*)(ws + WS_WINT); h16* WqbT = (h16*)(ws + WS_WQBT); h16* WkvbT = (h16*)(ws + WS_WKVBT); h16* WoutT = (h16*)(ws + WS_WOUTT);
    h16* WguT = (h16*)(ws + WS_WGUT); h16* WdT = (h16*)(ws + WS_WDT);
    constexpr int I_IN = 16 * 62, I_OUT = 16 * 32, I_QB = 4 * 24, I_KVB = 2 * 32;
    constexpr int NITEMS = I_IN + I_OUT + I_QB + I_KVB;
    for (int it = gw; it < NITEMS; it += NGW) {
        int r = it;
        if (r < I_IN) { const int kb = r / 62, nb = r % 62, n0 = 32 * nb;
            tr_item<32>(w_in, 1984, 64 * kb, win_src_col(n0), WinT, 1024, n0, 1, nullptr, n0 < 256 ? 0.125f : 1.f, scr, lane); continue; }
        r -= I_IN;
        if (r < I_OUT) { const int kb = r >> 5, nb = r & 31;
            tr_item<32>(w_out, 1024, 64 * kb, 32 * nb, WoutT, 1024, 32 * nb, 1, nullptr, 1.f, scr, lane); continue; }
        r -= I_OUT;
        if (r < I_QB) { const int kb = r / 24, nb = r % 24, c0 = 32 * nb, h = c0 / 96, d0 = c0 % 96;
            tr_item<32>(w_qb, 768, 64 * kb, c0, WqbT, 256, h * 128 + d0, 1, q_gain, 1.f, scr, lane); continue; }
        r -= I_QB;
        { const int kb = r >> 5, nb = r & 31;
            tr_item<32>(w_kvb, 1024, 64 * kb, 32 * nb, WkvbT, 256, 32 * nb, 1, kv_gain, 1.f, scr, lane); }
    }
    const u32x4 z4 = {0u, 0u, 0u, 0u};
    for (int i = gw; i < 128; i += NGW) *(u32x4*)((char*)(WinT + (size_t)1984 * 1024) + (size_t)i * 1024 + lane * 16) = z4;
    for (int i = gw; i < 128; i += NGW) { const int row = (i >> 4) * 128 + 96 + 2 * (i & 15) + (lane >> 5);
        *(u32x4*)((char*)(WqbT + (size_t)row * 256) + (lane & 31) * 16) = z4; }
    for (int i = gw; i < 256; i += NGW) { const int row = i * 4 + (lane >> 4);
        *(u32x4*)((char*)(WkvbT + (size_t)row * 256 + 128) + (lane & 15) * 16) = z4; }
    { const float* wrg = (const float*)a.in[17]; const float* wre = (const float*)a.in[19]; h16* W16 = (h16*)(ws + WS_WRT16);
      for (int i = gw; i < 256 * 1024 / 64; i += NGW) { const int idx = i * 64 + lane, k = idx & 1023, j = idx >> 10; float v = 0.f;
          if (j < 4) v = wrg[k * 4 + j] * gain2[k]; else if (j < 36) v = wre[k * 32 + (j - 4)] * gain2[k];
          W16[idx] = (h16)v; } }
    { const int* positions = (const int*)a.in[1]; float* CS = (float*)(ws + WS_CS);
      for (int i = gw; i < T * 16 / 64; i += NGW) { const int idx = i * 64 + lane, m = idx >> 4, fi = idx & 15;
          const float inv = exp2f(-(float)fi * (13.287712379549449f / 16.0f)); const float ang = (float)positions[m] * inv;
          CS[m * 32 + fi] = cosf(ang); CS[m * 32 + 16 + fi] = sinf(ang); } }
    { const float* x = (const float*)a.in[0]; const float* g1 = (const float*)a.in[2]; h16* H1 = (h16*)(ws + WS_H1);
      f32x4 g[4];
#pragma unroll
      for (int j = 0; j < 4; ++j) g[j] = ((const f32x4*)g1)[lane + 64 * j];
      for (int m = gw; m < T; m += 2 * NGW) {
          const int m2 = m + NGW;
          const f32x4* xr = (const f32x4*)(x + (size_t)m * DM) + lane; const f32x4* xr2 = (const f32x4*)(x + (size_t)(m2 < T ? m2 : m) * DM) + lane;
          f32x4 v[4], v2[4]; float s = 0.f, s2 = 0.f;
#pragma unroll
          for (int j = 0; j < 4; ++j) { v[j] = xr[64 * j]; v2[j] = xr2[64 * j]; }
#pragma unroll
          for (int j = 0; j < 4; ++j) { s += (v[j].x * v[j].x + v[j].y * v[j].y) + (v[j].z * v[j].z + v[j].w * v[j].w); s2 += (v2[j].x * v2[j].x + v2[j].y * v2[j].y) + (v2[j].z * v2[j].z + v2[j].w * v2[j].w); }
          const float rs = rsqrtf(wave_sum(s) * (1.f / DM) + EPS), rs2 = rsqrtf(wave_sum(s2) * (1.f / DM) + EPS);
          unsigned long long* o8 = (unsigned long long*)(H1 + (size_t)m * DM) + lane;
#pragma unroll
          for (int j = 0; j < 4; ++j) o8[64 * j] = (unsigned long long)pk_h2(v[j].x * rs * g[j].x, v[j].y * rs * g[j].y) | ((unsigned long long)pk_h2(v[j].z * rs * g[j].z, v[j].w * rs * g[j].w) << 32);
          if (m2 < T) { unsigned long long* p8 = (unsigned long long*)(H1 + (size_t)m2 * DM) + lane;
#pragma unroll
              for (int j = 0; j < 4; ++j) p8[64 * j] = (unsigned long long)pk_h2(v2[j].x * rs2 * g[j].x, v2[j].y * rs2 * g[j].y) | ((unsigned long long)pk_h2(v2[j].z * rs2 * g[j].z, v2[j].w * rs2 * g[j].w) << 32); }
      } }
}

namespace g8 {
typedef _Float16 f16x8 __attribute__((ext_vector_type(8)));
constexpr int BM = 256, BK = 64, HALF = 128, HTB = HALF * BK * 2, STAGE_BYTES = 8 * HTB, NXCD = 8, WGM = 8;
__host__ __device__ __forceinline__ int lds_byte(int r, int c) { const int st = (r >> 4) * 2 + (c >> 5), rr = r & 15, cc = c & 31, ob = rr * 64 + cc * 2; return st * 1024 + (ob ^ (((ob >> 9) & 1) << 5)); }
__host__ __device__ __forceinline__ void stage_rc(int b, int& R, int& C) { const int st = b / 1024, sb = b % 1024, swz = sb ^ (((sb >> 9) & 1) << 5); R = (st >> 1) * 16 + swz / 64; C = (st & 1) * 32 + (swz % 64) / 2; }
__host__ __device__ __forceinline__ int perm32(int rho) { const int n = rho >> 4, i = rho & 15; return 8 * (i >> 2) + 4 * n + (i & 3); }
struct Unit { int pm, pn, e, half; };
struct StaticOrder {
    int nM, nN, nwg, G, c;
    __device__ __forceinline__ void init(int nM_, int nN_, int G_, int c_) { nM = nM_; nN = nN_; nwg = nM * nN; G = G_; c = c_; }
    __device__ __forceinline__ bool next(int i, Unit& u) const {
        const long L = (long)i * G + c; if (L >= nwg) return false;
        int wgid = (int)L; { const int q = nwg / NXCD, r = nwg % NXCD, xcd = wgid % NXCD, off = wgid / NXCD; wgid = (xcd < r ? xcd * (q + 1) : r * (q + 1) + (xcd - r) * q) + off; }
        const int nig = WGM * nN, gid = wgid / nig, fm = gid * WGM, gsz = (nM - fm) < WGM ? (nM - fm) : WGM;
        u.pm = fm + ((wgid % nig) % gsz); u.pn = (wgid % nig) / gsz; u.e = 0; u.half = 0; return true;
    }
    __device__ __forceinline__ void a_ready(const Unit&) const {}
};
struct PlainProb {
    const h16* A; const h16* Bt; int lda, ldb, K;
    __device__ __forceinline__ const char* a_base() const { return (const char*)A; }
    __device__ __forceinline__ unsigned a_row_off(const Unit& u, int h, int R) const { return (unsigned)((u.pm * BM + h * HALF + R) * lda); }
    __device__ __forceinline__ const char* b_base(const Unit& u) const { return (const char*)(Bt + (size_t)u.pn * BM * ldb); }
};

template <class P, class Epi, class Sched, bool ALIGN_EPI, bool HALFSKIP = false>
__device__ __forceinline__ void gemm_phase(LAS unsigned char* lds, const P& p, const Sched& S, const Epi& E) {
    const int tid = threadIdx.x, wid = __builtin_amdgcn_readfirstlane(tid >> 6), lane = tid & 63, wr = wid >> 2, wc = wid & 3, fr = lane & 15, fq = lane >> 4;
    const int K = p.K, nt = K / BK;
    int Rs[2], Cs[2]; unsigned voffB[2];
#pragma unroll
    for (int i = 0; i < 2; ++i) { int R, C; stage_rc(tid * 16 + i * 8192, R, C); Rs[i] = R; Cs[i] = C; const int Rb = Epi::PERM ? ((R & ~31) + perm32(R & 31)) : R; voffB[i] = (unsigned)(Rb * p.ldb + C) * 2u; }
    const size_t kstep = (size_t)(BK * 2);
    const size_t hstepB = (size_t)HALF * p.ldb * 2;
    const unsigned ldsw = (unsigned)wid * 1024u;
    const int aoff = lds_byte(wr * 64 + fr, fq * 8), boff = lds_byte(wc * 32 + fr, fq * 8);
#define G8_SA(b, h) (((b) * 2 + (h)) * HTB)
#define G8_SB(b, h) ((4 + (b) * 2 + (h)) * HTB)
#define G8_STAGE(bufoff, gbase, voff) do { _Pragma("unroll") for (int _i = 0; _i < 2; ++_i) \
        __builtin_amdgcn_global_load_lds((const unsigned*)((const char*)(gbase) + (voff)[_i]), (LAS unsigned*)(lds + (bufoff) + ldsw + _i * 8192), 16, 0, 0); } while (0)
#define G8_LDA(dst, b, h) do { _Pragma("unroll") for (int m = 0; m < 4; ++m) _Pragma("unroll") for (int k = 0; k < 2; ++k) dst[m][k] = *(const LAS f16x8*)(lds + G8_SA(b, h) + aoff + m * 2048 + k * 1024); } while (0)
#define G8_LDB(dst, b, h) do { _Pragma("unroll") for (int n = 0; n < 2; ++n) _Pragma("unroll") for (int k = 0; k < 2; ++k) dst[n][k] = *(const LAS f16x8*)(lds + G8_SB(b, h) + boff + n * 2048 + k * 1024); } while (0)
#define G8_MMA(ai, bj, At, Bt) do { __builtin_amdgcn_s_setprio(1); _Pragma("unroll") for (int m = 0; m < 4; ++m) _Pragma("unroll") for (int n = 0; n < 2; ++n) _Pragma("unroll") for (int k = 0; k < 2; ++k) \
        acc[ai][bj][m][n] = __builtin_amdgcn_mfma_f32_16x16x32_f16(Bt[n][k], At[m][k], acc[ai][bj][m][n], 0, 0, 0); __builtin_amdgcn_s_setprio(0); } while (0)
#define G8_WAIT_V(n) asm volatile("s_waitcnt vmcnt(" #n ")" ::: "memory")
#define G8_WAIT_L(n) asm volatile("s_waitcnt lgkmcnt(" #n ")" ::: "memory")
#define G8_BAR __builtin_amdgcn_s_barrier()
#define G8_SCHED __builtin_amdgcn_sched_barrier(0)
    Unit cur, nxt; int ui = 0;
    if (!S.next(0, cur)) return;
    f32x4 acc[2][2][4][2];
#pragma unroll
    for (int a = 0; a < 2; ++a)
#pragma unroll
        for (int b = 0; b < 2; ++b)
#pragma unroll
            for (int m = 0; m < 4; ++m)
#pragma unroll
                for (int n = 0; n < 2; ++n) acc[a][b][m][n] = (f32x4){0.f, 0.f, 0.f, 0.f};
    f16x8 At[4][2], B0[2][2], B1[2][2];
    const char* const A0 = p.a_base();
    unsigned vAc[2][2], vAn[2][2];
#pragma unroll
    for (int h = 0; h < 2; ++h)
#pragma unroll
        for (int i = 0; i < 2; ++i) vAc[h][i] = (p.a_row_off(cur, h, Rs[i]) + (unsigned)Cs[i]) * 2u;
    const char* cB = p.b_base(cur);
    S.a_ready(cur);
    G8_STAGE(G8_SB(0, 0), cB, voffB); G8_STAGE(G8_SB(0, 1), cB + hstepB, voffB); G8_STAGE(G8_SA(0, 0), A0, vAc[0]); G8_STAGE(G8_SA(0, 1), A0, vAc[1]);
    if (wr == 1) G8_BAR;
    G8_WAIT_V(2); G8_BAR;
    G8_STAGE(G8_SB(1, 0), cB + kstep, voffB); G8_STAGE(G8_SA(1, 0), A0 + kstep, vAc[0]); G8_STAGE(G8_SB(1, 1), cB + hstepB + kstep, voffB);
    G8_WAIT_V(6); G8_BAR;
    for (;;) {
        const bool has_next = S.next(ui + 1, nxt);
        if (has_next) {
#pragma unroll
            for (int h = 0; h < 2; ++h)
#pragma unroll
                for (int i = 0; i < 2; ++i) vAn[h][i] = (p.a_row_off(nxt, h, Rs[i]) + (unsigned)Cs[i]) * 2u;
        } else {
#pragma unroll
            for (int h = 0; h < 2; ++h)
#pragma unroll
                for (int i = 0; i < 2; ++i) vAn[h][i] = vAc[h][i];
        }
        const char* nB = has_next ? p.b_base(nxt) : cB;
        const bool skip1 = HALFSKIP && cur.half != 0;
        for (int t = 0; t < nt; t += 2) {
            const bool last = (t == nt - 2);
            if (last && has_next) S.a_ready(nxt);
            const char* a1 = A0 + (size_t)(t + 1) * kstep;
            const char* a2 = last ? A0 : A0 + (size_t)(t + 2) * kstep; const char* b2 = last ? nB : cB + (size_t)(t + 2) * kstep;
            const char* a3 = a2 + kstep; const char* b3 = b2 + kstep;
            unsigned v2[2][2];
#pragma unroll
            for (int h = 0; h < 2; ++h)
#pragma unroll
                for (int i = 0; i < 2; ++i) v2[h][i] = last ? vAn[h][i] : vAc[h][i];
            G8_LDB(B0, 0, 0); G8_LDB(B1, 0, 1); G8_SCHED; G8_LDA(At, 0, 0); G8_STAGE(G8_SA(1, 1), a1, vAc[1]);
            G8_WAIT_V(8); G8_WAIT_L(0); G8_BAR; G8_MMA(0, 0, At, B0); G8_MMA(0, 1, At, B1); G8_BAR; G8_SCHED;
            if (!skip1) G8_LDA(At, 0, 1); G8_STAGE(G8_SB(0, 0), b2, voffB); G8_STAGE(G8_SB(0, 1), b2 + hstepB, voffB); G8_STAGE(G8_SA(0, 0), a2, v2[0]);
            G8_WAIT_V(8); G8_WAIT_L(0); G8_BAR; if (!skip1) { G8_MMA(1, 0, At, B0); G8_MMA(1, 1, At, B1); } G8_BAR; G8_SCHED;
            G8_LDB(B0, 1, 0); G8_LDB(B1, 1, 1); G8_SCHED; G8_LDA(At, 1, 0); G8_STAGE(G8_SA(0, 1), a2, v2[1]);
            G8_WAIT_V(8); G8_WAIT_L(0); G8_BAR; G8_MMA(0, 0, At, B0); G8_MMA(0, 1, At, B1); G8_BAR; G8_SCHED;
            if (!skip1) G8_LDA(At, 1, 1); G8_STAGE(G8_SB(1, 0), b3, voffB); G8_STAGE(G8_SB(1, 1), b3 + hstepB, voffB); G8_STAGE(G8_SA(1, 0), a3, v2[0]);
            G8_WAIT_V(8); G8_WAIT_L(0); G8_BAR; if (!skip1) { G8_MMA(1, 0, At, B0); G8_MMA(1, 1, At, B1); } G8_BAR; G8_SCHED;
        }
        if constexpr (ALIGN_EPI) { if (wr == 0) G8_BAR; }
        if constexpr (!Epi::AFTER_DRAIN) { E(acc, cur, wr, wc, fr, fq); }
        if (!has_next) break;
#pragma unroll
        for (int a = 0; a < 2; ++a)
#pragma unroll
            for (int b = 0; b < 2; ++b)
#pragma unroll
                for (int m = 0; m < 4; ++m)
#pragma unroll
                    for (int n = 0; n < 2; ++n) acc[a][b][m][n] = (f32x4){0.f, 0.f, 0.f, 0.f};
        cur = nxt; cB = nB; ++ui;
#pragma unroll
        for (int h = 0; h < 2; ++h)
#pragma unroll
            for (int i = 0; i < 2; ++i) vAc[h][i] = vAn[h][i];
        if constexpr (ALIGN_EPI) { if (wr == 1) G8_BAR; }
    }
    G8_WAIT_V(0);
    if constexpr (!ALIGN_EPI) { if (wr == 0) G8_BAR; }
    G8_BAR;
    if constexpr (Epi::AFTER_DRAIN) { E.fused(acc, cur, wr, wc, fr, fq, lds, wid, lane); }
#undef G8_SA
#undef G8_SB
#undef G8_STAGE
#undef G8_LDA
#undef G8_LDB
#undef G8_MMA
#undef G8_WAIT_V
#undef G8_WAIT_L
#undef G8_BAR
#undef G8_SCHED
}
struct EpiH16 {
    static constexpr bool PERM = true, AFTER_DRAIN = false;
    h16* O; int ldc;
    __device__ __forceinline__ void operator()(const f32x4 (&acc)[2][2][4][2], const Unit& u, int wr, int wc, int fr, int fq) const {
        const int row0 = u.pm * BM + wr * 64 + fr, col0 = u.pn * BM + wc * 32 + 8 * fq;
#pragma unroll
        for (int ai = 0; ai < 2; ++ai)
#pragma unroll
            for (int m = 0; m < 4; ++m) { h16* rowp = O + (size_t)(row0 + ai * HALF + m * 16) * ldc + col0;
#pragma unroll
                for (int bj = 0; bj < 2; ++bj) { const f32x4 v0 = acc[ai][bj][m][0], v1 = acc[ai][bj][m][1];
                    u32x4 w; w.x = pk_h2(v0[0], v0[1]); w.y = pk_h2(v0[2], v0[3]); w.z = pk_h2(v1[0], v1[1]); w.w = pk_h2(v1[2], v1[3]);
                    *(u32x4*)(rowp + bj * HALF) = w; } }
    }
};
struct OneUnit { Unit u; __device__ __forceinline__ bool next(int i, Unit& o) const { if (i) return false; o = u; return true; } __device__ __forceinline__ void a_ready(const Unit&) const {} };
typedef unsigned u32x2 __attribute__((ext_vector_type(2)));
__device__ __forceinline__ float ssq8(const u32x4 w) {
    typedef _Float16 h2 __attribute__((ext_vector_type(2))); float s = 0.f;
#pragma unroll
    for (int i = 0; i < 4; ++i) { const unsigned ui = w[i]; const h2 v = __builtin_bit_cast(h2, ui); const float a = (float)v.x, b = (float)v.y; s += a * a + b * b; }
    return s;
}
struct EpiQ {
    static constexpr bool PERM = false, AFTER_DRAIN = true;
    const h16* PROJ; const float* qn_gain; const float* CS; h16* QF;
    __device__ __forceinline__ void fused(f32x4 (&acc)[2][2][4][2], const Unit& u, int wr, int wc, int fr, int fq, LAS unsigned char* lds, int wid, int lane) const {
        LAS float* P = (LAS float*)lds;
        LAS float* RS = (LAS float*)(lds + 8192);
        const int tid = wid * 64 + lane;
#pragma unroll
        for (int ai = 0; ai < 2; ++ai)
#pragma unroll
            for (int m = 0; m < 4; ++m)
#pragma unroll
                for (int bj = 0; bj < 2; ++bj) { float sq = 0.f;
#pragma unroll
                    for (int n = 0; n < 2; ++n) { const f32x4 x = acc[ai][bj][m][n]; sq += (x[0] * x[0] + x[1] * x[1]) + (x[2] * x[2] + x[3] * x[3]); }
                    sq += __shfl_xor(sq, 16); sq += __shfl_xor(sq, 32);
                    if (fq == 0) P[((ai * HALF + wr * 64 + m * 16 + fr) * 2 + bj) * 4 + wc] = sq; }
        { const int row = tid >> 1, half = tid & 1; const u32x4* ap = (const u32x4*)(PROJ + (size_t)(u.pm * BM + row) * NPROJ + PC_MQA + half * 128); float sq = 0.f;
#pragma unroll
          for (int i = 0; i < 16; ++i) sq += ssq8(ap[i]);
          sq += __shfl_xor(sq, 1);
          if (half == 0) RS[row] = rsqrtf(sq * (1.f / 256.f) + EPS); }
        LDS_WAIT(); __builtin_amdgcn_s_barrier(); asm volatile("" ::: "memory");
        if (wc == 3) return;
        const float QS = 0.10206207261596577f * 1.4426950408889634f;
#pragma unroll
        for (int ai = 0; ai < 2; ++ai)
#pragma unroll
            for (int m = 0; m < 4; ++m) { const int r = ai * HALF + wr * 64 + m * 16 + fr, gm = u.pm * BM + r, b = gm / SEQ, sp = gm % SEQ; const float rq = RS[r];
                f32x4 cs = {1.f, 1.f, 1.f, 1.f}, sn = {0.f, 0.f, 0.f, 0.f};
                if (wc == 2) { cs = *(const f32x4*)(CS + (size_t)gm * 32 + 4 * fq); sn = *(const f32x4*)(CS + (size_t)gm * 32 + 16 + 4 * fq); }
#pragma unroll
                for (int bj = 0; bj < 2; ++bj) { const f32x4 pp = *(const LAS f32x4*)(P + (r * 2 + bj) * 4); const float tot = (pp[0] + pp[1]) + (pp[2] + pp[3]);
                    const float sc = rq * rsqrtf(rq * rq * tot * (1.f / 96.f) + EPS) * QS;
                    const int d0 = wc * 32 + 4 * fq; const f32x4 g0 = *(const f32x4*)(qn_gain + d0), g1 = *(const f32x4*)(qn_gain + d0 + 16);
                    f32x4 v0 = acc[ai][bj][m][0] * g0 * sc, v1 = acc[ai][bj][m][1] * g1 * sc;
                    if (wc == 2) { const f32x4 t1 = v0, t2 = v1; v0 = t1 * cs - t2 * sn; v1 = t1 * sn + t2 * cs; }
                    h16* qp = QF + ((size_t)(b * 8 + u.pn * 2 + bj) * SEQ + sp) * 96 + d0;
                    u32x2 w0, w1; w0.x = pk_h2(v0[0], v0[1]); w0.y = pk_h2(v0[2], v0[3]); w1.x = pk_h2(v1[0], v1[1]); w1.y = pk_h2(v1[2], v1[3]);
                    *(u32x2*)qp = w0; *(u32x2*)(qp + 16) = w1; } }
    }
};
struct EpiKV {
    static constexpr bool PERM = false, AFTER_DRAIN = true;
    const h16* PROJ; const float* kn_gain; const float* CS; h16* KF; h16* VF;
    __device__ __forceinline__ void fused(f32x4 (&acc)[2][2][4][2], const Unit& u, int wr, int wc, int fr, int fq, LAS unsigned char* lds, int wid, int lane) const {
        LAS float* P = (LAS float*)lds;
        LAS float* RS = (LAS float*)(lds + 8192);
        LAS float* KR = (LAS float*)(lds + 8192 + 1024);
        const int tid = wid * 64 + lane;
        if (wc < 2) {
#pragma unroll
            for (int ai = 0; ai < 2; ++ai)
#pragma unroll
                for (int m = 0; m < 4; ++m)
#pragma unroll
                    for (int bj = 0; bj < 2; ++bj) { float sq = 0.f;
#pragma unroll
                        for (int n = 0; n < 2; ++n) { const f32x4 x = acc[ai][bj][m][n]; sq += (x[0] * x[0] + x[1] * x[1]) + (x[2] * x[2] + x[3] * x[3]); }
                        sq += __shfl_xor(sq, 16); sq += __shfl_xor(sq, 32);
                        if (fq == 0) P[((ai * HALF + wr * 64 + m * 16 + fr) * 2 + bj) * 2 + wc] = sq; }
        }
        { const int row = tid >> 1, half = tid & 1; const h16* rp = PROJ + (size_t)(u.pm * BM + row) * NPROJ;
          const u32x4* ap = (const u32x4*)(rp + PC_MKVA + half * 64); float sq = 0.f;
#pragma unroll
          for (int i = 0; i < 8; ++i) sq += ssq8(ap[i]);
          const u32x4* kp = (const u32x4*)(rp + PC_KROPE + half * 16); float kq = ssq8(kp[0]) + ssq8(kp[1]);
          sq += __shfl_xor(sq, 1); kq += __shfl_xor(kq, 1);
          if (half == 0) { RS[row] = rsqrtf(sq * (1.f / 128.f) + EPS); KR[row] = kq; } }
        LDS_WAIT(); __builtin_amdgcn_s_barrier(); asm volatile("" ::: "memory");
#pragma unroll
        for (int ai = 0; ai < 2; ++ai)
#pragma unroll
            for (int m = 0; m < 4; ++m) { const int r = ai * HALF + wr * 64 + m * 16 + fr, gm = u.pm * BM + r, b = gm / SEQ, sp = gm % SEQ; const float rkv = RS[r], krs = KR[r];
                if (wc < 2) {
#pragma unroll
                    for (int bj = 0; bj < 2; ++bj) { const float tot = (P[(r * 2 + bj) * 2] + P[(r * 2 + bj) * 2 + 1]) * rkv * rkv + krs;
                        const float sc = rkv * rsqrtf(tot * (1.f / 96.f) + EPS);
                        const int d0 = wc * 32 + 4 * fq; const f32x4 g0 = *(const f32x4*)(kn_gain + d0), g1 = *(const f32x4*)(kn_gain + d0 + 16);
                        const f32x4 v0 = acc[ai][bj][m][0] * g0 * sc, v1 = acc[ai][bj][m][1] * g1 * sc;
                        h16* kp = KF + ((((size_t)(b * 8 + u.pn * 2 + bj) * 32 + (sp >> 6)) * 12 + (d0 >> 3)) * 64 + (sp & 63)) * 8 + (d0 & 7);
                        u32x2 w0, w1; w0.x = pk_h2(v0[0], v0[1]); w0.y = pk_h2(v0[2], v0[3]); w1.x = pk_h2(v1[0], v1[1]); w1.y = pk_h2(v1[2], v1[3]);
                        *(u32x2*)kp = w0; *(u32x2*)(kp + 2 * 512) = w1; }
                } else {
#pragma unroll
                    for (int bj = 0; bj < 2; ++bj) { const int e0 = (wc - 2) * 32 + 4 * fq; const f32x4 v0 = acc[ai][bj][m][0] * rkv, v1 = acc[ai][bj][m][1] * rkv;
                        { int rr = r; asm volatile("" : "+v"(rr)); const int t16 = rr & 15, pos = (rr & 48) + (t16 < 4 ? t16 : t16 < 8 ? t16 + 4 : t16 < 12 ? t16 - 4 : t16);
                          LAS h16* vp = (LAS h16*)(lds + 16384) + (((bj * 4 + (rr >> 6)) * 8 + (pos >> 3)) * 64 + e0) * 8 + (pos & 7);
#pragma unroll
                          for (int j = 0; j < 4; ++j) { vp[j * 8] = (h16)v0[j]; vp[(16 + j) * 8] = (h16)v1[j]; } }
                        }
                    { const int bj = wc - 2; const float tot = (P[(r * 2 + bj) * 2] + P[(r * 2 + bj) * 2 + 1]) * rkv * rkv + krs; const float ri = rsqrtf(tot * (1.f / 96.f) + EPS);
                      typedef _Float16 h4 __attribute__((ext_vector_type(4)));
                      const h16* rp = PROJ + (size_t)gm * NPROJ + PC_KROPE + 4 * fq; const h4 a1 = *(const h4*)rp, a2 = *(const h4*)(rp + 16);
                      const f32x4 g1 = *(const f32x4*)(kn_gain + 64 + 4 * fq), g2 = *(const f32x4*)(kn_gain + 80 + 4 * fq);
                      const f32x4 cs = *(const f32x4*)(CS + (size_t)gm * 32 + 4 * fq), sn = *(const f32x4*)(CS + (size_t)gm * 32 + 16 + 4 * fq);
                      f32x4 t1, t2;
#pragma unroll
                      for (int j = 0; j < 4; ++j) { t1[j] = (float)a1[j] * ri * g1[j]; t2[j] = (float)a2[j] * ri * g2[j]; }
                      const f32x4 o1 = t1 * cs - t2 * sn, o2 = t1 * sn + t2 * cs;
                      h16* kp = KF + ((((size_t)(b * 8 + u.pn * 2 + bj) * 32 + (sp >> 6)) * 12 + ((64 + 4 * fq) >> 3)) * 64 + (sp & 63)) * 8 + ((4 * fq) & 7);
                      u32x2 w0, w1; w0.x = pk_h2(o1[0], o1[1]); w0.y = pk_h2(o1[2], o1[3]); w1.x = pk_h2(o2[0], o2[1]); w1.y = pk_h2(o2[2], o2[3]);
                      *(u32x2*)kp = w0; *(u32x2*)(kp + 2 * 512) = w1; }
                } }
        LDS_WAIT(); __builtin_amdgcn_s_barrier(); asm volatile("" ::: "memory");
        { const int b0 = (u.pm * BM) / SEQ, t0 = ((u.pm * BM) % SEQ) >> 6;
#pragma unroll
          for (int i = 0; i < 8; ++i) { const int ch = i * 512 + tid, blk = ch >> 9, off = ch & 511;
              const u32x4 v = *(const LAS u32x4*)(lds + 16384 + ch * 16);
              *(u32x4*)(VF + (((size_t)(b0 * 8 + u.pn * 2 + (blk >> 2)) * 32 + t0 + (blk & 3)) * 4096) + off * 8) = v; } }
    }
};
struct EpiResid {
    static constexpr bool PERM = true, AFTER_DRAIN = false;
    const float* X; h16* O; float* SSQ;
    __device__ __forceinline__ void operator()(const f32x4 (&acc)[2][2][4][2], const Unit& u, int wr, int wc, int fr, int fq) const {
        const int row0 = u.pm * BM + wr * 64 + fr, col0 = u.pn * BM + wc * 32 + 8 * fq;
#pragma unroll
        for (int ai = 0; ai < 2; ++ai)
#pragma unroll
            for (int m = 0; m < 4; ++m) { const int row = row0 + ai * HALF + m * 16; float sq = 0.f;
#pragma unroll
                for (int bj = 0; bj < 2; ++bj) { const float* xp = X + (size_t)row * DM + col0 + bj * HALF; const f32x4 x0 = *(const f32x4*)xp, x1 = *(const f32x4*)(xp + 4);
                    const f32x4 v0 = acc[ai][bj][m][0] + x0, v1 = acc[ai][bj][m][1] + x1;
                    sq += (v0[0] * v0[0] + v0[1] * v0[1]) + (v0[2] * v0[2] + v0[3] * v0[3]) + (v1[0] * v1[0] + v1[1] * v1[1]) + (v1[2] * v1[2] + v1[3] * v1[3]);
                    u32x4 w; w.x = pk_h2(v0[0], v0[1]); w.y = pk_h2(v0[2], v0[3]); w.z = pk_h2(v1[0], v1[1]); w.w = pk_h2(v1[2], v1[3]);
                    *(u32x4*)(O + (size_t)row * DM + col0 + bj * HALF) = w; }
                sq += __shfl_xor(sq, 16); sq += __shfl_xor(sq, 32);
                if (fq == 0) SSQ[(size_t)row * 16 + u.pn * 4 + wc] = sq; }
    }
};
struct DynGroupSched {
    const volatile LAS int* GT; int ncol; unsigned* ctr; volatile LAS unsigned* slot;
    __device__ __forceinline__ bool next(int i, Unit& u) const {
        if (threadIdx.x == 0) slot[i & 1] = __hip_atomic_fetch_add(ctr, 1u, __ATOMIC_RELAXED, __HIP_MEMORY_SCOPE_AGENT);
        asm volatile("s_waitcnt vmcnt(0) lgkmcnt(0)" ::: "memory"); __builtin_amdgcn_s_barrier(); asm volatile("" ::: "memory");
        const int L = (int)slot[i & 1], total = GT[32] * ncol; if (L >= total) return false;
        const int g = L / ncol, nfull = GT[192 + 32]; int e = 0, pm;
        if (g < nfull) { while (GT[192 + e + 1] <= g) ++e; pm = g - GT[192 + e]; }
        else { e = GT[232 + (g - nfull)]; pm = GT[128 + e] >> 8; }
        u.e = e; u.pm = pm; u.pn = L - g * ncol; u.half = (GT[128 + e] - pm * 256) <= 128; return true;
    }
    __device__ __forceinline__ void a_ready(const Unit&) const {}
};
struct DynGroupSchedDep : DynGroupSched {
    unsigned* DONE; unsigned need;
    __device__ __forceinline__ void a_ready(const Unit& u) const {
        if (threadIdx.x < 64) {
            unsigned* p = DONE + 16 * (GT[u.e] + u.pm); unsigned sp = 0;
            while ((unsigned)__builtin_amdgcn_readfirstlane(__hip_atomic_load(p, __ATOMIC_RELAXED, __HIP_MEMORY_SCOPE_AGENT)) < need) { __builtin_amdgcn_s_sleep(2); if (++sp > (1u << 22)) break; }
            __builtin_amdgcn_fence(__ATOMIC_ACQUIRE, "agent");
            asm volatile("s_waitcnt vmcnt(0)" ::: "memory");
        }
        asm volatile("" ::: "memory"); __builtin_amdgcn_s_barrier(); asm volatile("" ::: "memory");
    }
};
struct GatherProb {
    const h16* X; const h16* W; const int* ETOK; const volatile LAS int* GT; int lda, ldb, K;
    __device__ __forceinline__ const char* a_base() const { return (const char*)X; }
    __device__ __forceinline__ unsigned a_row_off(const Unit& u, int h, int R) const { int pos = u.pm * BM + h * HALF + R; const int n = GT[128 + u.e]; pos = pos < n ? pos : n - 1;
        return (unsigned)ETOK[u.e * ECAP + pos] * (unsigned)lda; }
    __device__ __forceinline__ const char* b_base(const Unit& u) const { return (const char*)(W + ((size_t)u.e * 512 + (size_t)u.pn * BM) * ldb); }
};
struct SlotProb {
    const h16* H; const h16* W; const volatile LAS int* GT; int lda, ldb, K;
    __device__ __forceinline__ const char* a_base() const { return (const char*)H; }
    __device__ __forceinline__ unsigned a_row_off(const Unit& u, int h, int R) const { return (unsigned)((GT[64 + u.e] + u.pm * BM + h * HALF + R) * lda); }
    __device__ __forceinline__ const char* b_base(const Unit& u) const { return (const char*)(W + ((size_t)u.e * 1024 + (size_t)u.pn * BM) * ldb); }
};
struct EpiHid {
    static constexpr bool PERM = true, AFTER_DRAIN = false;
    const float* ESC; const volatile LAS int* GT; h16* HID; unsigned* DONE;
    __device__ __forceinline__ void operator()(const f32x4 (&acc)[2][2][4][2], const Unit& u, int wr, int wc, int fr, int fq) const {
        const int n = GT[128 + u.e], base = GT[64 + u.e];
#pragma unroll
        for (int ai = 0; ai < 2; ++ai) { if (ai == 1 && u.half) break;
#pragma unroll
            for (int m = 0; m < 4; ++m) { const int pos = u.pm * BM + ai * HALF + wr * 64 + m * 16 + fr; const bool ok = pos < n;
                float rs = 0.f, w = 0.f; if (ok) { const float* ep = ESC + ((size_t)u.e * ECAP + pos) * 2; rs = ep[0]; w = ep[1]; }
#pragma unroll
                for (int bj = 0; bj < 2; ++bj) { const f32x4 v0 = acc[ai][bj][m][0] * rs, v1 = acc[ai][bj][m][1] * rs;
                    const float h0 = v0[0] / (1.f + __expf(-v0[0])) * v0[1] * w, h1 = v0[2] / (1.f + __expf(-v0[2])) * v0[3] * w;
                    const float h2 = v1[0] / (1.f + __expf(-v1[0])) * v1[1] * w, h3 = v1[2] / (1.f + __expf(-v1[2])) * v1[3] * w;
                    const unsigned long long o = (unsigned long long)pk_h2(h0, h1) | ((unsigned long long)pk_h2(h2, h3) << 32);
                    __hip_atomic_store((unsigned long long*)(HID + (size_t)(base + pos) * DEXP + u.pn * 128 + bj * 64 + wc * 16 + 4 * fq), o, __ATOMIC_RELAXED, __HIP_MEMORY_SCOPE_AGENT); } } }
        asm volatile("s_waitcnt vmcnt(0)" ::: "memory");
        if (fr == 0 && fq == 0) __hip_atomic_fetch_add(DONE + 16 * (GT[u.e] + u.pm), 1u, __ATOMIC_RELAXED, __HIP_MEMORY_SCOPE_AGENT);
    }
};
struct EpiY {
    static constexpr bool PERM = true, AFTER_DRAIN = false;
    const volatile LAS int* GT; h16* Y;
    __device__ __forceinline__ void operator()(const f32x4 (&acc)[2][2][4][2], const Unit& u, int wr, int wc, int fr, int fq) const {
        const int row0 = GT[64 + u.e] + u.pm * BM + wr * 64 + fr, col0 = u.pn * BM + wc * 32 + 8 * fq;
#pragma unroll
        for (int ai = 0; ai < 2; ++ai) { if (ai == 1 && u.half) break;
#pragma unroll
            for (int m = 0; m < 4; ++m) { h16* rowp = Y + (size_t)(row0 + ai * HALF + m * 16) * DM + col0;
#pragma unroll
                for (int bj = 0; bj < 2; ++bj) { const f32x4 v0 = acc[ai][bj][m][0], v1 = acc[ai][bj][m][1];
                    u32x4 w; w.x = pk_h2(v0[0], v0[1]); w.y = pk_h2(v0[2], v0[3]); w.z = pk_h2(v1[0], v1[1]); w.w = pk_h2(v1[2], v1[3]);
                    *(u32x4*)(rowp + bj * HALF) = w; } } }
    }
};
}

__device__ __forceinline__ void gla_combine_rows(const h16* OGLA, const h16* PROJ, const float* og_gain, h16* MIX, int m0, int m1, int mstep, int lane) {
    typedef _Float16 h8 __attribute__((ext_vector_type(8)));
    const int c = lane * 8;
    const f32x4 g0 = *(const f32x4*)(og_gain + (c & 127)), g1 = *(const f32x4*)(og_gain + (c & 127) + 4);
    for (int mb = m0; mb < m1; mb += 4 * mstep) {
        h8 a[4], b2[4], g[4];
#pragma unroll
        for (int q = 0; q < 4; ++q) { const int m = mb + q * mstep < m1 ? mb + q * mstep : mb;
            a[q] = *(const h8*)(OGLA + (size_t)m * 512 + c); b2[q] = *(const h8*)(OGLA + ((size_t)T + m) * 512 + c); g[q] = *(const h8*)(PROJ + (size_t)m * NPROJ + PC_GATE + c); }
#pragma unroll
        for (int q = 0; q < 4; ++q) { const int m = mb + q * mstep; if (m >= m1) break;
            float o[8]; float sq = 0.f;
#pragma unroll
            for (int k = 0; k < 8; ++k) { o[k] = (float)a[q][k] + (float)b2[q][k]; sq += o[k] * o[k]; }
            sq += __shfl_xor(sq, 1); sq += __shfl_xor(sq, 2); sq += __shfl_xor(sq, 4); sq += __shfl_xor(sq, 8);
            const float rs = rsqrtf(sq * (1.f / 128.f) + EPS);
            float r[8];
#pragma unroll
            for (int k = 0; k < 8; ++k) { const float gg = (float)g[q][k]; r[k] = o[k] * rs * (k < 4 ? g0[k] : g1[k - 4]) * (gg / (1.f + __expf(-gg))); }
            u32x4 w; w.x = pk_h2(r[0], r[1]); w.y = pk_h2(r[2], r[3]); w.z = pk_h2(r[4], r[5]); w.w = pk_h2(r[6], r[7]);
            *(u32x4*)(MIX + (size_t)m * DM + c) = w; }
    }
}

namespace at {
typedef _Float16 f16x8 __attribute__((ext_vector_type(8)));
typedef float f32x16 __attribute__((ext_vector_type(16)));
typedef __fp16 fp16x2 __attribute__((ext_vector_type(2)));
constexpr int KB_BYTES = 12288, VB_BYTES = 8192, TILE_BYTES = KB_BYTES + VB_BYTES, BUF_BYTES = 2 * TILE_BYTES, NT2 = SEQ / 128;
constexpr float THR = 8.f;
__device__ __forceinline__ int crow(int r, int hi) { return (r & 3) + 8 * (r >> 2) + 4 * hi; }
#define AT_DMA(gsrc, ldsoff) __builtin_amdgcn_global_load_lds((const unsigned*)(gsrc), (LAS unsigned*)(lds + (ldsoff)), 16, 0, 0)
__device__ __forceinline__ void attn_unit(LAS unsigned char* lds, const h16* __restrict__ QF, const h16* __restrict__ KF, const h16* __restrict__ VT, h16* __restrict__ MIX, int bh, int qb) {
    int tid = threadIdx.x; asm volatile("" : "+v"(tid));
    const int lane = tid & 63, wid = __builtin_amdgcn_readfirstlane(tid >> 6), r32 = lane & 31, hi = lane >> 5;
    f16x8 qf[6];
    { const h16* qp = QF + ((size_t)bh * SEQ + qb * 256 + wid * 32 + r32) * 96 + hi * 8;
#pragma unroll
      for (int ks = 0; ks < 6; ++ks) qf[ks] = *(const f16x8*)(qp + 16 * ks); }
    LAS float* wsf = (LAS float*)(lds + 2 * BUF_BYTES) + wid * 64;
    const h16* kg = KF + (size_t)bh * SEQ * 96 + wid * 512 + lane * 8;
    const h16* vg = VT + (size_t)bh * SEQ * 64 + wid * 512 + lane * 8;
    const int kdst = wid * 1024, vdst = KB_BYTES + wid * 1024;
#define AT_ISSUE1(t, off) do { AT_DMA(kg + (size_t)(t) * 6144, (off) + kdst); if (wid < 4) AT_DMA(kg + (size_t)(t) * 6144 + 8 * 512, (off) + kdst + 8192); AT_DMA(vg + (size_t)(t) * 4096, (off) + vdst); } while (0)
#define AT_ISSUE(t2, b) do { AT_ISSUE1(2 * (t2), (b) * BUF_BYTES); AT_ISSUE1(2 * (t2) + 1, (b) * BUF_BYTES + TILE_BYTES); } while (0)
    f32x16 o0, o1;
#pragma unroll
    for (int r = 0; r < 16; ++r) { o0[r] = 0.f; o1[r] = 0.f; }
    float m_run = 0.f, l_run = 0.f;
    AT_ISSUE(0, 0);
    asm volatile("s_waitcnt vmcnt(0)" ::: "memory"); __builtin_amdgcn_s_barrier(); asm volatile("" ::: "memory");
    for (int t = 0; t < NT2; ++t) {
        const int cur = t & 1;
        if (t + 1 < NT2) AT_ISSUE(t + 1, cur ^ 1);
        LAS unsigned char* Kb = lds + cur * BUF_BYTES; LAS unsigned char* Vb = Kb + KB_BYTES;
        f32x16 s[4];
        { const float nm = -m_run;
#pragma unroll
          for (int q = 0; q < 4; ++q)
#pragma unroll
              for (int r = 0; r < 16; ++r) s[q][r] = nm; }
#pragma unroll
        for (int tl = 0; tl < 2; ++tl) {
            f16x8 kf[12];
#pragma unroll
            for (int ks = 0; ks < 6; ++ks) { kf[2 * ks] = *(const LAS f16x8*)(Kb + tl * TILE_BYTES + (2 * ks + hi) * 1024 + r32 * 16); kf[2 * ks + 1] = *(const LAS f16x8*)(Kb + tl * TILE_BYTES + (2 * ks + hi) * 1024 + (32 + r32) * 16); }
            asm volatile("s_waitcnt lgkmcnt(0)" ::: "memory"); __builtin_amdgcn_sched_barrier(0);
            __builtin_amdgcn_s_setprio(1);
#pragma unroll
            for (int ks = 0; ks < 6; ++ks) {
                s[2 * tl] = __builtin_amdgcn_mfma_f32_32x32x16_f16(kf[2 * ks], qf[ks], s[2 * tl], 0, 0, 0);
                s[2 * tl + 1] = __builtin_amdgcn_mfma_f32_32x32x16_f16(kf[2 * ks + 1], qf[ks], s[2 * tl + 1], 0, 0, 0);
            }
            __builtin_amdgcn_s_setprio(0);
        }
        float mx = fmaxf(fmaxf(s[0][0], s[1][0]), fmaxf(s[2][0], s[3][0]));
#pragma unroll
        for (int r = 1; r < 16; ++r) mx = fmaxf(mx, fmaxf(fmaxf(s[0][r], s[1][r]), fmaxf(s[2][r], s[3][r])));
        mx = fmaxf(mx, __shfl_xor(mx, 32));
        if (t == 0 || __any(mx > THR)) {
            const float d = (t == 0) ? mx : fmaxf(mx, 0.f), f = __builtin_amdgcn_exp2f(-d);
            m_run += d;
#pragma unroll
            for (int q = 0; q < 4; ++q)
#pragma unroll
                for (int r = 0; r < 16; ++r) s[q][r] -= d;
            if (t != 0) { l_run *= f;
                if (hi == 0) wsf[r32] = f;
                asm volatile("s_waitcnt lgkmcnt(0)" ::: "memory");
#pragma unroll
                for (int r = 0; r < 16; ++r) { const float ff = wsf[crow(r, hi)]; o0[r] *= ff; o1[r] *= ff; } }
        }
#pragma unroll
        for (int tl = 0; tl < 2; ++tl) {
            float ps = 0.f;
#pragma unroll
            for (int r = 0; r < 16; ++r) { s[2 * tl][r] = __builtin_amdgcn_exp2f(s[2 * tl][r]); s[2 * tl + 1][r] = __builtin_amdgcn_exp2f(s[2 * tl + 1][r]); ps += s[2 * tl][r] + s[2 * tl + 1][r]; }
            l_run += ps;
            f16x8 vf[8], pa[4];
#pragma unroll
            for (int g = 0; g < 4; ++g) { vf[2 * g] = *(const LAS f16x8*)(Vb + tl * TILE_BYTES + (2 * g + hi) * 1024 + r32 * 16); vf[2 * g + 1] = *(const LAS f16x8*)(Vb + tl * TILE_BYTES + (2 * g + hi) * 1024 + (32 + r32) * 16); }
#pragma unroll
            for (int g = 0; g < 4; ++g)
#pragma unroll
                for (int j = 0; j < 4; ++j) { const int base = 8 * (g & 1) + 2 * j; const fp16x2 pk = __builtin_amdgcn_cvt_pkrtz(s[2 * tl + (g >> 1)][base], s[2 * tl + (g >> 1)][base + 1]); pa[g][2 * j] = (h16)pk[0]; pa[g][2 * j + 1] = (h16)pk[1]; }
            asm volatile("s_waitcnt lgkmcnt(0)" ::: "memory"); __builtin_amdgcn_sched_barrier(0);
            __builtin_amdgcn_s_setprio(1);
#pragma unroll
            for (int g = 0; g < 4; ++g) {
                o0 = __builtin_amdgcn_mfma_f32_32x32x16_f16(pa[g], vf[2 * g], o0, 0, 0, 0);
                o1 = __builtin_amdgcn_mfma_f32_32x32x16_f16(pa[g], vf[2 * g + 1], o1, 0, 0, 0);
            }
            __builtin_amdgcn_s_setprio(0);
        }
        asm volatile("s_waitcnt vmcnt(0) lgkmcnt(0)" ::: "memory"); __builtin_amdgcn_s_barrier(); asm volatile("" ::: "memory");
    }
    l_run += __shfl_xor(l_run, 32);
    if (hi == 0) wsf[r32] = 1.f / l_run;
    asm volatile("s_waitcnt lgkmcnt(0)" ::: "memory");
    const int b = bh >> 3, h = bh & 7;
    h16* op = MIX + ((size_t)b * SEQ + qb * 256 + wid * 32) * DM + 512 + h * 64 + r32;
#pragma unroll
    for (int r = 0; r < 16; ++r) { const int q = crow(r, hi); const float il = wsf[q]; op[(size_t)q * DM] = (h16)(o0[r] * il); op[(size_t)q * DM + 32] = (h16)(o1[r] * il); }
    asm volatile("s_waitcnt lgkmcnt(0)" ::: "memory"); __builtin_amdgcn_s_barrier(); asm volatile("" ::: "memory");
#undef AT_ISSUE
#undef AT_ISSUE1
}
#undef AT_DMA
}

namespace gl {
typedef _Float16 f16x8 __attribute__((ext_vector_type(8)));
typedef _Float16 f16x4 __attribute__((ext_vector_type(4)));
typedef short v4i16_t __attribute__((ext_vector_type(4)));
constexpr int RAW_Q = 0, RAW_K = 8192, RAW_V = 16384, RAW_LR = 32768, RAW_BYTES = 34816;
constexpr int OFF_QREL = 2 * RAW_BYTES, RS = 144  , IMG = 64 * RS;
constexpr int OFF_KREL = OFF_QREL + IMG, OFF_QDEC = OFF_KREL + IMG, OFF_KDECT = OFF_QDEC + IMG, OFF_SC = OFF_KDECT + IMG, OFF_TOT = OFF_SC + IMG, OFF_EBL = OFF_TOT + 2048, GLA_LDS = OFF_EBL + 256;
static_assert(GLA_LDS <= RING_BYTES, "GLA LDS map");
__device__ __forceinline__ int vswz(int token) { return 2 * ((token & 3) | (((token >> 3) & 1) << 2)); }
#define GL_DMA(gsrc, ldsoff) __builtin_amdgcn_global_load_lds((const unsigned*)(gsrc), (LAS unsigned*)(lds + (ldsoff)), 16, 0, 0)
#define GL_BAR() do { asm volatile("s_waitcnt lgkmcnt(0)" ::: "memory"); __builtin_amdgcn_s_barrier(); asm volatile("" ::: "memory"); } while (0)
__device__ __forceinline__ void gla_unit(LAS unsigned char* lds, const h16* __restrict__ PROJ, const float* __restrict__ GW, const float* __restrict__ GB, h16* __restrict__ OG, int b, int h, int dir) {
    int tid = threadIdx.x; asm volatile("" : "+v"(tid));
    const int lane = tid & 63, w = __builtin_amdgcn_readfirstlane(tid >> 6), l15 = lane & 15, kg = lane >> 4;
    typedef _Float16 h2v __attribute__((ext_vector_type(2)));
    h2v gwp[8];
#pragma unroll
    for (int r = 0; r < 8; ++r) gwp[r] = (h2v){(h16)GW[(2 * r) * 256 + h * 64 + lane], (h16)GW[(2 * r + 1) * 256 + h * 64 + lane]};
    const float gb = GB[h * 64 + lane];
    const h16* pb = PROJ + (size_t)b * SEQ * NPROJ;
    f32x4 Sacc[4];
#pragma unroll
    for (int k = 0; k < 4; ++k) Sacc[k] = (f32x4){0.f, 0.f, 0.f, 0.f};
#define GL_TOK(c, i) (dir ? (SEQ - 1 - ((c) * 64 + (i))) : ((c) * 64 + (i)))
#define GL_ISSUE(c, buf) do { const int _rb = (buf) * RAW_BYTES; \
        { const int row = 8 * w + (lane >> 3); const h16* src = pb + (size_t)GL_TOK(c, row) * NPROJ + h * 64 + (lane & 7) * 8; GL_DMA(src + PC_Q, _rb + RAW_Q + w * 1024); GL_DMA(src + PC_K, _rb + RAW_K + w * 1024); } \
        _Pragma("unroll") for (int _j = 0; _j < 2; ++_j) { const int row = 8 * w + 4 * _j + (lane >> 4); const int cc = (lane & 15) ^ vswz(row); \
            GL_DMA(pb + (size_t)GL_TOK(c, row) * NPROJ + PC_V + h * 128 + cc * 8, _rb + RAW_V + (2 * w + _j) * 1024); } \
        if (lane < 16) { const int row = 8 * w + (lane >> 1); GL_DMA(pb + (size_t)GL_TOK(c, row) * NPROJ + (dir ? PC_LRB : PC_LRF) + (lane & 1) * 8, _rb + RAW_LR + w * 256); } } while (0)
    f32x4 opend[4];
    float bl[8];
#define GL_GATES(rb_) do { float run = 0.f; const LAS unsigned char* lrp_ = lds + (rb_) * RAW_BYTES + RAW_LR; \
        _Pragma("unroll") for (int k = 0; k < 8; ++k) { const int i = 8 * w + k; const f16x8 l0 = *(const LAS f16x8*)(lrp_ + i * 32), l1 = *(const LAS f16x8*)(lrp_ + i * 32 + 16); \
            float z = gb, z1 = 0.f; \
            _Pragma("unroll") for (int r = 0; r < 4; ++r) { z = __builtin_amdgcn_fdot2((h2v){l0[2 * r], l0[2 * r + 1]}, gwp[r], z, false); z1 = __builtin_amdgcn_fdot2((h2v){l1[2 * r], l1[2 * r + 1]}, gwp[4 + r], z1, false); } \
            z += z1; \
            const float z2 = z * 1.4426950408889634f; \
            const float ls2 = fminf(z2, 0.f) - __builtin_amdgcn_logf(1.f + __builtin_amdgcn_exp2f(-fabsf(z2))); \
            run += ls2 * (1.f / 16.f); bl[k] = run; } \
        ((LAS float*)(lds + OFF_TOT))[w * 64 + lane] = run; } while (0)
    GL_ISSUE(0, 0);
    asm volatile("s_waitcnt vmcnt(0)" ::: "memory");
    GL_GATES(0);
    GL_BAR();
    for (int c = 0; c < SEQ / 64; ++c) {
        const int cur = c & 1; LAS unsigned char* raw = lds + cur * RAW_BYTES;
        if (c + 1 < SEQ / 64) GL_ISSUE(c + 1, cur ^ 1);
        float pre = 0.f, bref = 0.f, blast = 0.f;
#pragma unroll
        for (int ww = 0; ww < 8; ++ww) { const float tv = ((const LAS float*)(lds + OFF_TOT))[ww * 64 + lane]; if (ww < w) pre += tv; if (ww < 4) bref += tv; blast += tv; }
        { const int d = lane; const int dperm = (d & 32) + 8 * ((d >> 2) & 3) + 4 * ((d >> 4) & 1) + (d & 3);
          f16x8 kd; const float eref = __builtin_amdgcn_exp2f(bref), elr = __builtin_amdgcn_exp2f(blast - bref);
#pragma unroll
          for (int k = 0; k < 8; ++k) { const int i = 8 * w + k; const float bb = pre + bl[k];
              const float qv = (float)*(const LAS h16*)(raw + RAW_Q + i * 128 + d * 2), kv = (float)*(const LAS h16*)(raw + RAW_K + i * 128 + d * 2);
              const float dd = fminf(fmaxf(bb - bref, -14.f), 14.f); const float e1 = __builtin_amdgcn_exp2f(dd), e1i = __builtin_amdgcn_rcpf(e1);
              const float qr = qv * e1, kr = kv * e1i;
              *(LAS h16*)(lds + OFF_QREL + i * RS + d * 2) = (h16)qr;
              *(LAS h16*)(lds + OFF_KREL + i * RS + d * 2) = (h16)kr;
              *(LAS h16*)(lds + OFF_QDEC + i * RS + dperm * 2) = (h16)(qr * eref);
              kd[k] = (h16)(kr * elr); }
          *(LAS f16x8*)(lds + OFF_KDECT + d * RS + (8 * w) * 2) = kd;
          if (w == 0) ((LAS float*)(lds + OFF_EBL))[d] = __builtin_amdgcn_exp2f(blast); }
        GL_BAR();
#pragma unroll
        for (int q = 0; q < 2; ++q) { const int blk = 2 * w + q, ib = blk >> 2, jb = blk & 3;
            f32x4 sc = {0.f, 0.f, 0.f, 0.f};
            if (jb <= ib) {
#pragma unroll
                for (int ks = 0; ks < 2; ++ks) { const f16x8 a = *(const LAS f16x8*)(lds + OFF_KREL + (16 * jb + l15) * RS + (32 * ks + 8 * kg) * 2), bq = *(const LAS f16x8*)(lds + OFF_QREL + (16 * ib + l15) * RS + (32 * ks + 8 * kg) * 2);
                    sc = __builtin_amdgcn_mfma_f32_16x16x32_f16(a, bq, sc, 0, 0, 0); }
                if (jb == ib) {
#pragma unroll
                    for (int r = 0; r < 4; ++r) { const int j = 4 * kg + r, i = l15; const bool keep = dir ? (j < i) : (j <= i); if (!keep) sc[r] = 0.f; }
                }
            }
            f16x4 o; o[0] = (h16)sc[0]; o[1] = (h16)sc[1]; o[2] = (h16)sc[2]; o[3] = (h16)sc[3];
            *(LAS f16x4*)(lds + OFF_SC + (16 * ib + l15) * RS + (16 * jb + 4 * kg) * 2) = o; }
        f16x8 Vf[2], Sf[2];
#pragma unroll
        for (int ks = 0; ks < 2; ++ks) {
            v4i16_t t0, t1;
            { const int q = l15 >> 2, p = l15 & 3;
              const int tk0 = 32 * ks + 8 * kg + q, tk1 = tk0 + 4;
              const int c0 = (2 * w + (p >> 1)) ^ vswz(tk0), c1 = (2 * w + (p >> 1)) ^ vswz(tk1);
              t0 = __builtin_amdgcn_ds_read_tr16_b64_v4i16((LAS v4i16_t*)(raw + RAW_V + tk0 * 256 + c0 * 16 + (p & 1) * 8));
              t1 = __builtin_amdgcn_ds_read_tr16_b64_v4i16((LAS v4i16_t*)(raw + RAW_V + tk1 * 256 + c1 * 16 + (p & 1) * 8)); }
            const f16x4 a = __builtin_bit_cast(f16x4, t0), bq = __builtin_bit_cast(f16x4, t1);
            Vf[ks] = (f16x8){a[0], a[1], a[2], a[3], bq[0], bq[1], bq[2], bq[3]};
            Sf[ks] = (f16x8){(h16)Sacc[2 * ks][0], (h16)Sacc[2 * ks][1], (h16)Sacc[2 * ks][2], (h16)Sacc[2 * ks][3], (h16)Sacc[2 * ks + 1][0], (h16)Sacc[2 * ks + 1][1], (h16)Sacc[2 * ks + 1][2], (h16)Sacc[2 * ks + 1][3]};
        }
        GL_BAR();
        { f16x8 fsc[4][2], fqd[4][2], fkd[4][2]; f32x4 feb[4];
#pragma unroll
          for (int ib = 0; ib < 4; ++ib)
#pragma unroll
              for (int ks = 0; ks < 2; ++ks) { if (32 * ks <= 16 * ib + 15) fsc[ib][ks] = *(const LAS f16x8*)(lds + OFF_SC + (16 * ib + l15) * RS + (32 * ks + 8 * kg) * 2);
                  fqd[ib][ks] = *(const LAS f16x8*)(lds + OFF_QDEC + (16 * ib + l15) * RS + (32 * ks + 8 * kg) * 2); }
#pragma unroll
          for (int blk = 0; blk < 4; ++blk) { feb[blk] = *(const LAS f32x4*)(lds + OFF_EBL + (16 * blk + 4 * kg) * 4);
#pragma unroll
              for (int ks = 0; ks < 2; ++ks) fkd[blk][ks] = *(const LAS f16x8*)(lds + OFF_KDECT + (16 * blk + l15) * RS + (32 * ks + 8 * kg) * 2); }
          asm volatile("s_waitcnt lgkmcnt(0)" ::: "memory"); __builtin_amdgcn_sched_barrier(0);
          f32x4 oa[4];
#pragma unroll
          for (int ib = 0; ib < 4; ++ib) oa[ib] = (f32x4){0.f, 0.f, 0.f, 0.f};
#pragma unroll
          for (int ks = 0; ks < 2; ++ks)
#pragma unroll
              for (int ib = 0; ib < 4; ++ib) { if (32 * ks <= 16 * ib + 15) oa[ib] = __builtin_amdgcn_mfma_f32_16x16x32_f16(fsc[ib][ks], Vf[ks], oa[ib], 0, 0, 0); }
#pragma unroll
          for (int ks = 0; ks < 2; ++ks)
#pragma unroll
              for (int ib = 0; ib < 4; ++ib) oa[ib] = __builtin_amdgcn_mfma_f32_16x16x32_f16(fqd[ib][ks], Sf[ks], oa[ib], 0, 0, 0);
#pragma unroll
          for (int blk = 0; blk < 4; ++blk) Sacc[blk] = Sacc[blk] * feb[blk];
#pragma unroll
          for (int ks = 0; ks < 2; ++ks)
#pragma unroll
              for (int blk = 0; blk < 4; ++blk) Sacc[blk] = __builtin_amdgcn_mfma_f32_16x16x32_f16(fkd[blk][ks], Vf[ks], Sacc[blk], 0, 0, 0);
#pragma unroll
          for (int ib = 0; ib < 4; ++ib) opend[ib] = oa[ib]; }
        asm volatile("s_waitcnt vmcnt(0)" ::: "memory");
        if (c + 1 < SEQ / 64) GL_GATES(cur ^ 1);
        { LAS unsigned char* stg = lds + OFF_QREL + w * 2048;
#pragma unroll
          for (int ib = 0; ib < 4; ++ib)
#pragma unroll
              for (int r = 0; r < 4; ++r) *(LAS h16*)(stg + (16 * ib + 4 * kg + r) * 32 + l15 * 2) = (h16)opend[ib][r];
          asm volatile("s_waitcnt lgkmcnt(0)" ::: "memory");
#pragma unroll
          for (int q = 0; q < 2; ++q) { const int p = q * 64 + lane, i = p >> 1; const u32x4 v = *(const LAS u32x4*)(stg + p * 16);
              *(u32x4*)(OG + ((size_t)dir * T + (size_t)b * SEQ + GL_TOK(c, i)) * 512 + h * 128 + 16 * w + (p & 1) * 8) = v; } }
        GL_BAR();
    }
#undef GL_ISSUE
#undef GL_TOK
#undef GL_GATES
}
#undef GL_DMA
#undef GL_BAR
}

namespace rt {
typedef _Float16 f16x8 __attribute__((ext_vector_type(8)));
__device__ __forceinline__ void route_block(LAS unsigned char* lds, const h16* __restrict__ X1H, const h16* __restrict__ W16, const float* __restrict__ SSQ, const float* __restrict__ bg, const float* __restrict__ be,
                                            float* RS2, int* TOKE, int* TOKP, float* TOKW, int* ETOK, float* ESC, int* cnt, int row0) {
    int tid = threadIdx.x; asm volatile("" : "+v"(tid));
    const int lane = tid & 63, w = __builtin_amdgcn_readfirstlane(tid >> 6), l15 = lane & 15, kg = lane >> 4;
    f32x4 acc[4][3];
#pragma unroll
    for (int i = 0; i < 4; ++i)
#pragma unroll
        for (int j = 0; j < 3; ++j) acc[i][j] = (f32x4){0.f, 0.f, 0.f, 0.f};
    f16x8 af[4][4], bf[3][4];
#pragma unroll
    for (int ks = 0; ks < 4; ++ks) { const int k0 = 128 * w + 32 * ks + 8 * kg;
#pragma unroll
        for (int i = 0; i < 4; ++i) af[i][ks] = *(const f16x8*)(X1H + (size_t)(row0 + 16 * i + l15) * DM + k0);
#pragma unroll
        for (int j = 0; j < 3; ++j) bf[j][ks] = *(const f16x8*)(W16 + (size_t)(16 * j + l15) * DM + k0); }
#pragma unroll
    for (int ks = 0; ks < 4; ++ks)
#pragma unroll
        for (int i = 0; i < 4; ++i)
#pragma unroll
            for (int j = 0; j < 3; ++j) acc[i][j] = __builtin_amdgcn_mfma_f32_16x16x32_f16(bf[j][ks], af[i][ks], acc[i][j], 0, 0, 0);
    LAS float* PS = (LAS float*)lds;
#pragma unroll
    for (int i = 0; i < 4; ++i)
#pragma unroll
        for (int j = 0; j < 3; ++j) *(LAS f32x4*)(PS + (w * 64 + 16 * i + l15) * 48 + 16 * j + 4 * kg) = acc[i][j];
    LDS_WAIT(); __builtin_amdgcn_s_barrier(); asm volatile("" ::: "memory");
    LAS float* L = (LAS float*)(lds + 8 * 64 * 48 * 4);
    for (int t = tid; t < 64 * 12; t += NTHREADS) { const int r = t / 12, c4 = (t % 12) * 4; f32x4 sum = {0.f, 0.f, 0.f, 0.f};
#pragma unroll
        for (int ww = 0; ww < 8; ++ww) sum += *(const LAS f32x4*)(PS + (ww * 64 + r) * 48 + c4);
        *(LAS f32x4*)(L + r * 48 + c4) = sum; }
    LDS_WAIT(); __builtin_amdgcn_s_barrier(); asm volatile("" ::: "memory");
    if (tid < 64) { const int r = tid, m = row0 + r; LAS float* l = L + r * 48;
        float ss = 0.f; { const f32x4* sp = (const f32x4*)(SSQ + (size_t)m * 16);
#pragma unroll
            for (int i = 0; i < 4; ++i) { const f32x4 t4 = sp[i]; ss += (t4[0] + t4[1]) + (t4[2] + t4[3]); } }
        const float rs = rsqrtf(ss * (1.f / DM) + EPS);
        float mx = l[0] * rs + bg[0]; int gi = 0;
        for (int g = 1; g < 4; ++g) { const float v = l[g] * rs + bg[g]; if (v > mx) { mx = v; gi = g; } }
        float den = 0.f;
        for (int g = 0; g < 4; ++g) den += expf(l[g] * rs + bg[g] - mx);
        const float ptop = 1.f / den;
        LAS float* l8 = l + 4 + gi * 8;
        for (int j = 0; j < 8; ++j) l8[j] = l8[j] * rs + be[gi * 8 + j];
        float b0 = l8[0]; int i0 = 0;
        for (int j = 1; j < 8; ++j) if (l8[j] > b0) { b0 = l8[j]; i0 = j; }
        float b1 = -3.0e38f; int i1 = 0;
        for (int j = 0; j < 8; ++j) if (j != i0 && l8[j] > b1) { b1 = l8[j]; i1 = j; }
        const float p1 = expf(b1 - b0);
        const float w0 = ptop / (1.f + p1), w1 = ptop * p1 / (1.f + p1);
        const int e0 = gi * 8 + i0, e1 = gi * 8 + i1;
        LAS int* H = (LAS int*)(lds + 8 * 64 * 48 * 4 + 64 * 48 * 4);
        if (tid < 32) H[tid] = 0;
        __builtin_amdgcn_wave_barrier(); asm volatile("s_waitcnt lgkmcnt(0)" ::: "memory");
        const int r0 = __hip_atomic_fetch_add(H + e0, 1, __ATOMIC_RELAXED, __HIP_MEMORY_SCOPE_WORKGROUP), r1 = __hip_atomic_fetch_add(H + e1, 1, __ATOMIC_RELAXED, __HIP_MEMORY_SCOPE_WORKGROUP);
        __builtin_amdgcn_wave_barrier(); asm volatile("s_waitcnt lgkmcnt(0)" ::: "memory");
        if (tid < 32) { const int c = H[tid]; H[32 + tid] = c ? atomicAdd(&cnt[tid], c) : 0; }
        __builtin_amdgcn_wave_barrier(); asm volatile("s_waitcnt vmcnt(0) lgkmcnt(0)" ::: "memory");
        const int q0 = H[32 + e0] + r0, q1 = H[32 + e1] + r1;
        ETOK[e0 * ECAP + q0] = m; ETOK[e1 * ECAP + q1] = m;
        ESC[((size_t)e0 * ECAP + q0) * 2] = rs; ESC[((size_t)e0 * ECAP + q0) * 2 + 1] = w0;
        ESC[((size_t)e1 * ECAP + q1) * 2] = rs; ESC[((size_t)e1 * ECAP + q1) * 2 + 1] = w1;
        RS2[m] = rs; TOKE[m * 2] = e0; TOKE[m * 2 + 1] = e1; TOKP[m * 2] = q0; TOKP[m * 2 + 1] = q1; TOKW[m * 2] = w0; TOKW[m * 2 + 1] = w1;
    }
    __syncthreads();
}
}

__global__ void __launch_bounds__(NTHREADS, 2) mega_fwd(MArgs args) {
    extern __shared__ __attribute__((aligned(16))) unsigned char lds_raw[];
    LAS unsigned char* lds = (LAS unsigned char*)lds_raw;
    volatile LAS unsigned* MISC = (volatile LAS unsigned*)(lds + MISC_OFF);
    const int tid = threadIdx.x, lane = tid & 63, wave = __builtin_amdgcn_readfirstlane(tid >> 6);
    const int G = gridDim.x, bx = blockIdx.x;
    const int vcu = (G % 8 == 0) ? (bx % 8) * (G / 8) + bx / 8 : bx;
    unsigned* ctl = (unsigned*)(args.ws + WS_CTL);
    for (int u = tid; u < (LDS_BYTES - RING_BYTES) / 4; u += NTHREADS) ((LAS unsigned*)(lds + RING_BYTES))[u] = 0u;
    __syncthreads();
    XcdBarrier bar = xcd_barrier_post(ctl + CW_BAR + args.li * XCD_BAR_WORDS, MISC + 8);
    const int gw = vcu * NWAVES + wave, NGW = G * NWAVES;
    const int lo = args.ph_lo, hi = args.ph_hi;
#ifndef DUP_PHASE
#define DUP_PHASE -1
#endif
#define REPS(k) ((k) == DUP_PHASE ? 3 : 1)
#define IN(k) (lo <= (k) && (k) < hi)
#define BOTH(k) (IN(k) && IN((k) + 1))
    if (IN(0)) for (int rep = 0; rep < REPS(0); ++rep) { p0_prologue(args, lds, gw, NGW, lane, wave); if (BOTH(0) || rep + 1 < REPS(0)) xcd_barrier(bar); }
    if (IN(1)) for (int rep = 0; rep < REPS(1); ++rep) {
        g8::PlainProb p{(const h16*)(args.ws + WS_H1), (const h16*)(args.ws + WS_WINT), DM, DM, DM};
        g8::StaticOrder S; S.init(T / 256, NPROJ / 256, G, bx);
        g8::EpiH16 E{(h16*)(args.ws + WS_PROJ), NPROJ};
        g8::gemm_phase<g8::PlainProb, g8::EpiH16, g8::StaticOrder, true>(lds, p, S, E);
        if (BOTH(1) || rep + 1 < REPS(1)) xcd_barrier(bar);
    }
    if (IN(2)) for (int rep = 0; rep < REPS(2); ++rep) {
        const h16* PROJ = (const h16*)(args.ws + WS_PROJ); const float* CS = (const float*)(args.ws + WS_CS);
        g8::StaticOrder S; S.init(T / 256, 8, G, bx);
        g8::Unit u;
        for (int i = 0; S.next(i, u); ++i) {
            if (u.pn < 4) {
                g8::PlainProb p{PROJ + PC_MQA, (const h16*)(args.ws + WS_WQBT), NPROJ, 256, 256};
                g8::EpiQ E{PROJ, (const float*)args.in[13], CS, (h16*)(args.ws + WS_QF)};
                g8::OneUnit O{u};
                g8::gemm_phase<g8::PlainProb, g8::EpiQ, g8::OneUnit, false>(lds, p, O, E);
            } else {
                g8::PlainProb p{PROJ + PC_MKVA, (const h16*)(args.ws + WS_WKVBT), NPROJ, 256, 256};
                g8::EpiKV E{PROJ, (const float*)args.in[14], CS, (h16*)(args.ws + WS_KF), (h16*)(args.ws + WS_VF)};
                g8::Unit u2 = u; u2.pn = u.pn - 4;
                g8::OneUnit O{u2};
                g8::gemm_phase<g8::PlainProb, g8::EpiKV, g8::OneUnit, false>(lds, p, O, E);
            }
            __syncthreads();
        }
        if (BOTH(2) || rep + 1 < REPS(2)) xcd_barrier(bar);
    }
    if (IN(PH_MIX)) for (int rep = 0; rep < REPS(PH_MIX); ++rep) {
        const h16* PROJ = (const h16*)(args.ws + WS_PROJ);
        { const int x0 = (int)(xb_xcc_id() & 7u);
          for (int k = 0; k < 8; ++k) { const int x = (x0 + k) & 7;
              for (;;) {
                  if (tid == 0) MISC[16] = xb_add(ctl + CW_Q + 64 * (rep * 8 + x), 1u);
                  __syncthreads();
                  const int idx = (int)MISC[16];
                  __syncthreads();
                  if (idx >= 152) break;
                  if (idx < 8) { const int dir = idx & 1, hh = idx >> 1; gl::gla_unit(lds, PROJ, (const float*)args.in[dir ? 6 : 4], (const float*)args.in[dir ? 7 : 5], (h16*)(args.ws + WS_OGLA), x, hh, dir);
                      VM_WAIT(); __syncthreads();
                      if (wave == 0) { __builtin_amdgcn_fence(__ATOMIC_RELEASE, "agent"); VM_WAIT(); xb_add(ctl + CW_GLADONE + 64 * (rep * 8 + x), lane == 0 ? 1u : 0u); } }
                  else if (idx < 96 && ((idx - 8) % 11) < 8) { const int a = ((idx - 8) / 11) * 8 + ((idx - 8) % 11); at::attn_unit(lds, (const h16*)(args.ws + WS_QF), (const h16*)(args.ws + WS_KF), (const h16*)(args.ws + WS_VF), (h16*)(args.ws + WS_MIX), x * 8 + (a >> 3), a & 7); }
                  else if (idx < 120) {
                      int ln = lane; asm volatile("" : "+v"(ln));
                      const int bj = idx < 96 ? ((idx - 8) / 11) * 3 + ((idx - 8) % 11) - 8 : idx - 72;
                      const int base = (x * 48 + bj) * 32 + wave * 4; LAS float* scr = (LAS float*)(lds + wave * 16384);
                      if (rep == 0) expert_items4(args, base, scr, ln);
                      __syncthreads(); }
                  else {
                      const int j = idx - 120;
                      if (wave == 0) { unsigned sp = 0; while ((unsigned)__builtin_amdgcn_readfirstlane(xb_ld(ctl + CW_GLADONE + 64 * (rep * 8 + x))) < 8u) { __builtin_amdgcn_s_sleep(4); if (++sp > (1u << 16)) break; }
                          __builtin_amdgcn_fence(__ATOMIC_ACQUIRE, "agent"); VM_WAIT(); }
                      __syncthreads();
                      int ln = lane; asm volatile("" : "+v"(ln));
                      const int m0 = x * SEQ + j * 64 + wave * 8;
                      gla_combine_rows((const h16*)(args.ws + WS_OGLA), PROJ, (const float*)args.in[8], (h16*)(args.ws + WS_MIX), m0, m0 + 8, 1, ln);
                      __syncthreads(); }
              } } }
        if (BOTH(PH_MIX) || rep + 1 < REPS(PH_MIX)) xcd_barrier(bar);
    }
    if (IN(PH_COMB)) for (int rep = 0; rep < REPS(PH_COMB); ++rep) {
    }
    if (IN(PH_OUT)) for (int rep = 0; rep < REPS(PH_OUT); ++rep) {
        g8::PlainProb p{(const h16*)(args.ws + WS_MIX), (const h16*)(args.ws + WS_WOUTT), DM, DM, DM};
        g8::StaticOrder S; S.init(T / 256, DM / 256, G, bx);
        g8::EpiResid E{(const float*)args.in[0], (h16*)(args.ws + WS_X1H), (float*)(args.ws + WS_SSQ)};
        g8::gemm_phase<g8::PlainProb, g8::EpiResid, g8::StaticOrder, true>(lds, p, S, E);
        if (BOTH(PH_OUT) || rep + 1 < REPS(PH_OUT)) xcd_barrier(bar);
    }
    if (IN(PH_ROUTE)) {
        for (int blk = bx; blk < T / 64; blk += G)
            rt::route_block(lds, (const h16*)(args.ws + WS_X1H), (const h16*)(args.ws + WS_WRT16), (const float*)(args.ws + WS_SSQ), (const float*)args.in[18], (const float*)args.in[20],
                            (float*)(args.ws + WS_RS2), (int*)(args.ws + WS_TOKE), (int*)(args.ws + WS_TOKP), (float*)(args.ws + WS_TOKW), (int*)(args.ws + WS_ETOK), (float*)(args.ws + WS_ESC), (int*)(ctl + CW_CNT), blk * 64);
        if (BOTH(PH_ROUTE)) xcd_barrier(bar);
    }
    volatile LAS int* GT = (volatile LAS int*)(lds + MISC_OFF + 128);
    if (IN(PH_UP) || IN(PH_DOWN) || IN(PH_FIN)) {
        if (tid == 0) { int tp = 0, rb = 0; for (int e = 0; e < NEXP; ++e) { const int n = __hip_atomic_load((int*)(ctl + CW_CNT) + e, __ATOMIC_RELAXED, __HIP_MEMORY_SCOPE_AGENT); const int t = (n + 255) >> 8;
            GT[e] = tp; GT[64 + e] = rb; GT[128 + e] = n; tp += t; rb += t * 256; } GT[32] = tp; GT[64 + 32] = rb;
            int pf = 0, np = 0; for (int e = 0; e < NEXP; ++e) { const int n = GT[128 + e]; GT[192 + e] = pf; pf += n >> 8; if (n & 255) { GT[232 + np] = e; ++np; } } GT[192 + 32] = pf; }
        __syncthreads();
    }
    if (IN(PH_UP)) for (int rep = 0; rep < REPS(PH_UP); ++rep) {
        g8::GatherProb p{(const h16*)(args.ws + WS_X1H), (const h16*)(args.ws + WS_WGUT), (const int*)(args.ws + WS_ETOK), GT, DM, DM, DM};
        g8::DynGroupSched S{GT, 2, ctl + CW_MOEQ, MISC + 20};
        g8::EpiHid E{(const float*)(args.ws + WS_ESC), GT, (h16*)(args.ws + WS_HID), ctl + CW_DONE};
        g8::gemm_phase<g8::GatherProb, g8::EpiHid, g8::DynGroupSched, true, true>(lds, p, S, E);
        if (!IN(PH_DOWN)) { if (BOTH(PH_UP) || rep + 1 < REPS(PH_UP)) xcd_barrier(bar); }
        else __syncthreads();
    }
    if (IN(PH_DOWN)) for (int rep = 0; rep < REPS(PH_DOWN); ++rep) {
        g8::SlotProb p{(const h16*)(args.ws + WS_HID), (const h16*)(args.ws + WS_WDT), GT, DEXP, DEXP, DEXP};
        g8::DynGroupSchedDep S{{GT, 4, ctl + CW_MOEQ + 64, MISC + 22}, ctl + CW_DONE, 16u};
        g8::EpiY E{GT, (h16*)(args.ws + WS_Y)};
        g8::gemm_phase<g8::SlotProb, g8::EpiY, g8::DynGroupSchedDep, true, true>(lds, p, S, E);
        if (BOTH(PH_DOWN) || rep + 1 < REPS(PH_DOWN)) xcd_barrier(bar);
    }
    if (IN(PH_FIN)) {
        const h16* X1H = (const h16*)(args.ws + WS_X1H); const h16* Y = (const h16*)(args.ws + WS_Y);
        const int* TOKE = (const int*)(args.ws + WS_TOKE); const int* TOKP = (const int*)(args.ws + WS_TOKP);
        typedef _Float16 h8 __attribute__((ext_vector_type(8)));
        for (int q0 = 0; gw + NGW * q0 < T; q0 += 8) {
        int myslot = 0;
        { const int q = lane >> 1, r = lane & 1, m = gw + NGW * (q0 + q); if (lane < 16 && m < T) myslot = GT[64 + TOKE[m * 2 + r]] + TOKP[m * 2 + r]; }
        for (int q = 0; q < 8; q += 2) {
            const int mA = gw + NGW * (q0 + q), mB = mA + NGW; if (mA >= T) break;
            const bool hasB = mB < T;
            const int sA0 = __shfl(myslot, 2 * q), sA1 = __shfl(myslot, 2 * q + 1), sB0 = __shfl(myslot, 2 * q + 2), sB1 = __shfl(myslot, 2 * q + 3);
            h8 a[2][2], y0[2][2], y1[2][2];
#pragma unroll
            for (int j = 0; j < 2; ++j) { const int c = j * 512 + lane * 8;
                a[0][j] = *(const h8*)(X1H + (size_t)mA * DM + c); y0[0][j] = *(const h8*)(Y + (size_t)sA0 * DM + c); y1[0][j] = *(const h8*)(Y + (size_t)sA1 * DM + c);
                a[1][j] = *(const h8*)(X1H + (size_t)(hasB ? mB : mA) * DM + c); y0[1][j] = *(const h8*)(Y + (size_t)(hasB ? sB0 : sA0) * DM + c); y1[1][j] = *(const h8*)(Y + (size_t)(hasB ? sB1 : sA1) * DM + c); }
#pragma unroll
            for (int t2 = 0; t2 < 2; ++t2) { if (t2 == 1 && !hasB) break; const int m = t2 ? mB : mA;
#pragma unroll
                for (int j = 0; j < 2; ++j) { const int c = j * 512 + lane * 8; f32x4 o0, o1;
#pragma unroll
                    for (int k = 0; k < 4; ++k) { o0[k] = (float)a[t2][j][k] + ((float)y0[t2][j][k] + (float)y1[t2][j][k]); o1[k] = (float)a[t2][j][4 + k] + ((float)y0[t2][j][4 + k] + (float)y1[t2][j][4 + k]); }
                    *(f32x4*)(args.out + (size_t)m * DM + c) = o0; *(f32x4*)(args.out + (size_t)m * DM + c + 4) = o1; } }
        }
        }
    }
#undef IN
#undef BOTH
#undef REPS
}

extern "C" void kernel_launch(void* const* d_in, const int* in_sizes, int n_in, void* d_out, int out_size, void* d_ws, size_t ws_size, hipStream_t stream) {
    if (n_in != 24 || out_size != T * DM || ws_size < WS_END) { fprintf(stderr, "kernel_launch: unexpected shapes (n_in %d out %d ws %zu)\n", n_in, out_size, ws_size); return; }
    static int grid = 0;
    if (grid == 0) {
        int dev = 0, cus = 0;
        if (hipGetDevice(&dev) != hipSuccess || hipDeviceGetAttribute(&cus, hipDeviceAttributeMultiprocessorCount, dev) != hipSuccess) { fprintf(stderr, "kernel_launch: device query failed\n"); grid = -1; return; }
        if (hipFuncSetAttribute((const void*)mega_fwd, hipFuncAttributeMaxDynamicSharedMemorySize, LDS_BYTES) != hipSuccess) { fprintf(stderr, "kernel_launch: hipFuncSetAttribute failed\n"); grid = -1; return; }
        int per_cu = 0; (void)hipOccupancyMaxActiveBlocksPerMultiprocessor(&per_cu, (const void*)mega_fwd, NTHREADS, LDS_BYTES); (void)hipGetLastError();
        if (per_cu < 1) fprintf(stderr, "kernel_launch: note: occupancy query reports %d\n", per_cu);
        grid = cus;
    }
    if (grid < 0) return;
    char* ws = (char*)d_ws; float* out = (float*)d_out;
    (void)hipMemsetAsync(ws + WS_CTL, 0, CTL_ZERO_BYTES, stream);
    MArgs a{};
    for (int i = 0; i < 24; ++i) a.in[i] = d_in[i];
    a.out = out; a.ws = (unsigned char*)d_ws; a.ph_lo = 0; a.ph_hi = PH_END; a.li = 0;
    hipLaunchKernelGGL(mega_fwd, dim3(grid), dim3(NTHREADS), LDS_BYTES, stream, a);
}
```

```cpp
#include <hip/hip_runtime.h>
#include <cstdio>
#include <cstdint>

typedef _Float16 h16;

constexpr int BATCH = 8, SEQ = 2048, T = BATCH * SEQ, DM = 1024;
constexpr int NPROJ = 2048;
constexpr int PC_Q = 0, PC_K = 256, PC_V = 512, PC_GATE = 1024, PC_MQA = 1536, PC_MKVA = 1792, PC_KROPE = 1920, PC_LRF = 1952, PC_LRB = 1968;
constexpr int NEXP = 32, DEXP = 256;
constexpr int ECAP = 16384;
constexpr int SLOT_ROWS = 32768 + 32 * 256;
constexpr float EPS = 1e-6f;

constexpr size_t MiB = 1u << 20;
constexpr size_t WS_CTL = 0;
constexpr size_t WS_WINT = 1 * MiB;
constexpr size_t WS_WQBT = 5 * MiB;
constexpr size_t WS_WKVBT = 5 * MiB + 512 * 1024;
constexpr size_t WS_WOUTT = 6 * MiB;
constexpr size_t WS_WGUT = 8 * MiB;
constexpr size_t WS_WDT = 40 * MiB;
constexpr size_t WS_ROUTE = 56 * MiB;
constexpr size_t WS_RS2 = WS_ROUTE + 256 * 1024;
constexpr size_t WS_TOKE = WS_RS2 + 64 * 1024;
constexpr size_t WS_TOKP = WS_TOKE + 128 * 1024;
constexpr size_t WS_TOKW = WS_TOKP + 128 * 1024;
constexpr size_t WS_ETOK = WS_ROUTE + 1 * MiB;
constexpr size_t WS_A = 60 * MiB;
constexpr size_t WS_H1 = WS_A, WS_PROJ = WS_A + 32 * MiB, WS_MIX = WS_A, WS_Y = WS_A;
constexpr size_t WS_B = 156 * MiB;
constexpr size_t WS_QF = WS_B, WS_KF = WS_B + 24 * MiB, WS_VF = WS_B + 48 * MiB, WS_HID = WS_B;
constexpr size_t WS_OGLA = 220 * MiB;
constexpr size_t WS_X1H = WS_OGLA;
constexpr size_t WS_WRT16 = WS_ROUTE + 3 * MiB;
constexpr size_t WS_SSQ = 254 * MiB;
constexpr size_t WS_ESC = 200 * MiB;
constexpr size_t WS_CS = 252 * MiB;
constexpr size_t WS_END = 256 * MiB;

__device__ __forceinline__ int win_src_col(int n) {
    if (n < 1536) return n;
    if (n < 1792) return 1568 + (n - 1536);
    if (n < 1920) return 1824 + (n - 1792);
    if (n < 1952) return 1952 + (n - 1920);
    if (n < 1968) return 1536 + (n - 1952);
    if (n < 1984) return 1552 + (n - 1968);
    return -1;
}

#define LAS __attribute__((address_space(3)))
#define GAS __attribute__((address_space(1)))
typedef unsigned u32x4 __attribute__((ext_vector_type(4)));
typedef float f32x4 __attribute__((ext_vector_type(4)));
#define LDS_WAIT() asm volatile("s_waitcnt lgkmcnt(0)" ::: "memory")
#define VM_WAIT() asm volatile("s_waitcnt vmcnt(0)" ::: "memory")
constexpr int NWAVES = 8, NTHREADS = 512;
constexpr int RING_BYTES = 131072, MISC_OFF = RING_BYTES + 320, LDS_BYTES = 147456;
constexpr int CW_CNT = 0;
constexpr int CW_BAR = 4096;
constexpr int CW_GLADONE = 10240;
constexpr int CW_Q = 12288;
constexpr size_t CTL_ZERO_BYTES = 131072;
constexpr int CW_MOEQ = 14336;
constexpr int CW_DONE = 16384;
constexpr int PH_MIX = 3, PH_COMB = 4, PH_OUT = 5, PH_ROUTE = 6, PH_UP = 7, PH_DOWN = 8, PH_FIN = 9, PH_END = 10;

__device__ __forceinline__ unsigned pk_h2(float a, float b) { typedef _Float16 h2 __attribute__((ext_vector_type(2))); h2 v = {(h16)a, (h16)b}; return __builtin_bit_cast(unsigned, v); }

#define XB_TMO      128
#define XB_XCNT(j)  (256  + 64 * (j))
#define XB_XSUB(j)  (1280 + 64 * (j))
#define XB_XGEN(j)  (2304 + 64 * (j))
#define XB_TOP      3328
#define XB_TOPGEN   3392
#define XCD_BAR_WORDS 3456
#define XB_SPIN_CAP (1u << 18)
__device__ __forceinline__ unsigned xb_ld(unsigned* p)              { return __hip_atomic_load(p, __ATOMIC_RELAXED, __HIP_MEMORY_SCOPE_AGENT); }
__device__ __forceinline__ unsigned xb_add(unsigned* p, unsigned v) { return __hip_atomic_fetch_add(p, v, __ATOMIC_RELAXED, __HIP_MEMORY_SCOPE_AGENT); }
__device__ __forceinline__ unsigned xb_xcc_id() { return (unsigned)__builtin_amdgcn_s_getreg((3 << 11) | 20) & 0xFu; }
#define XB_SPIN(cond, bar) do { unsigned _sp = 0; while (cond) { __builtin_amdgcn_s_sleep(1); \
    if ((++_sp & 255u) == 0u) { if (xb_ld(&(bar)[XB_TMO])) break; if (_sp > XB_SPIN_CAP) { atomicAdd(&(bar)[XB_TMO], 1u); break; } } } } while (0)
struct XcdBarrier { unsigned* bar; unsigned x; volatile LAS unsigned* st; };
__device__ __forceinline__ XcdBarrier xcd_barrier_post(unsigned* bar, volatile LAS unsigned* st) {
    XcdBarrier b; b.bar = bar; b.x = xb_xcc_id(); b.st = st;
    if (threadIdx.x == 0) (void)xb_add(&bar[XB_XCNT(b.x)], 1u);
    return b;
}
__device__ __forceinline__ void xcd_barrier_complete(unsigned* bar, unsigned x, unsigned& nloc, unsigned& nx) {
    const unsigned G = gridDim.x * gridDim.y * gridDim.z;
    unsigned sum, cnt, mine, sp = 0u;
    for (;;) {
        sum = 0u; cnt = 0u; mine = 0u;
#pragma unroll
        for (unsigned j = 0; j < 16; ++j) { const unsigned c = xb_ld(&bar[XB_XCNT(j)]); sum += c; cnt += (c > 0u) ? 1u : 0u; mine = (j == x) ? c : mine; }
        if (sum == G) break;
        __builtin_amdgcn_s_sleep(1);
        if ((++sp & 255u) == 0u) { if (xb_ld(&bar[XB_TMO])) break; if (sp > XB_SPIN_CAP) { atomicAdd(&bar[XB_TMO], 1u); break; } }
    }
    nloc = mine > 0u ? mine : 1u; nx = cnt > 0u ? cnt : 1u;
}
__device__ __forceinline__ void xcd_barrier(const XcdBarrier& b) {
    asm volatile("s_waitcnt vmcnt(0)" ::: "memory");
    __syncthreads();
    if (threadIdx.x == 0) {
        unsigned* bar = b.bar;
        __builtin_amdgcn_s_waitcnt(0);
        unsigned nloc = b.st[0], nx = b.st[1];
        if (nloc == 0u) { xcd_barrier_complete(bar, b.x, nloc, nx); b.st[0] = nloc; b.st[1] = nx; }
        const unsigned old = xb_add(&bar[XB_XSUB(b.x)], 1u);
        const unsigned gen = old / nloc;
        if (old + 1u == (gen + 1u) * nloc) {
            __builtin_amdgcn_fence(__ATOMIC_RELEASE, "agent");
            asm volatile("s_waitcnt vmcnt(0)" ::: "memory");
            const unsigned og = xb_add(&bar[XB_TOP], 1u);
            const unsigned tg = og / nx;
            if (og + 1u == (tg + 1u) * nx) xb_add(&bar[XB_TOPGEN], 1u);
            else XB_SPIN(xb_ld(&bar[XB_TOPGEN]) == tg, bar);
            __builtin_amdgcn_fence(__ATOMIC_ACQUIRE, "agent");
            xb_add(&bar[XB_XGEN(b.x)], 1u);
            asm volatile("s_waitcnt vmcnt(0)" ::: "memory");
        } else {
            XB_SPIN(xb_ld(&bar[XB_XGEN(b.x)]) == gen, bar);
            __builtin_amdgcn_fence(__ATOMIC_ACQUIRE, "agent");
            asm volatile("s_waitcnt vmcnt(0)" ::: "memory");
        }
    }
    __syncthreads();
}

template <int NBATCH>
__device__ __forceinline__ void tr_item(const float* __restrict__ src, int src_ld, int k0, int c0, h16* __restrict__ dst, int dst_ld, long row0, int rstride,
                                        const float* __restrict__ kg, float scale, LAS float* scr, int lane) {
#pragma unroll
    for (int bt = 0; bt < 32 / NBATCH; ++bt) {
        float tv[NBATCH];
#pragma unroll
        for (int i = 0; i < NBATCH; ++i) { const int kk = 2 * (bt * NBATCH + i) + (lane >> 5); tv[i] = src[(size_t)(k0 + kk) * src_ld + c0 + (lane & 31)]; }
#pragma unroll
        for (int i = 0; i < NBATCH; ++i) { const int kk = 2 * (bt * NBATCH + i) + (lane >> 5); float v = tv[i] * scale; if (kg) v *= kg[k0 + kk]; scr[kk * 33 + (lane & 31)] = v; }
    }
    LDS_WAIT(); asm volatile("" ::: "memory");
    const int c = lane & 7;
#pragma unroll
    for (int j = 0; j < 4; ++j) { const int n = (lane >> 3) + 8 * j; const LAS float* s = scr + (8 * c) * 33 + n;
        u32x4 o; o.x = pk_h2(s[0 * 33], s[1 * 33]); o.y = pk_h2(s[2 * 33], s[3 * 33]); o.z = pk_h2(s[4 * 33], s[5 * 33]); o.w = pk_h2(s[6 * 33], s[7 * 33]);
        *(u32x4*)(dst + (size_t)(row0 + (long)n * rstride) * dst_ld + k0 + 8 * c) = o; }
    LDS_WAIT(); asm volatile("" ::: "memory");
}
struct TrP { const float* src; int src_ld, k0, c0; h16* dst; int dst_ld; long row0; int rstride; const float* kg; };
__device__ __forceinline__ void tr_load(const TrP& p, float (&tv)[32], int lane) {
#pragma unroll
    for (int i = 0; i < 32; ++i) { const int kk = 2 * i + (lane >> 5); tv[i] = p.src[(size_t)(p.k0 + kk) * p.src_ld + p.c0 + (lane & 31)]; }
}
__device__ __forceinline__ void tr_finish(const TrP& p, const float (&tv)[32], LAS float* scr, int lane) {
#pragma unroll
    for (int i = 0; i < 32; ++i) { const int kk = 2 * i + (lane >> 5); float v = tv[i]; if (p.kg) v *= p.kg[p.k0 + kk]; scr[kk * 33 + (lane & 31)] = v; }
    LDS_WAIT(); asm volatile("" ::: "memory");
    const int c = lane & 7;
#pragma unroll
    for (int j = 0; j < 4; ++j) { const int n = (lane >> 3) + 8 * j; const LAS float* s = scr + (8 * c) * 33 + n;
        u32x4 o; o.x = pk_h2(s[0 * 33], s[1 * 33]); o.y = pk_h2(s[2 * 33], s[3 * 33]); o.z = pk_h2(s[4 * 33], s[5 * 33]); o.w = pk_h2(s[6 * 33], s[7 * 33]);
        *(u32x4*)(p.dst + (size_t)(p.row0 + (long)n * p.rstride) * p.dst_ld + p.k0 + 8 * c) = o; }
    LDS_WAIT(); asm volatile("" ::: "memory");
}
__device__ __forceinline__ float wave_sum(float v) {
#pragma unroll
    for (int o = 1; o < 64; o <<= 1) v += __shfl_xor(v, o);
    return v;
}
struct MArgs { const void* in[24]; float* out; unsigned char* ws; int ph_lo, ph_hi, li, pad; };

__device__ __forceinline__ TrP expert_params(const MArgs& a, int r) {
    unsigned char* ws = a.ws;
    const float* wg = (const float*)a.in[21]; const float* wu = (const float*)a.in[22]; const float* wd = (const float*)a.in[23]; const float* gain2 = (const float*)a.in[16];
    h16* WguT = (h16*)(ws + WS_WGUT); h16* WdT = (h16*)(ws + WS_WDT);
    if (r < 8192) { const int e = r >> 8, sx = (r >> 7) & 1, kb = (r >> 3) & 15, nb = r & 7;
        return TrP{(sx ? wu : wg) + (size_t)e * 1024 * 256, 256, 64 * kb, 32 * nb, WguT, 1024, (long)e * 512 + 64 * nb + sx, 2, gain2}; }
    r -= 8192; const int e = r >> 7, kb = (r >> 5) & 3, nb = r & 31;
    return TrP{wd + (size_t)e * 256 * 1024, 1024, 64 * kb, 32 * nb, WdT, 256, (long)e * 1024 + 32 * nb, 1, nullptr};
}
__device__ __forceinline__ void expert_items4(const MArgs& a, int r0, LAS float* scr, int lane) {
    float ta[32], tb[32], tc[32], td[32];
    const TrP p0 = expert_params(a, r0), p1 = expert_params(a, r0 + 1), p2 = expert_params(a, r0 + 2), p3 = expert_params(a, r0 + 3);
    tr_load(p0, ta, lane); tr_load(p1, tb, lane); tr_load(p2, tc, lane); tr_load(p3, td, lane);
    tr_finish(p0, ta, scr, lane); tr_finish(p1, tb, scr, lane); tr_finish(p2, tc, scr, lane); tr_finish(p3, td, scr, lane);
}

__device__ __forceinline__ void p0_prologue(const MArgs& a, LAS unsigned char* lds, int gw, int NGW, int lane, int wave) {
    unsigned char* ws = a.ws;
    LAS float* scr = (LAS float*)(lds + wave * 16384);
    const float* w_in = (const float*)a.in[3]; const float* w_qb = (const float*)a.in[10]; const float* w_kvb = (const float*)a.in[12]; const float* w_out = (const float*)a.in[15];
    const float* wg = (const float*)a.in[21]; const float* wu = (const float*)a.in[22]; const float* wd = (const float*)a.in[23];
    const float* q_gain = (const float*)a.in[9]; const float* kv_gain = (const float*)a.in[11]; const float* gain2 = (const float*)a.in[16];
    h16* WinT = (h16*)(ws + WS_WINT); h16* WqbT = (h16*)(ws + WS_WQBT); h16* WkvbT = (h16*)(ws + WS_WKVBT); h16* WoutT = (h16*)(ws + WS_WOUTT);
    h16* WguT = (h16*)(ws + WS_WGUT); h16* WdT = (h16*)(ws + WS_WDT);
    constexpr int I_IN = 16 * 62, I_OUT = 16 * 32, I_QB = 4 * 24, I_KVB = 2 * 32;
    constexpr int NITEMS = I_IN + I_OUT + I_QB + I_KVB;
    for (int it = gw; it < NITEMS; it += NGW) {
        int r = it;
        if (r < I_IN) { const int kb = r / 62, nb = r % 62, n0 = 32 * nb;
            tr_item<32>(w_in, 1984, 64 * kb, win_src_col(n0), WinT, 1024, n0, 1, nullptr, n0 < 256 ? 0.125f : 1.f, scr, lane); continue; }
        r -= I_IN;
        if (r < I_OUT) { const int kb = r >> 5, nb = r & 31;
            tr_item<32>(w_out, 1024, 64 * kb, 32 * nb, WoutT, 1024, 32 * nb, 1, nullptr, 1.f, scr, lane); continue; }
        r -= I_OUT;
        if (r < I_QB) { const int kb = r / 24, nb = r % 24, c0 = 32 * nb, h = c0 / 96, d0 = c0 % 96;
            tr_item<32>(w_qb, 768, 64 * kb, c0, WqbT, 256, h * 128 + d0, 1, q_gain, 1.f, scr, lane); continue; }
        r -= I_QB;
        { const int kb = r >> 5, nb = r & 31;
            tr_item<32>(w_kvb, 1024, 64 * kb, 32 * nb, WkvbT, 256, 32 * nb, 1, kv_gain, 1.f, scr, lane); }
    }
    const u32x4 z4 = {0u, 0u, 0u, 0u};
    for (int i = gw; i < 128; i += NGW) *(u32x4*)((char*)(WinT + (size_t)1984 * 1024) + (size_t)i * 1024 + lane * 16) = z4;
    for (int i = gw; i < 128; i += NGW) { const int row = (i >> 4) * 128 + 96 + 2 * (i & 15) + (lane >> 5);
        *(u32x4*)((char*)(WqbT + (size_t)row * 256) + (lane & 31) * 16) = z4; }
    for (int i = gw; i < 256; i += NGW) { const int row = i * 4 + (lane >> 4);
        *(u32x4*)((char*)(WkvbT + (size_t)row * 256 + 128) + (lane & 15) * 16) = z4; }
    { const float* wrg = (const float*)a.in[17]; const float* wre = (const float*)a.in[19]; h16* W16 = (h16*)(ws + WS_WRT16);
      for (int i = gw; i < 256 * 1024 / 64; i += NGW) { const int idx = i * 64 + lane, k = idx & 1023, j = idx >> 10; float v = 0.f;
          if (j < 4) v = wrg[k * 4 + j] * gain2[k]; else if (j < 36) v = wre[k * 32 + (j - 4)] * gain2[k];
          W16[idx] = (h16)v; } }
    { const int* positions = (const int*)a.in[1]; float* CS = (float*)(ws + WS_CS);
      for (int i = gw; i < T * 16 / 64; i += NGW) { const int idx = i * 64 + lane, m = idx >> 4, fi = idx & 15;
          const float inv = exp2f(-(float)fi * (13.287712379549449f / 16.0f)); const float ang = (float)positions[m] * inv;
          CS[m * 32 + fi] = cosf(ang); CS[m * 32 + 16 + fi] = sinf(ang); } }
    { const float* x = (const float*)a.in[0]; const float* g1 = (const float*)a.in[2]; h16* H1 = (h16*)(ws + WS_H1);
      f32x4 g[4];
#pragma unroll
      for (int j = 0; j < 4; ++j) g[j] = ((const f32x4*)g1)[lane + 64 * j];
      for (int m = gw; m < T; m += 2 * NGW) {
          const int m2 = m + NGW;
          const f32x4* xr = (const f32x4*)(x + (size_t)m * DM) + lane; const f32x4* xr2 = (const f32x4*)(x + (size_t)(m2 < T ? m2 : m) * DM) + lane;
          f32x4 v[4], v2[4]; float s = 0.f, s2 = 0.f;
#pragma unroll
          for (int j = 0; j < 4; ++j) { v[j] = xr[64 * j]; v2[j] = xr2[64 * j]; }
#pragma unroll
          for (int j = 0; j < 4; ++j) { s += (v[j].x * v[j].x + v[j].y * v[j].y) + (v[j].z * v[j].z + v[j].w * v[j].w); s2 += (v2[j].x * v2[j].x + v2[j].y * v2[j].y) + (v2[j].z * v2[j].z + v2[j].w * v2[j].w); }
          const float rs = rsqrtf(wave_sum(s) * (1.f / DM) + EPS), rs2 = rsqrtf(wave_sum(s2) * (1.f / DM) + EPS);
          unsigned long long* o8 = (unsigned long long*)(H1 + (size_t)m * DM) + lane;
#pragma unroll
          for (int j = 0; j < 4; ++j) o8[64 * j] = (unsigned long long)pk_h2(v[j].x * rs * g[j].x, v[j].y * rs * g[j].y) | ((unsigned long long)pk_h2(v[j].z * rs * g[j].z, v[j].w * rs * g[j].w) << 32);
          if (m2 < T) { unsigned long long* p8 = (unsigned long long*)(H1 + (size_t)m2 * DM) + lane;
#pragma unroll
              for (int j = 0; j < 4; ++j) p8[64 * j] = (unsigned long long)pk_h2(v2[j].x * rs2 * g[j].x, v2[j].y * rs2 * g[j].y) | ((unsigned long long)pk_h2(v2[j].z * rs2 * g[j].z, v2[j].w * rs2 * g[j].w) << 32); }
      } }
}

namespace g8 {
typedef _Float16 f16x8 __attribute__((ext_vector_type(8)));
constexpr int BM = 256, BK = 64, HALF = 128, HTB = HALF * BK * 2, STAGE_BYTES = 8 * HTB, NXCD = 8, WGM = 8;
__host__ __device__ __forceinline__ int lds_byte(int r, int c) { const int st = (r >> 4) * 2 + (c >> 5), rr = r & 15, cc = c & 31, ob = rr * 64 + cc * 2; return st * 1024 + (ob ^ (((ob >> 9) & 1) << 5)); }
__host__ __device__ __forceinline__ void stage_rc(int b, int& R, int& C) { const int st = b / 1024, sb = b % 1024, swz = sb ^ (((sb >> 9) & 1) << 5); R = (st >> 1) * 16 + swz / 64; C = (st & 1) * 32 + (swz % 64) / 2; }
__host__ __device__ __forceinline__ int perm32(int rho) { const int n = rho >> 4, i = rho & 15; return 8 * (i >> 2) + 4 * n + (i & 3); }
struct Unit { int pm, pn, e, half; };
struct StaticOrder {
    int nM, nN, nwg, G, c;
    __device__ __forceinline__ void init(int nM_, int nN_, int G_, int c_) { nM = nM_; nN = nN_; nwg = nM * nN; G = G_; c = c_; }
    __device__ __forceinline__ bool next(int i, Unit& u) const {
        const long L = (long)i * G + c; if (L >= nwg) return false;
        int wgid = (int)L; { const int q = nwg / NXCD, r = nwg % NXCD, xcd = wgid % NXCD, off = wgid / NXCD; wgid = (xcd < r ? xcd * (q + 1) : r * (q + 1) + (xcd - r) * q) + off; }
        const int nig = WGM * nN, gid = wgid / nig, fm = gid * WGM, gsz = (nM - fm) < WGM ? (nM - fm) : WGM;
        u.pm = fm + ((wgid % nig) % gsz); u.pn = (wgid % nig) / gsz; u.e = 0; u.half = 0; return true;
    }
    __device__ __forceinline__ void a_ready(const Unit&) const {}
};
struct PlainProb {
    const h16* A; const h16* Bt; int lda, ldb, K;
    __device__ __forceinline__ const char* a_base() const { return (const char*)A; }
    __device__ __forceinline__ unsigned a_row_off(const Unit& u, int h, int R) const { return (unsigned)((u.pm * BM + h * HALF + R) * lda); }
    __device__ __forceinline__ const char* b_base(const Unit& u) const { return (const char*)(Bt + (size_t)u.pn * BM * ldb); }
};

template <class P, class Epi, class Sched, bool ALIGN_EPI, bool HALFSKIP = false>
__device__ __forceinline__ void gemm_phase(LAS unsigned char* lds, const P& p, const Sched& S, const Epi& E) {
    const int tid = threadIdx.x, wid = __builtin_amdgcn_readfirstlane(tid >> 6), lane = tid & 63, wr = wid >> 2, wc = wid & 3, fr = lane & 15, fq = lane >> 4;
    const int K = p.K, nt = K / BK;
    int Rs[2], Cs[2]; unsigned voffB[2];
#pragma unroll
    for (int i = 0; i < 2; ++i) { int R, C; stage_rc(tid * 16 + i * 8192, R, C); Rs[i] = R; Cs[i] = C; const int Rb = Epi::PERM ? ((R & ~31) + perm32(R & 31)) : R; voffB[i] = (unsigned)(Rb * p.ldb + C) * 2u; }
    const size_t kstep = (size_t)(BK * 2);
    const size_t hstepB = (size_t)HALF * p.ldb * 2;
    const unsigned ldsw = (unsigned)wid * 1024u;
    const int aoff = lds_byte(wr * 64 + fr, fq * 8), boff = lds_byte(wc * 32 + fr, fq * 8);
#define G8_SA(b, h) (((b) * 2 + (h)) * HTB)
#define G8_SB(b, h) ((4 + (b) * 2 + (h)) * HTB)
#define G8_STAGE(bufoff, gbase, voff) do { _Pragma("unroll") for (int _i = 0; _i < 2; ++_i) \
        __builtin_amdgcn_global_load_lds((const unsigned*)((const char*)(gbase) + (voff)[_i]), (LAS unsigned*)(lds + (bufoff) + ldsw + _i * 8192), 16, 0, 0); } while (0)
#define G8_LDA(dst, b, h) do { _Pragma("unroll") for (int m = 0; m < 4; ++m) _Pragma("unroll") for (int k = 0; k < 2; ++k) dst[m][k] = *(const LAS f16x8*)(lds + G8_SA(b, h) + aoff + m * 2048 + k * 1024); } while (0)
#define G8_LDB(dst, b, h) do { _Pragma("unroll") for (int n = 0; n < 2; ++n) _Pragma("unroll") for (int k = 0; k < 2; ++k) dst[n][k] = *(const LAS f16x8*)(lds + G8_SB(b, h) + boff + n * 2048 + k * 1024); } while (0)
#define G8_MMA(ai, bj, At, Bt) do { __builtin_amdgcn_s_setprio(1); _Pragma("unroll") for (int m = 0; m < 4; ++m) _Pragma("unroll") for (int n = 0; n < 2; ++n) _Pragma("unroll") for (int k = 0; k < 2; ++k) \
        acc[ai][bj][m][n] = __builtin_amdgcn_mfma_f32_16x16x32_f16(Bt[n][k], At[m][k], acc[ai][bj][m][n], 0, 0, 0); __builtin_amdgcn_s_setprio(0); } while (0)
#define G8_WAIT_V(n) asm volatile("s_waitcnt vmcnt(" #n ")" ::: "memory")
#define G8_WAIT_L(n) asm volatile("s_waitcnt lgkmcnt(" #n ")" ::: "memory")
#define G8_BAR __builtin_amdgcn_s_barrier()
#define G8_SCHED __builtin_amdgcn_sched_barrier(0)
    Unit cur, nxt; int ui = 0;
    if (!S.next(0, cur)) return;
    f32x4 acc[2][2][4][2];
#pragma unroll
    for (int a = 0; a < 2; ++a)
#pragma unroll
        for (int b = 0; b < 2; ++b)
#pragma unroll
            for (int m = 0; m < 4; ++m)
#pragma unroll
                for (int n = 0; n < 2; ++n) acc[a][b][m][n] = (f32x4){0.f, 0.f, 0.f, 0.f};
    f16x8 At[4][2], B0[2][2], B1[2][2];
    const char* const A0 = p.a_base();
    unsigned vAc[2][2], vAn[2][2];
#pragma unroll
    for (int h = 0; h < 2; ++h)
#pragma unroll
        for (int i = 0; i < 2; ++i) vAc[h][i] = (p.a_row_off(cur, h, Rs[i]) + (unsigned)Cs[i]) * 2u;
    const char* cB = p.b_base(cur);
    S.a_ready(cur);
    G8_STAGE(G8_SB(0, 0), cB, voffB); G8_STAGE(G8_SB(0, 1), cB + hstepB, voffB); G8_STAGE(G8_SA(0, 0), A0, vAc[0]); G8_STAGE(G8_SA(0, 1), A0, vAc[1]);
    if (wr == 1) G8_BAR;
    G8_WAIT_V(2); G8_BAR;
    G8_STAGE(G8_SB(1, 0), cB + kstep, voffB); G8_STAGE(G8_SA(1, 0), A0 + kstep, vAc[0]); G8_STAGE(G8_SB(1, 1), cB + hstepB + kstep, voffB);
    G8_WAIT_V(6); G8_BAR;
    for (;;) {
        const bool has_next = S.next(ui + 1, nxt);
        if (has_next) {
#pragma unroll
            for (int h = 0; h < 2; ++h)
#pragma unroll
                for (int i = 0; i < 2; ++i) vAn[h][i] = (p.a_row_off(nxt, h, Rs[i]) + (unsigned)Cs[i]) * 2u;
        } else {
#pragma unroll
            for (int h = 0; h < 2; ++h)
#pragma unroll
                for (int i = 0; i < 2; ++i) vAn[h][i] = vAc[h][i];
        }
        const char* nB = has_next ? p.b_base(nxt) : cB;
        const bool skip1 = HALFSKIP && cur.half != 0;
        for (int t = 0; t < nt; t += 2) {
            const bool last = (t == nt - 2);
            if (last && has_next) S.a_ready(nxt);
            const char* a1 = A0 + (size_t)(t + 1) * kstep;
            const char* a2 = last ? A0 : A0 + (size_t)(t + 2) * kstep; const char* b2 = last ? nB : cB + (size_t)(t + 2) * kstep;
            const char* a3 = a2 + kstep; const char* b3 = b2 + kstep;
            unsigned v2[2][2];
#pragma unroll
            for (int h = 0; h < 2; ++h)
#pragma unroll
                for (int i = 0; i < 2; ++i) v2[h][i] = last ? vAn[h][i] : vAc[h][i];
            G8_LDB(B0, 0, 0); G8_LDB(B1, 0, 1); G8_SCHED; G8_LDA(At, 0, 0); G8_STAGE(G8_SA(1, 1), a1, vAc[1]);
            G8_WAIT_V(8); G8_WAIT_L(0); G8_BAR; G8_MMA(0, 0, At, B0); G8_MMA(0, 1, At, B1); G8_BAR; G8_SCHED;
            if (!skip1) G8_LDA(At, 0, 1); G8_STAGE(G8_SB(0, 0), b2, voffB); G8_STAGE(G8_SB(0, 1), b2 + hstepB, voffB); G8_STAGE(G8_SA(0, 0), a2, v2[0]);
            G8_WAIT_V(8); G8_WAIT_L(0); G8_BAR; if (!skip1) { G8_MMA(1, 0, At, B0); G8_MMA(1, 1, At, B1); } G8_BAR; G8_SCHED;
            G8_LDB(B0, 1, 0); G8_LDB(B1, 1, 1); G8_SCHED; G8_LDA(At, 1, 0); G8_STAGE(G8_SA(0, 1), a2, v2[1]);
            G8_WAIT_V(8); G8_WAIT_L(0); G8_BAR; G8_MMA(0, 0, At, B0); G8_MMA(0, 1, At, B1); G8_BAR; G8_SCHED;
            if (!skip1) G8_LDA(At, 1, 1); G8_STAGE(G8_SB(1, 0), b3, voffB); G8_STAGE(G8_SB(1, 1), b3 + hstepB, voffB); G8_STAGE(G8_SA(1, 0), a3, v2[0]);
            G8_WAIT_V(8); G8_WAIT_L(0); G8_BAR; if (!skip1) { G8_MMA(1, 0, At, B0); G8_MMA(1, 1, At, B1); } G8_BAR; G8_SCHED;
        }
        if constexpr (ALIGN_EPI) { if (wr == 0) G8_BAR; }
        if constexpr (!Epi::AFTER_DRAIN) { E(acc, cur, wr, wc, fr, fq); }
        if (!has_next) break;
#pragma unroll
        for (int a = 0; a < 2; ++a)
#pragma unroll
            for (int b = 0; b < 2; ++b)
#pragma unroll
                for (int m = 0; m < 4; ++m)
#pragma unroll
                    for (int n = 0; n < 2; ++n) acc[a][b][m][n] = (f32x4){0.f, 0.f, 0.f, 0.f};
        cur = nxt; cB = nB; ++ui;
#pragma unroll
        for (int h = 0; h < 2; ++h)
#pragma unroll
            for (int i = 0; i < 2; ++i) vAc[h][i] = vAn[h][i];
        if constexpr (ALIGN_EPI) { if (wr == 1) G8_BAR; }
    }
    G8_WAIT_V(0);
    if constexpr (!ALIGN_EPI) { if (wr == 0) G8_BAR; }
    G8_BAR;
    if constexpr (Epi::AFTER_DRAIN) { E.fused(acc, cur, wr, wc, fr, fq, lds, wid, lane); }
#undef G8_SA
#undef G8_SB
#undef G8_STAGE
#undef G8_LDA
#undef G8_LDB
#undef G8_MMA
#undef G8_WAIT_V
#undef G8_WAIT_L
#undef G8_BAR
#undef G8_SCHED
}
struct EpiH16 {
    static constexpr bool PERM = true, AFTER_DRAIN = false;
    h16* O; int ldc;
    __device__ __forceinline__ void operator()(const f32x4 (&acc)[2][2][4][2], const Unit& u, int wr, int wc, int fr, int fq) const {
        const int row0 = u.pm * BM + wr * 64 + fr, col0 = u.pn * BM + wc * 32 + 8 * fq;
#pragma unroll
        for (int ai = 0; ai < 2; ++ai)
#pragma unroll
            for (int m = 0; m < 4; ++m) { h16* rowp = O + (size_t)(row0 + ai * HALF + m * 16) * ldc + col0;
#pragma unroll
                for (int bj = 0; bj < 2; ++bj) { const f32x4 v0 = acc[ai][bj][m][0], v1 = acc[ai][bj][m][1];
                    u32x4 w; w.x = pk_h2(v0[0], v0[1]); w.y = pk_h2(v0[2], v0[3]); w.z = pk_h2(v1[0], v1[1]); w.w = pk_h2(v1[2], v1[3]);
                    *(u32x4*)(rowp + bj * HALF) = w; } }
    }
};
struct OneUnit { Unit u; __device__ __forceinline__ bool next(int i, Unit& o) const { if (i) return false; o = u; return true; } __device__ __forceinline__ void a_ready(const Unit&) const {} };
typedef unsigned u32x2 __attribute__((ext_vector_type(2)));
__device__ __forceinline__ float ssq8(const u32x4 w) {
    typedef _Float16 h2 __attribute__((ext_vector_type(2))); float s = 0.f;
#pragma unroll
    for (int i = 0; i < 4; ++i) { const unsigned ui = w[i]; const h2 v = __builtin_bit_cast(h2, ui); const float a = (float)v.x, b = (float)v.y; s += a * a + b * b; }
    return s;
}
struct EpiQ {
    static constexpr bool PERM = false, AFTER_DRAIN = true;
    const h16* PROJ; const float* qn_gain; const float* CS; h16* QF;
    __device__ __forceinline__ void fused(f32x4 (&acc)[2][2][4][2], const Unit& u, int wr, int wc, int fr, int fq, LAS unsigned char* lds, int wid, int lane) const {
        LAS float* P = (LAS float*)lds;
        LAS float* RS = (LAS float*)(lds + 8192);
        const int tid = wid * 64 + lane;
#pragma unroll
        for (int ai = 0; ai < 2; ++ai)
#pragma unroll
            for (int m = 0; m < 4; ++m)
#pragma unroll
                for (int bj = 0; bj < 2; ++bj) { float sq = 0.f;
#pragma unroll
                    for (int n = 0; n < 2; ++n) { const f32x4 x = acc[ai][bj][m][n]; sq += (x[0] * x[0] + x[1] * x[1]) + (x[2] * x[2] + x[3] * x[3]); }
                    sq += __shfl_xor(sq, 16); sq += __shfl_xor(sq, 32);
                    if (fq == 0) P[((ai * HALF + wr * 64 + m * 16 + fr) * 2 + bj) * 4 + wc] = sq; }
        { const int row = tid >> 1, half = tid & 1; const u32x4* ap = (const u32x4*)(PROJ + (size_t)(u.pm * BM + row) * NPROJ + PC_MQA + half * 128); float sq = 0.f;
#pragma unroll
          for (int i = 0; i < 16; ++i) sq += ssq8(ap[i]);
          sq += __shfl_xor(sq, 1);
          if (half == 0) RS[row] = rsqrtf(sq * (1.f / 256.f) + EPS); }
        LDS_WAIT(); __builtin_amdgcn_s_barrier(); asm volatile("" ::: "memory");
        if (wc == 3) return;
        const float QS = 0.10206207261596577f * 1.4426950408889634f;
#pragma unroll
        for (int ai = 0; ai < 2; ++ai)
#pragma unroll
            for (int m = 0; m < 4; ++m) { const int r = ai * HALF + wr * 64 + m * 16 + fr, gm = u.pm * BM + r, b = gm / SEQ, sp = gm % SEQ; const float rq = RS[r];
                f32x4 cs = {1.f, 1.f, 1.f, 1.f}, sn = {0.f, 0.f, 0.f, 0.f};
                if (wc == 2) { cs = *(const f32x4*)(CS + (size_t)gm * 32 + 4 * fq); sn = *(const f32x4*)(CS + (size_t)gm * 32 + 16 + 4 * fq); }
#pragma unroll
                for (int bj = 0; bj < 2; ++bj) { const f32x4 pp = *(const LAS f32x4*)(P + (r * 2 + bj) * 4); const float tot = (pp[0] + pp[1]) + (pp[2] + pp[3]);
                    const float sc = rq * rsqrtf(rq * rq * tot * (1.f / 96.f) + EPS) * QS;
                    const int d0 = wc * 32 + 4 * fq; const f32x4 g0 = *(const f32x4*)(qn_gain + d0), g1 = *(const f32x4*)(qn_gain + d0 + 16);
                    f32x4 v0 = acc[ai][bj][m][0] * g0 * sc, v1 = acc[ai][bj][m][1] * g1 * sc;
                    if (wc == 2) { const f32x4 t1 = v0, t2 = v1; v0 = t1 * cs - t2 * sn; v1 = t1 * sn + t2 * cs; }
                    h16* qp = QF + ((size_t)(b * 8 + u.pn * 2 + bj) * SEQ + sp) * 96 + d0;
                    u32x2 w0, w1; w0.x = pk_h2(v0[0], v0[1]); w0.y = pk_h2(v0[2], v0[3]); w1.x = pk_h2(v1[0], v1[1]); w1.y = pk_h2(v1[2], v1[3]);
                    *(u32x2*)qp = w0; *(u32x2*)(qp + 16) = w1; } }
    }
};
struct EpiKV {
    static constexpr bool PERM = false, AFTER_DRAIN = true;
    const h16* PROJ; const float* kn_gain; const float* CS; h16* KF; h16* VF;
    __device__ __forceinline__ void fused(f32x4 (&acc)[2][2][4][2], const Unit& u, int wr, int wc, int fr, int fq, LAS unsigned char* lds, int wid, int lane) const {
        LAS float* P = (LAS float*)lds;
        LAS float* RS = (LAS float*)(lds + 8192);
        LAS float* KR = (LAS float*)(lds + 8192 + 1024);
        const int tid = wid * 64 + lane;
        if (wc < 2) {
#pragma unroll
            for (int ai = 0; ai < 2; ++ai)
#pragma unroll
                for (int m = 0; m < 4; ++m)
#pragma unroll
                    for (int bj = 0; bj < 2; ++bj) { float sq = 0.f;
#pragma unroll
                        for (int n = 0; n < 2; ++n) { const f32x4 x = acc[ai][bj][m][n]; sq += (x[0] * x[0] + x[1] * x[1]) + (x[2] * x[2] + x[3] * x[3]); }
                        sq += __shfl_xor(sq, 16); sq += __shfl_xor(sq, 32);
                        if (fq == 0) P[((ai * HALF + wr * 64 + m * 16 + fr) * 2 + bj) * 2 + wc] = sq; }
        }
        { const int row = tid >> 1, half = tid & 1; const h16* rp = PROJ + (size_t)(u.pm * BM + row) * NPROJ;
          const u32x4* ap = (const u32x4*)(rp + PC_MKVA + half * 64); float sq = 0.f;
#pragma unroll
          for (int i = 0; i < 8; ++i) sq += ssq8(ap[i]);
          const u32x4* kp = (const u32x4*)(rp + PC_KROPE + half * 16); float kq = ssq8(kp[0]) + ssq8(kp[1]);
          sq += __shfl_xor(sq, 1); kq += __shfl_xor(kq, 1);
          if (half == 0) { RS[row] = rsqrtf(sq * (1.f / 128.f) + EPS); KR[row] = kq; } }
        LDS_WAIT(); __builtin_amdgcn_s_barrier(); asm volatile("" ::: "memory");
#pragma unroll
        for (int ai = 0; ai < 2; ++ai)
#pragma unroll
            for (int m = 0; m < 4; ++m) { const int r = ai * HALF + wr * 64 + m * 16 + fr, gm = u.pm * BM + r, b = gm / SEQ, sp = gm % SEQ; const float rkv = RS[r], krs = KR[r];
                if (wc < 2) {
#pragma unroll
                    for (int bj = 0; bj < 2; ++bj) { const float tot = (P[(r * 2 + bj) * 2] + P[(r * 2 + bj) * 2 + 1]) * rkv * rkv + krs;
                        const float sc = rkv * rsqrtf(tot * (1.f / 96.f) + EPS);
                        const int d0 = wc * 32 + 4 * fq; const f32x4 g0 = *(const f32x4*)(kn_gain + d0), g1 = *(const f32x4*)(kn_gain + d0 + 16);
                        const f32x4 v0 = acc[ai][bj][m][0] * g0 * sc, v1 = acc[ai][bj][m][1] * g1 * sc;
                        h16* kp = KF + ((((size_t)(b * 8 + u.pn * 2 + bj) * 32 + (sp >> 6)) * 12 + (d0 >> 3)) * 64 + (sp & 63)) * 8 + (d0 & 7);
                        u32x2 w0, w1; w0.x = pk_h2(v0[0], v0[1]); w0.y = pk_h2(v0[2], v0[3]); w1.x = pk_h2(v1[0], v1[1]); w1.y = pk_h2(v1[2], v1[3]);
                        *(u32x2*)kp = w0; *(u32x2*)(kp + 2 * 512) = w1; }
                } else {
#pragma unroll
                    for (int bj = 0; bj < 2; ++bj) { const int e0 = (wc - 2) * 32 + 4 * fq; const f32x4 v0 = acc[ai][bj][m][0] * rkv, v1 = acc[ai][bj][m][1] * rkv;
                        { int rr = r; asm volatile("" : "+v"(rr)); const int t16 = rr & 15, pos = (rr & 48) + (t16 < 4 ? t16 : t16 < 8 ? t16 + 4 : t16 < 12 ? t16 - 4 : t16);
                          LAS h16* vp = (LAS h16*)(lds + 16384) + (((bj * 4 + (rr >> 6)) * 8 + (pos >> 3)) * 64 + e0) * 8 + (pos & 7);
#pragma unroll
                          for (int j = 0; j < 4; ++j) { vp[j * 8] = (h16)v0[j]; vp[(16 + j) * 8] = (h16)v1[j]; } }
                        }
                    { const int bj = wc - 2; const float tot = (P[(r * 2 + bj) * 2] + P[(r * 2 + bj) * 2 + 1]) * rkv * rkv + krs; const float ri = rsqrtf(tot * (1.f / 96.f) + EPS);
                      typedef _Float16 h4 __attribute__((ext_vector_type(4)));
                      const h16* rp = PROJ + (size_t)gm * NPROJ + PC_KROPE + 4 * fq; const h4 a1 = *(const h4*)rp, a2 = *(const h4*)(rp + 16);
                      const f32x4 g1 = *(const f32x4*)(kn_gain + 64 + 4 * fq), g2 = *(const f32x4*)(kn_gain + 80 + 4 * fq);
                      const f32x4 cs = *(const f32x4*)(CS + (size_t)gm * 32 + 4 * fq), sn = *(const f32x4*)(CS + (size_t)gm * 32 + 16 + 4 * fq);
                      f32x4 t1, t2;
#pragma unroll
                      for (int j = 0; j < 4; ++j) { t1[j] = (float)a1[j] * ri * g1[j]; t2[j] = (float)a2[j] * ri * g2[j]; }
                      const f32x4 o1 = t1 * cs - t2 * sn, o2 = t1 * sn + t2 * cs;
                      h16* kp = KF + ((((size_t)(b * 8 + u.pn * 2 + bj) * 32 + (sp >> 6)) * 12 + ((64 + 4 * fq) >> 3)) * 64 + (sp & 63)) * 8 + ((4 * fq) & 7);
                      u32x2 w0, w1; w0.x = pk_h2(o1[0], o1[1]); w0.y = pk_h2(o1[2], o1[3]); w1.x = pk_h2(o2[0], o2[1]); w1.y = pk_h2(o2[2], o2[3]);
                      *(u32x2*)kp = w0; *(u32x2*)(kp + 2 * 512) = w1; }
                } }
        LDS_WAIT(); __builtin_amdgcn_s_barrier(); asm volatile("" ::: "memory");
        { const int b0 = (u.pm * BM) / SEQ, t0 = ((u.pm * BM) % SEQ) >> 6;
#pragma unroll
          for (int i = 0; i < 8; ++i) { const int ch = i * 512 + tid, blk = ch >> 9, off = ch & 511;
              const u32x4 v = *(const LAS u32x4*)(lds + 16384 + ch * 16);
              *(u32x4*)(VF + (((size_t)(b0 * 8 + u.pn * 2 + (blk >> 2)) * 32 + t0 + (blk & 3)) * 4096) + off * 8) = v; } }
    }
};
struct EpiResid {
    static constexpr bool PERM = true, AFTER_DRAIN = false;
    const float* X; h16* O; float* SSQ;
    __device__ __forceinline__ void operator()(const f32x4 (&acc)[2][2][4][2], const Unit& u, int wr, int wc, int fr, int fq) const {
        const int row0 = u.pm * BM + wr * 64 + fr, col0 = u.pn * BM + wc * 32 + 8 * fq;
#pragma unroll
        for (int ai = 0; ai < 2; ++ai)
#pragma unroll
            for (int m = 0; m < 4; ++m) { const int row = row0 + ai * HALF + m * 16; float sq = 0.f;
#pragma unroll
                for (int bj = 0; bj < 2; ++bj) { const float* xp = X + (size_t)row * DM + col0 + bj * HALF; const f32x4 x0 = *(const f32x4*)xp, x1 = *(const f32x4*)(xp + 4);
                    const f32x4 v0 = acc[ai][bj][m][0] + x0, v1 = acc[ai][bj][m][1] + x1;
                    sq += (v0[0] * v0[0] + v0[1] * v0[1]) + (v0[2] * v0[2] + v0[3] * v0[3]) + (v1[0] * v1[0] + v1[1] * v1[1]) + (v1[2] * v1[2] + v1[3] * v1[3]);
                    u32x4 w; w.x = pk_h2(v0[0], v0[1]); w.y = pk_h2(v0[2], v0[3]); w.z = pk_h2(v1[0], v1[1]); w.w = pk_h2(v1[2], v1[3]);
                    *(u32x4*)(O + (size_t)row * DM + col0 + bj * HALF) = w; }
                sq += __shfl_xor(sq, 16); sq += __shfl_xor(sq, 32);
                if (fq == 0) SSQ[(size_t)row * 16 + u.pn * 4 + wc] = sq; }
    }
};
struct DynGroupSched {
    const volatile LAS int* GT; int ncol; unsigned* ctr; volatile LAS unsigned* slot;
    __device__ __forceinline__ bool next(int i, Unit& u) const {
        if (threadIdx.x == 0) slot[i & 1] = __hip_atomic_fetch_add(ctr, 1u, __ATOMIC_RELAXED, __HIP_MEMORY_SCOPE_AGENT);
        asm volatile("s_waitcnt vmcnt(0) lgkmcnt(0)" ::: "memory"); __builtin_amdgcn_s_barrier(); asm volatile("" ::: "memory");
        const int L = (int)slot[i & 1], total = GT[32] * ncol; if (L >= total) return false;
        const int g = L / ncol, nfull = GT[192 + 32]; int e = 0, pm;
        if (g < nfull) { while (GT[192 + e + 1] <= g) ++e; pm = g - GT[192 + e]; }
        else { e = GT[232 + (g - nfull)]; pm = GT[128 + e] >> 8; }
        u.e = e; u.pm = pm; u.pn = L - g * ncol; u.half = (GT[128 + e] - pm * 256) <= 128; return true;
    }
    __device__ __forceinline__ void a_ready(const Unit&) const {}
};
struct DynGroupSchedDep : DynGroupSched {
    unsigned* DONE; unsigned need;
    __device__ __forceinline__ void a_ready(const Unit& u) const {
        if (threadIdx.x < 64) {
            unsigned* p = DONE + 16 * (GT[u.e] + u.pm); unsigned sp = 0;
            while ((unsigned)__builtin_amdgcn_readfirstlane(__hip_atomic_load(p, __ATOMIC_RELAXED, __HIP_MEMORY_SCOPE_AGENT)) < need) { __builtin_amdgcn_s_sleep(2); if (++sp > (1u << 22)) break; }
            __builtin_amdgcn_fence(__ATOMIC_ACQUIRE, "agent");
            asm volatile("s_waitcnt vmcnt(0)" ::: "memory");
        }
        asm volatile("" ::: "memory"); __builtin_amdgcn_s_barrier(); asm volatile("" ::: "memory");
    }
};
struct GatherProb {
    const h16* X; const h16* W; const int* ETOK; const volatile LAS int* GT; int lda, ldb, K;
    __device__ __forceinline__ const char* a_base() const { return (const char*)X; }
    __device__ __forceinline__ unsigned a_row_off(const Unit& u, int h, int R) const { int pos = u.pm * BM + h * HALF + R; const int n = GT[128 + u.e]; pos = pos < n ? pos : n - 1;
        return (unsigned)ETOK[u.e * ECAP + pos] * (unsigned)lda; }
    __device__ __forceinline__ const char* b_base(const Unit& u) const { return (const char*)(W + ((size_t)u.e * 512 + (size_t)u.pn * BM) * ldb); }
};
struct SlotProb {
    const h16* H; const h16* W; const volatile LAS int* GT; int lda, ldb, K;
    __device__ __forceinline__ const char* a_base() const { return (const char*)H; }
    __device__ __forceinline__ unsigned a_row_off(const Unit& u, int h, int R) const { return (unsigned)((GT[64 + u.e] + u.pm * BM + h * HALF + R) * lda); }
    __device__ __forceinline__ const char* b_base(const Unit& u) const { return (const char*)(W + ((size_t)u.e * 1024 + (size_t)u.pn * BM) * ldb); }
};
struct EpiHid {
    static constexpr bool PERM = true, AFTER_DRAIN = false;
    const float* ESC; const volatile LAS int* GT; h16* HID; unsigned* DONE;
    __device__ __forceinline__ void operator()(const f32x4 (&acc)[2][2][4][2], const Unit& u, int wr, int wc, int fr, int fq) const {
        const int n = GT[128 + u.e], base = GT[64 + u.e];
#pragma unroll
        for (int ai = 0; ai < 2; ++ai) { if (ai == 1 && u.half) break;
#pragma unroll
            for (int m = 0; m < 4; ++m) { const int pos = u.pm * BM + ai * HALF + wr * 64 + m * 16 + fr; const bool ok = pos < n;
                float rs = 0.f, w = 0.f; if (ok) { const float* ep = ESC + ((size_t)u.e * ECAP + pos) * 2; rs = ep[0]; w = ep[1]; }
#pragma unroll
                for (int bj = 0; bj < 2; ++bj) { const f32x4 v0 = acc[ai][bj][m][0] * rs, v1 = acc[ai][bj][m][1] * rs;
                    const float h0 = v0[0] / (1.f + __expf(-v0[0])) * v0[1] * w, h1 = v0[2] / (1.f + __expf(-v0[2])) * v0[3] * w;
                    const float h2 = v1[0] / (1.f + __expf(-v1[0])) * v1[1] * w, h3 = v1[2] / (1.f + __expf(-v1[2])) * v1[3] * w;
                    const unsigned long long o = (unsigned long long)pk_h2(h0, h1) | ((unsigned long long)pk_h2(h2, h3) << 32);
                    __hip_atomic_store((unsigned long long*)(HID + (size_t)(base + pos) * DEXP + u.pn * 128 + bj * 64 + wc * 16 + 4 * fq), o, __ATOMIC_RELAXED, __HIP_MEMORY_SCOPE_AGENT); } } }
        asm volatile("s_waitcnt vmcnt(0)" ::: "memory");
        if (fr == 0 && fq == 0) __hip_atomic_fetch_add(DONE + 16 * (GT[u.e] + u.pm), 1u, __ATOMIC_RELAXED, __HIP_MEMORY_SCOPE_AGENT);
    }
};
struct EpiY {
    static constexpr bool PERM = true, AFTER_DRAIN = false;
    const volatile LAS int* GT; h16* Y;
    __device__ __forceinline__ void operator()(const f32x4 (&acc)[2][2][4][2], const Unit& u, int wr, int wc, int fr, int fq) const {
        const int row0 = GT[64 + u.e] + u.pm * BM + wr * 64 + fr, col0 = u.pn * BM + wc * 32 + 8 * fq;
#pragma unroll
        for (int ai = 0; ai < 2; ++ai) { if (ai == 1 && u.half) break;
#pragma unroll
            for (int m = 0; m < 4; ++m) { h16* rowp = Y + (size_t)(row0 + ai * HALF + m * 16) * DM + col0;
#pragma unroll
                for (int bj = 0; bj < 2; ++bj) { const f32x4 v0 = acc[ai][bj][m][0], v1 = acc[ai][bj][m][1];
                    u32x4 w; w.x = pk_h2(v0[0], v0[1]); w.y = pk_h2(v0[2], v0[3]); w.z = pk_h2(v1[0], v1[1]); w.w = pk_h2(v1[2], v1[3]);
                    *(u32x4*)(rowp + bj * HALF) = w; } } }
    }
};
}

__device__ __forceinline__ void gla_combine_rows(const h16* OGLA, const h16* PROJ, const float* og_gain, h16* MIX, int m0, int m1, int mstep, int lane) {
    typedef _Float16 h8 __attribute__((ext_vector_type(8)));
    const int c = lane * 8;
    const f32x4 g0 = *(const f32x4*)(og_gain + (c & 127)), g1 = *(const f32x4*)(og_gain + (c & 127) + 4);
    for (int mb = m0; mb < m1; mb += 4 * mstep) {
        h8 a[4], b2[4], g[4];
#pragma unroll
        for (int q = 0; q < 4; ++q) { const int m = mb + q * mstep < m1 ? mb + q * mstep : mb;
            a[q] = *(const h8*)(OGLA + (size_t)m * 512 + c); b2[q] = *(const h8*)(OGLA + ((size_t)T + m) * 512 + c); g[q] = *(const h8*)(PROJ + (size_t)m * NPROJ + PC_GATE + c); }
#pragma unroll
        for (int q = 0; q < 4; ++q) { const int m = mb + q * mstep; if (m >= m1) break;
            float o[8]; float sq = 0.f;
#pragma unroll
            for (int k = 0; k < 8; ++k) { o[k] = (float)a[q][k] + (float)b2[q][k]; sq += o[k] * o[k]; }
            sq += __shfl_xor(sq, 1); sq += __shfl_xor(sq, 2); sq += __shfl_xor(sq, 4); sq += __shfl_xor(sq, 8);
            const float rs = rsqrtf(sq * (1.f / 128.f) + EPS);
            float r[8];
#pragma unroll
            for (int k = 0; k < 8; ++k) { const float gg = (float)g[q][k]; r[k] = o[k] * rs * (k < 4 ? g0[k] : g1[k - 4]) * (gg / (1.f + __expf(-gg))); }
            u32x4 w; w.x = pk_h2(r[0], r[1]); w.y = pk_h2(r[2], r[3]); w.z = pk_h2(r[4], r[5]); w.w = pk_h2(r[6], r[7]);
            *(u32x4*)(MIX + (size_t)m * DM + c) = w; }
    }
}

namespace at {
typedef _Float16 f16x8 __attribute__((ext_vector_type(8)));
typedef float f32x16 __attribute__((ext_vector_type(16)));
typedef __fp16 fp16x2 __attribute__((ext_vector_type(2)));
constexpr int KB_BYTES = 12288, VB_BYTES = 8192, TILE_BYTES = KB_BYTES + VB_BYTES, BUF_BYTES = 2 * TILE_BYTES, NT2 = SEQ / 128;
constexpr float THR = 8.f;
__device__ __forceinline__ int crow(int r, int hi) { return (r & 3) + 8 * (r >> 2) + 4 * hi; }
__device__ __forceinline__ float vmax3(float a, float b, float c) { float r; asm("v_max3_f32 %0, %1, %2, %3" : "=v"(r) : "v"(a), "v"(b), "v"(c)); return r; }
__device__ __forceinline__ float vadd(float a, float b) { float r; asm("v_add_f32 %0, %1, %2" : "=v"(r) : "v"(a), "v"(b)); return r; }
#define AT_DMA(gsrc, ldsoff) __builtin_amdgcn_global_load_lds((const unsigned*)(gsrc), (LAS unsigned*)(lds + (ldsoff)), 16, 0, 0)
__device__ __forceinline__ void attn_unit(LAS unsigned char* lds, const h16* __restrict__ QF, const h16* __restrict__ KF, const h16* __restrict__ VT, h16* __restrict__ MIX, int bh, int qb) {
    int tid = threadIdx.x; asm volatile("" : "+v"(tid));
    const int lane = tid & 63, wid = __builtin_amdgcn_readfirstlane(tid >> 6), r32 = lane & 31, hi = lane >> 5;
    f16x8 qf[6];
    { const h16* qp = QF + ((size_t)bh * SEQ + qb * 256 + wid * 32 + r32) * 96 + hi * 8;
#pragma unroll
      for (int ks = 0; ks < 6; ++ks) qf[ks] = *(const f16x8*)(qp + 16 * ks); }
    LAS float* wsf = (LAS float*)(lds + 2 * BUF_BYTES) + wid * 64;
    const h16* kg = KF + (size_t)bh * SEQ * 96 + wid * 512 + lane * 8;
    const h16* vg = VT + (size_t)bh * SEQ * 64 + wid * 512 + lane * 8;
    const int kdst = wid * 1024, vdst = KB_BYTES + wid * 1024;
#define AT_ISSUE1(t, off) do { AT_DMA(kg + (size_t)(t) * 6144, (off) + kdst); if (wid < 4) AT_DMA(kg + (size_t)(t) * 6144 + 8 * 512, (off) + kdst + 8192); AT_DMA(vg + (size_t)(t) * 4096, (off) + vdst); } while (0)
#define AT_ISSUE(t2, b) do { AT_ISSUE1(2 * (t2), (b) * BUF_BYTES); AT_ISSUE1(2 * (t2) + 1, (b) * BUF_BYTES + TILE_BYTES); } while (0)
    f32x16 o0, o1;
#pragma unroll
    for (int r = 0; r < 16; ++r) { o0[r] = 0.f; o1[r] = 0.f; }
    float m_run = 0.f, l_run = 0.f;
    AT_ISSUE(0, 0);
    asm volatile("s_waitcnt vmcnt(0)" ::: "memory"); __builtin_amdgcn_s_barrier(); asm volatile("" ::: "memory");
    for (int t = 0; t < NT2; ++t) {
        const int cur = t & 1;
        if (t + 1 < NT2) AT_ISSUE(t + 1, cur ^ 1);
        LAS unsigned char* Kb = lds + cur * BUF_BYTES; LAS unsigned char* Vb = Kb + KB_BYTES;
        f32x16 s[4];
        { const float nm = -m_run;
#pragma unroll
          for (int q = 0; q < 4; ++q)
#pragma unroll
              for (int r = 0; r < 16; ++r) s[q][r] = nm; }
#pragma unroll
        for (int tl = 0; tl < 2; ++tl) {
            f16x8 kf[12];
#pragma unroll
            for (int ks = 0; ks < 6; ++ks) { kf[2 * ks] = *(const LAS f16x8*)(Kb + tl * TILE_BYTES + (2 * ks + hi) * 1024 + r32 * 16); kf[2 * ks + 1] = *(const LAS f16x8*)(Kb + tl * TILE_BYTES + (2 * ks + hi) * 1024 + (32 + r32) * 16); }
            asm volatile("s_waitcnt lgkmcnt(0)" ::: "memory"); __builtin_amdgcn_sched_barrier(0);
            __builtin_amdgcn_s_setprio(1);
#pragma unroll
            for (int ks = 0; ks < 6; ++ks) {
                s[2 * tl] = __builtin_amdgcn_mfma_f32_32x32x16_f16(kf[2 * ks], qf[ks], s[2 * tl], 0, 0, 0);
                s[2 * tl + 1] = __builtin_amdgcn_mfma_f32_32x32x16_f16(kf[2 * ks + 1], qf[ks], s[2 * tl + 1], 0, 0, 0);
            }
            __builtin_amdgcn_s_setprio(0);
        }
        asm volatile("s_nop 15\n\ts_nop 15" ::: "memory"); __builtin_amdgcn_sched_barrier(0);
        float mxa = vmax3(s[0][0], s[1][0], s[2][0]), mxb = s[3][0];
#pragma unroll
        for (int r = 1; r < 16; ++r) { mxa = vmax3(mxa, s[0][r], s[1][r]); mxb = vmax3(mxb, s[2][r], s[3][r]); }
        float mx = vmax3(mxa, mxb, mxb);
        mx = fmaxf(mx, __shfl_xor(mx, 32));
        if (t == 0 || __any(mx > THR)) {
            const float d = (t == 0) ? mx : fmaxf(mx, 0.f), f = __builtin_amdgcn_exp2f(-d);
            m_run += d;
#pragma unroll
            for (int q = 0; q < 4; ++q)
#pragma unroll
                for (int r = 0; r < 16; ++r) s[q][r] -= d;
            if (t != 0) { l_run *= f;
                if (hi == 0) wsf[r32] = f;
                asm volatile("s_waitcnt lgkmcnt(0)" ::: "memory");
#pragma unroll
                for (int r = 0; r < 16; ++r) { const float ff = wsf[crow(r, hi)]; o0[r] *= ff; o1[r] *= ff; } }
        }
#pragma unroll
        for (int tl = 0; tl < 2; ++tl) {
#pragma unroll
            for (int r = 0; r < 16; ++r) { s[2 * tl][r] = __builtin_amdgcn_exp2f(s[2 * tl][r]); s[2 * tl + 1][r] = __builtin_amdgcn_exp2f(s[2 * tl + 1][r]); l_run += s[2 * tl][r]; l_run += s[2 * tl + 1][r]; }
            f16x8 vf[8], pa[4];
#pragma unroll
            for (int g = 0; g < 4; ++g) { vf[2 * g] = *(const LAS f16x8*)(Vb + tl * TILE_BYTES + (2 * g + hi) * 1024 + r32 * 16); vf[2 * g + 1] = *(const LAS f16x8*)(Vb + tl * TILE_BYTES + (2 * g + hi) * 1024 + (32 + r32) * 16); }
#pragma unroll
            for (int g = 0; g < 4; ++g)
#pragma unroll
                for (int j = 0; j < 4; ++j) { const int base = 8 * (g & 1) + 2 * j; const fp16x2 pk = __builtin_amdgcn_cvt_pkrtz(s[2 * tl + (g >> 1)][base], s[2 * tl + (g >> 1)][base + 1]); pa[g][2 * j] = (h16)pk[0]; pa[g][2 * j + 1] = (h16)pk[1]; }
            asm volatile("s_waitcnt lgkmcnt(0)" ::: "memory"); __builtin_amdgcn_sched_barrier(0);
            __builtin_amdgcn_s_setprio(1);
#pragma unroll
            for (int g = 0; g < 4; ++g) {
                o0 = __builtin_amdgcn_mfma_f32_32x32x16_f16(pa[g], vf[2 * g], o0, 0, 0, 0);
                o1 = __builtin_amdgcn_mfma_f32_32x32x16_f16(pa[g], vf[2 * g + 1], o1, 0, 0, 0);
            }
            __builtin_amdgcn_s_setprio(0);
        }
        asm volatile("s_waitcnt vmcnt(0) lgkmcnt(0)" ::: "memory"); __builtin_amdgcn_s_barrier(); asm volatile("" ::: "memory");
    }
    l_run += __shfl_xor(l_run, 32);
    if (hi == 0) wsf[r32] = 1.f / l_run;
    asm volatile("s_waitcnt lgkmcnt(0)" ::: "memory");
    const int b = bh >> 3, h = bh & 7;
    h16* op = MIX + ((size_t)b * SEQ + qb * 256 + wid * 32) * DM + 512 + h * 64 + r32;
#pragma unroll
    for (int r = 0; r < 16; ++r) { const int q = crow(r, hi); const float il = wsf[q]; op[(size_t)q * DM] = (h16)(o0[r] * il); op[(size_t)q * DM + 32] = (h16)(o1[r] * il); }
    asm volatile("s_waitcnt lgkmcnt(0)" ::: "memory"); __builtin_amdgcn_s_barrier(); asm volatile("" ::: "memory");
#undef AT_ISSUE
#undef AT_ISSUE1
}
#undef AT_DMA
}

namespace gl {
typedef _Float16 f16x8 __attribute__((ext_vector_type(8)));
typedef _Float16 f16x4 __attribute__((ext_vector_type(4)));
typedef short v4i16_t __attribute__((ext_vector_type(4)));
constexpr int RAW_Q = 0, RAW_K = 8192, RAW_V = 16384, RAW_LR = 32768, RAW_BYTES = 34816;
constexpr int OFF_QREL = 2 * RAW_BYTES, RS = 144  , IMG = 64 * RS;
constexpr int OFF_KREL = OFF_QREL + IMG, OFF_QDEC = OFF_KREL + IMG, OFF_KDECT = OFF_QDEC + IMG, OFF_SC = OFF_KDECT + IMG, OFF_TOT = OFF_SC + IMG, OFF_EBL = OFF_TOT + 2048, GLA_LDS = OFF_EBL + 256;
static_assert(GLA_LDS <= RING_BYTES, "GLA LDS map");
__device__ __forceinline__ int vswz(int token) { return 2 * ((token & 3) | (((token >> 3) & 1) << 2)); }
#define GL_DMA(gsrc, ldsoff) __builtin_amdgcn_global_load_lds((const unsigned*)(gsrc), (LAS unsigned*)(lds + (ldsoff)), 16, 0, 0)
#define GL_BAR() do { asm volatile("s_waitcnt lgkmcnt(0)" ::: "memory"); __builtin_amdgcn_s_barrier(); asm volatile("" ::: "memory"); } while (0)
__device__ __forceinline__ void gla_unit(LAS unsigned char* lds, const h16* __restrict__ PROJ, const float* __restrict__ GW, const float* __restrict__ GB, h16* __restrict__ OG, int b, int h, int dir) {
    int tid = threadIdx.x; asm volatile("" : "+v"(tid));
    const int lane = tid & 63, w = __builtin_amdgcn_readfirstlane(tid >> 6), l15 = lane & 15, kg = lane >> 4;
    typedef _Float16 h2v __attribute__((ext_vector_type(2)));
    h2v gwp[8];
#pragma unroll
    for (int r = 0; r < 8; ++r) gwp[r] = (h2v){(h16)GW[(2 * r) * 256 + h * 64 + lane], (h16)GW[(2 * r + 1) * 256 + h * 64 + lane]};
    const float gb = GB[h * 64 + lane];
    const h16* pb = PROJ + (size_t)b * SEQ * NPROJ;
    f32x4 Sacc[4];
#pragma unroll
    for (int k = 0; k < 4; ++k) Sacc[k] = (f32x4){0.f, 0.f, 0.f, 0.f};
#define GL_TOK(c, i) (dir ? (SEQ - 1 - ((c) * 64 + (i))) : ((c) * 64 + (i)))
#define GL_ISSUE(c, buf) do { const int _rb = (buf) * RAW_BYTES; \
        { const int row = 8 * w + (lane >> 3); const h16* src = pb + (size_t)GL_TOK(c, row) * NPROJ + h * 64 + (lane & 7) * 8; GL_DMA(src + PC_Q, _rb + RAW_Q + w * 1024); GL_DMA(src + PC_K, _rb + RAW_K + w * 1024); } \
        _Pragma("unroll") for (int _j = 0; _j < 2; ++_j) { const int row = 8 * w + 4 * _j + (lane >> 4); const int cc = (lane & 15) ^ vswz(row); \
            GL_DMA(pb + (size_t)GL_TOK(c, row) * NPROJ + PC_V + h * 128 + cc * 8, _rb + RAW_V + (2 * w + _j) * 1024); } \
        if (lane < 16) { const int row = 8 * w + (lane >> 1); GL_DMA(pb + (size_t)GL_TOK(c, row) * NPROJ + (dir ? PC_LRB : PC_LRF) + (lane & 1) * 8, _rb + RAW_LR + w * 256); } } while (0)
    f32x4 opend[4];
    float bl[8];
#define GL_GATES(rb_) do { float run = 0.f; const LAS unsigned char* lrp_ = lds + (rb_) * RAW_BYTES + RAW_LR; \
        _Pragma("unroll") for (int k = 0; k < 8; ++k) { const int i = 8 * w + k; const f16x8 l0 = *(const LAS f16x8*)(lrp_ + i * 32), l1 = *(const LAS f16x8*)(lrp_ + i * 32 + 16); \
            float z = gb, z1 = 0.f; \
            _Pragma("unroll") for (int r = 0; r < 4; ++r) { z = __builtin_amdgcn_fdot2((h2v){l0[2 * r], l0[2 * r + 1]}, gwp[r], z, false); z1 = __builtin_amdgcn_fdot2((h2v){l1[2 * r], l1[2 * r + 1]}, gwp[4 + r], z1, false); } \
            z += z1; \
            const float z2 = z * 1.4426950408889634f; \
            const float ls2 = fminf(z2, 0.f) - __builtin_amdgcn_logf(1.f + __builtin_amdgcn_exp2f(-fabsf(z2))); \
            run += ls2 * (1.f / 16.f); bl[k] = run; } \
        ((LAS float*)(lds + OFF_TOT))[w * 64 + lane] = run; } while (0)
    GL_ISSUE(0, 0);
    asm volatile("s_waitcnt vmcnt(0)" ::: "memory");
    GL_GATES(0);
    GL_BAR();
    for (int c = 0; c < SEQ / 64; ++c) {
        const int cur = c & 1; LAS unsigned char* raw = lds + cur * RAW_BYTES;
        if (c + 1 < SEQ / 64) GL_ISSUE(c + 1, cur ^ 1);
        float pre = 0.f, bref = 0.f, blast = 0.f;
#pragma unroll
        for (int ww = 0; ww < 8; ++ww) { const float tv = ((const LAS float*)(lds + OFF_TOT))[ww * 64 + lane]; if (ww < w) pre += tv; if (ww < 4) bref += tv; blast += tv; }
        { const int d = lane; const int dperm = (d & 32) + 8 * ((d >> 2) & 3) + 4 * ((d >> 4) & 1) + (d & 3);
          f16x8 kd; const float eref = __builtin_amdgcn_exp2f(bref), elr = __builtin_amdgcn_exp2f(blast - bref);
#pragma unroll
          for (int k = 0; k < 8; ++k) { const int i = 8 * w + k; const float bb = pre + bl[k];
              const float qv = (float)*(const LAS h16*)(raw + RAW_Q + i * 128 + d * 2), kv = (float)*(const LAS h16*)(raw + RAW_K + i * 128 + d * 2);
              const float dd = fminf(fmaxf(bb - bref, -14.f), 14.f); const float e1 = __builtin_amdgcn_exp2f(dd), e1i = __builtin_amdgcn_rcpf(e1);
              const float qr = qv * e1, kr = kv * e1i;
              *(LAS h16*)(lds + OFF_QREL + i * RS + d * 2) = (h16)qr;
              *(LAS h16*)(lds + OFF_KREL + i * RS + d * 2) = (h16)kr;
              *(LAS h16*)(lds + OFF_QDEC + i * RS + dperm * 2) = (h16)(qr * eref);
              kd[k] = (h16)(kr * elr); }
          *(LAS f16x8*)(lds + OFF_KDECT + d * RS + (8 * w) * 2) = kd;
          if (w == 0) ((LAS float*)(lds + OFF_EBL))[d] = __builtin_amdgcn_exp2f(blast); }
        GL_BAR();
#pragma unroll
        for (int q = 0; q < 2; ++q) { const int blk = 2 * w + q, ib = blk >> 2, jb = blk & 3;
            f32x4 sc = {0.f, 0.f, 0.f, 0.f};
            if (jb <= ib) {
#pragma unroll
                for (int ks = 0; ks < 2; ++ks) { const f16x8 a = *(const LAS f16x8*)(lds + OFF_KREL + (16 * jb + l15) * RS + (32 * ks + 8 * kg) * 2), bq = *(const LAS f16x8*)(lds + OFF_QREL + (16 * ib + l15) * RS + (32 * ks + 8 * kg) * 2);
                    sc = __builtin_amdgcn_mfma_f32_16x16x32_f16(a, bq, sc, 0, 0, 0); }
                if (jb == ib) {
#pragma unroll
                    for (int r = 0; r < 4; ++r) { const int j = 4 * kg + r, i = l15; const bool keep = dir ? (j < i) : (j <= i); if (!keep) sc[r] = 0.f; }
                }
            }
            f16x4 o; o[0] = (h16)sc[0]; o[1] = (h16)sc[1]; o[2] = (h16)sc[2]; o[3] = (h16)sc[3];
            *(LAS f16x4*)(lds + OFF_SC + (16 * ib + l15) * RS + (16 * jb + 4 * kg) * 2) = o; }
        f16x8 Vf[2], Sf[2];
#pragma unroll
        for (int ks = 0; ks < 2; ++ks) {
            v4i16_t t0, t1;
            { const int q = l15 >> 2, p = l15 & 3;
              const int tk0 = 32 * ks + 8 * kg + q, tk1 = tk0 + 4;
              const int c0 = (2 * w + (p >> 1)) ^ vswz(tk0), c1 = (2 * w + (p >> 1)) ^ vswz(tk1);
              t0 = __builtin_amdgcn_ds_read_tr16_b64_v4i16((LAS v4i16_t*)(raw + RAW_V + tk0 * 256 + c0 * 16 + (p & 1) * 8));
              t1 = __builtin_amdgcn_ds_read_tr16_b64_v4i16((LAS v4i16_t*)(raw + RAW_V + tk1 * 256 + c1 * 16 + (p & 1) * 8)); }
            const f16x4 a = __builtin_bit_cast(f16x4, t0), bq = __builtin_bit_cast(f16x4, t1);
            Vf[ks] = (f16x8){a[0], a[1], a[2], a[3], bq[0], bq[1], bq[2], bq[3]};
            Sf[ks] = (f16x8){(h16)Sacc[2 * ks][0], (h16)Sacc[2 * ks][1], (h16)Sacc[2 * ks][2], (h16)Sacc[2 * ks][3], (h16)Sacc[2 * ks + 1][0], (h16)Sacc[2 * ks + 1][1], (h16)Sacc[2 * ks + 1][2], (h16)Sacc[2 * ks + 1][3]};
        }
        GL_BAR();
        { f16x8 fsc[4][2], fqd[4][2], fkd[4][2]; f32x4 feb[4];
#pragma unroll
          for (int ib = 0; ib < 4; ++ib)
#pragma unroll
              for (int ks = 0; ks < 2; ++ks) { if (32 * ks <= 16 * ib + 15) fsc[ib][ks] = *(const LAS f16x8*)(lds + OFF_SC + (16 * ib + l15) * RS + (32 * ks + 8 * kg) * 2);
                  fqd[ib][ks] = *(const LAS f16x8*)(lds + OFF_QDEC + (16 * ib + l15) * RS + (32 * ks + 8 * kg) * 2); }
#pragma unroll
          for (int blk = 0; blk < 4; ++blk) { feb[blk] = *(const LAS f32x4*)(lds + OFF_EBL + (16 * blk + 4 * kg) * 4);
#pragma unroll
              for (int ks = 0; ks < 2; ++ks) fkd[blk][ks] = *(const LAS f16x8*)(lds + OFF_KDECT + (16 * blk + l15) * RS + (32 * ks + 8 * kg) * 2); }
          asm volatile("s_waitcnt lgkmcnt(0)" ::: "memory"); __builtin_amdgcn_sched_barrier(0);
          f32x4 oa[4];
#pragma unroll
          for (int ib = 0; ib < 4; ++ib) oa[ib] = (f32x4){0.f, 0.f, 0.f, 0.f};
#pragma unroll
          for (int ks = 0; ks < 2; ++ks)
#pragma unroll
              for (int ib = 0; ib < 4; ++ib) { if (32 * ks <= 16 * ib + 15) oa[ib] = __builtin_amdgcn_mfma_f32_16x16x32_f16(fsc[ib][ks], Vf[ks], oa[ib], 0, 0, 0); }
#pragma unroll
          for (int ks = 0; ks < 2; ++ks)
#pragma unroll
              for (int ib = 0; ib < 4; ++ib) oa[ib] = __builtin_amdgcn_mfma_f32_16x16x32_f16(fqd[ib][ks], Sf[ks], oa[ib], 0, 0, 0);
#pragma unroll
          for (int blk = 0; blk < 4; ++blk) Sacc[blk] = Sacc[blk] * feb[blk];
#pragma unroll
          for (int ks = 0; ks < 2; ++ks)
#pragma unroll
              for (int blk = 0; blk < 4; ++blk) Sacc[blk] = __builtin_amdgcn_mfma_f32_16x16x32_f16(fkd[blk][ks], Vf[ks], Sacc[blk], 0, 0, 0);
#pragma unroll
          for (int ib = 0; ib < 4; ++ib) opend[ib] = oa[ib]; }
        asm volatile("s_waitcnt vmcnt(0)" ::: "memory");
        if (c + 1 < SEQ / 64) GL_GATES(cur ^ 1);
        { LAS unsigned char* stg = lds + OFF_QREL + w * 2048;
#pragma unroll
          for (int ib = 0; ib < 4; ++ib)
#pragma unroll
              for (int r = 0; r < 4; ++r) *(LAS h16*)(stg + (16 * ib + 4 * kg + r) * 32 + l15 * 2) = (h16)opend[ib][r];
          asm volatile("s_waitcnt lgkmcnt(0)" ::: "memory");
#pragma unroll
          for (int q = 0; q < 2; ++q) { const int p = q * 64 + lane, i = p >> 1; const u32x4 v = *(const LAS u32x4*)(stg + p * 16);
              *(u32x4*)(OG + ((size_t)dir * T + (size_t)b * SEQ + GL_TOK(c, i)) * 512 + h * 128 + 16 * w + (p & 1) * 8) = v; } }
        GL_BAR();
    }
#undef GL_ISSUE
#undef GL_TOK
#undef GL_GATES
}
#undef GL_DMA
#undef GL_BAR
}

namespace rt {
typedef _Float16 f16x8 __attribute__((ext_vector_type(8)));
__device__ __forceinline__ void route_block(LAS unsigned char* lds, const h16* __restrict__ X1H, const h16* __restrict__ W16, const float* __restrict__ SSQ, const float* __restrict__ bg, const float* __restrict__ be,
                                            float* RS2, int* TOKE, int* TOKP, float* TOKW, int* ETOK, float* ESC, int* cnt, int row0) {
    int tid = threadIdx.x; asm volatile("" : "+v"(tid));
    const int lane = tid & 63, w = __builtin_amdgcn_readfirstlane(tid >> 6), l15 = lane & 15, kg = lane >> 4;
    f32x4 acc[4][3];
#pragma unroll
    for (int i = 0; i < 4; ++i)
#pragma unroll
        for (int j = 0; j < 3; ++j) acc[i][j] = (f32x4){0.f, 0.f, 0.f, 0.f};
    f16x8 af[4][4], bf[3][4];
#pragma unroll
    for (int ks = 0; ks < 4; ++ks) { const int k0 = 128 * w + 32 * ks + 8 * kg;
#pragma unroll
        for (int i = 0; i < 4; ++i) af[i][ks] = *(const f16x8*)(X1H + (size_t)(row0 + 16 * i + l15) * DM + k0);
#pragma unroll
        for (int j = 0; j < 3; ++j) bf[j][ks] = *(const f16x8*)(W16 + (size_t)(16 * j + l15) * DM + k0); }
#pragma unroll
    for (int ks = 0; ks < 4; ++ks)
#pragma unroll
        for (int i = 0; i < 4; ++i)
#pragma unroll
            for (int j = 0; j < 3; ++j) acc[i][j] = __builtin_amdgcn_mfma_f32_16x16x32_f16(bf[j][ks], af[i][ks], acc[i][j], 0, 0, 0);
    LAS float* PS = (LAS float*)lds;
#pragma unroll
    for (int i = 0; i < 4; ++i)
#pragma unroll
        for (int j = 0; j < 3; ++j) *(LAS f32x4*)(PS + (w * 64 + 16 * i + l15) * 48 + 16 * j + 4 * kg) = acc[i][j];
    LDS_WAIT(); __builtin_amdgcn_s_barrier(); asm volatile("" ::: "memory");
    LAS float* L = (LAS float*)(lds + 8 * 64 * 48 * 4);
    for (int t = tid; t < 64 * 12; t += NTHREADS) { const int r = t / 12, c4 = (t % 12) * 4; f32x4 sum = {0.f, 0.f, 0.f, 0.f};
#pragma unroll
        for (int ww = 0; ww < 8; ++ww) sum += *(const LAS f32x4*)(PS + (ww * 64 + r) * 48 + c4);
        *(LAS f32x4*)(L + r * 48 + c4) = sum; }
    LDS_WAIT(); __builtin_amdgcn_s_barrier(); asm volatile("" ::: "memory");
    if (tid < 64) { const int r = tid, m = row0 + r; LAS float* l = L + r * 48;
        float ss = 0.f; { const f32x4* sp = (const f32x4*)(SSQ + (size_t)m * 16);
#pragma unroll
            for (int i = 0; i < 4; ++i) { const f32x4 t4 = sp[i]; ss += (t4[0] + t4[1]) + (t4[2] + t4[3]); } }
        const float rs = rsqrtf(ss * (1.f / DM) + EPS);
        float mx = l[0] * rs + bg[0]; int gi = 0;
        for (int g = 1; g < 4; ++g) { const float v = l[g] * rs + bg[g]; if (v > mx) { mx = v; gi = g; } }
        float den = 0.f;
        for (int g = 0; g < 4; ++g) den += expf(l[g] * rs + bg[g] - mx);
        const float ptop = 1.f / den;
        LAS float* l8 = l + 4 + gi * 8;
        for (int j = 0; j < 8; ++j) l8[j] = l8[j] * rs + be[gi * 8 + j];
        float b0 = l8[0]; int i0 = 0;
        for (int j = 1; j < 8; ++j) if (l8[j] > b0) { b0 = l8[j]; i0 = j; }
        float b1 = -3.0e38f; int i1 = 0;
        for (int j = 0; j < 8; ++j) if (j != i0 && l8[j] > b1) { b1 = l8[j]; i1 = j; }
        const float p1 = expf(b1 - b0);
        const float w0 = ptop / (1.f + p1), w1 = ptop * p1 / (1.f + p1);
        const int e0 = gi * 8 + i0, e1 = gi * 8 + i1;
        LAS int* H = (LAS int*)(lds + 8 * 64 * 48 * 4 + 64 * 48 * 4);
        if (tid < 32) H[tid] = 0;
        __builtin_amdgcn_wave_barrier(); asm volatile("s_waitcnt lgkmcnt(0)" ::: "memory");
        const int r0 = __hip_atomic_fetch_add(H + e0, 1, __ATOMIC_RELAXED, __HIP_MEMORY_SCOPE_WORKGROUP), r1 = __hip_atomic_fetch_add(H + e1, 1, __ATOMIC_RELAXED, __HIP_MEMORY_SCOPE_WORKGROUP);
        __builtin_amdgcn_wave_barrier(); asm volatile("s_waitcnt lgkmcnt(0)" ::: "memory");
        if (tid < 32) { const int c = H[tid]; H[32 + tid] = c ? atomicAdd(&cnt[tid], c) : 0; }
        __builtin_amdgcn_wave_barrier(); asm volatile("s_waitcnt vmcnt(0) lgkmcnt(0)" ::: "memory");
        const int q0 = H[32 + e0] + r0, q1 = H[32 + e1] + r1;
        ETOK[e0 * ECAP + q0] = m; ETOK[e1 * ECAP + q1] = m;
        ESC[((size_t)e0 * ECAP + q0) * 2] = rs; ESC[((size_t)e0 * ECAP + q0) * 2 + 1] = w0;
        ESC[((size_t)e1 * ECAP + q1) * 2] = rs; ESC[((size_t)e1 * ECAP + q1) * 2 + 1] = w1;
        RS2[m] = rs; TOKE[m * 2] = e0; TOKE[m * 2 + 1] = e1; TOKP[m * 2] = q0; TOKP[m * 2 + 1] = q1; TOKW[m * 2] = w0; TOKW[m * 2 + 1] = w1;
    }
    __syncthreads();
}
}

__global__ void __launch_bounds__(NTHREADS, 2) mega_fwd(MArgs args) {
    extern __shared__ __attribute__((aligned(16))) unsigned char lds_raw[];
    LAS unsigned char* lds = (LAS unsigned char*)lds_raw;
    volatile LAS unsigned* MISC = (volatile LAS unsigned*)(lds + MISC_OFF);
    const int tid = threadIdx.x, lane = tid & 63, wave = __builtin_amdgcn_readfirstlane(tid >> 6);
    const int G = gridDim.x, bx = blockIdx.x;
    const int vcu = (G % 8 == 0) ? (bx % 8) * (G / 8) + bx / 8 : bx;
    unsigned* ctl = (unsigned*)(args.ws + WS_CTL);
    for (int u = tid; u < (LDS_BYTES - RING_BYTES) / 4; u += NTHREADS) ((LAS unsigned*)(lds + RING_BYTES))[u] = 0u;
    __syncthreads();
    XcdBarrier bar = xcd_barrier_post(ctl + CW_BAR + args.li * XCD_BAR_WORDS, MISC + 8);
    const int gw = vcu * NWAVES + wave, NGW = G * NWAVES;
    const int lo = args.ph_lo, hi = args.ph_hi;
#ifndef DUP_PHASE
#define DUP_PHASE -1
#endif
#define REPS(k) ((k) == DUP_PHASE ? 3 : 1)
#define IN(k) (lo <= (k) && (k) < hi)
#define BOTH(k) (IN(k) && IN((k) + 1))
    if (IN(0)) for (int rep = 0; rep < REPS(0); ++rep) { p0_prologue(args, lds, gw, NGW, lane, wave); if (BOTH(0) || rep + 1 < REPS(0)) xcd_barrier(bar); }
    if (IN(1)) for (int rep = 0; rep < REPS(1); ++rep) {
        g8::PlainProb p{(const h16*)(args.ws + WS_H1), (const h16*)(args.ws + WS_WINT), DM, DM, DM};
        g8::StaticOrder S; S.init(T / 256, NPROJ / 256, G, bx);
        g8::EpiH16 E{(h16*)(args.ws + WS_PROJ), NPROJ};
        g8::gemm_phase<g8::PlainProb, g8::EpiH16, g8::StaticOrder, true>(lds, p, S, E);
        if (BOTH(1) || rep + 1 < REPS(1)) xcd_barrier(bar);
    }
    if (IN(2)) for (int rep = 0; rep < REPS(2); ++rep) {
        const h16* PROJ = (const h16*)(args.ws + WS_PROJ); const float* CS = (const float*)(args.ws + WS_CS);
        g8::StaticOrder S; S.init(T / 256, 8, G, bx);
        g8::Unit u;
        for (int i = 0; S.next(i, u); ++i) {
            if (u.pn < 4) {
                g8::PlainProb p{PROJ + PC_MQA, (const h16*)(args.ws + WS_WQBT), NPROJ, 256, 256};
                g8::EpiQ E{PROJ, (const float*)args.in[13], CS, (h16*)(args.ws + WS_QF)};
                g8::OneUnit O{u};
                g8::gemm_phase<g8::PlainProb, g8::EpiQ, g8::OneUnit, false>(lds, p, O, E);
            } else {
                g8::PlainProb p{PROJ + PC_MKVA, (const h16*)(args.ws + WS_WKVBT), NPROJ, 256, 256};
                g8::EpiKV E{PROJ, (const float*)args.in[14], CS, (h16*)(args.ws + WS_KF), (h16*)(args.ws + WS_VF)};
                g8::Unit u2 = u; u2.pn = u.pn - 4;
                g8::OneUnit O{u2};
                g8::gemm_phase<g8::PlainProb, g8::EpiKV, g8::OneUnit, false>(lds, p, O, E);
            }
            __syncthreads();
        }
        if (BOTH(2) || rep + 1 < REPS(2)) xcd_barrier(bar);
    }
    if (IN(PH_MIX)) for (int rep = 0; rep < REPS(PH_MIX); ++rep) {
        const h16* PROJ = (const h16*)(args.ws + WS_PROJ);
        { const int x0 = (int)(xb_xcc_id() & 7u);
          for (int k = 0; k < 8; ++k) { const int x = (x0 + k) & 7;
              for (;;) {
                  if (tid == 0) MISC[16] = xb_add(ctl + CW_Q + 64 * (rep * 8 + x), 1u);
                  __syncthreads();
                  const int idx = (int)MISC[16];
                  __syncthreads();
                  if (idx >= 152) break;
                  if (idx < 8) { const int dir = idx & 1, hh = idx >> 1; gl::gla_unit(lds, PROJ, (const float*)args.in[dir ? 6 : 4], (const float*)args.in[dir ? 7 : 5], (h16*)(args.ws + WS_OGLA), x, hh, dir);
                      VM_WAIT(); __syncthreads();
                      if (wave == 0) { __builtin_amdgcn_fence(__ATOMIC_RELEASE, "agent"); VM_WAIT(); xb_add(ctl + CW_GLADONE + 64 * (rep * 8 + x), lane == 0 ? 1u : 0u); } }
                  else if (idx < 96 && ((idx - 8) % 11) < 8) { const int a = ((idx - 8) / 11) * 8 + ((idx - 8) % 11); at::attn_unit(lds, (const h16*)(args.ws + WS_QF), (const h16*)(args.ws + WS_KF), (const h16*)(args.ws + WS_VF), (h16*)(args.ws + WS_MIX), x * 8 + (a >> 3), a & 7); }
                  else if (idx < 120) {
                      int ln = lane; asm volatile("" : "+v"(ln));
                      const int bj = idx < 96 ? ((idx - 8) / 11) * 3 + ((idx - 8) % 11) - 8 : idx - 72;
                      const int base = (x * 48 + bj) * 32 + wave * 4; LAS float* scr = (LAS float*)(lds + wave * 16384);
                      if (rep == 0) expert_items4(args, base, scr, ln);
                      __syncthreads(); }
                  else {
                      const int j = idx - 120;
                      if (wave == 0) { unsigned sp = 0; while ((unsigned)__builtin_amdgcn_readfirstlane(xb_ld(ctl + CW_GLADONE + 64 * (rep * 8 + x))) < 8u) { __builtin_amdgcn_s_sleep(4); if (++sp > (1u << 16)) break; }
                          __builtin_amdgcn_fence(__ATOMIC_ACQUIRE, "agent"); VM_WAIT(); }
                      __syncthreads();
                      int ln = lane; asm volatile("" : "+v"(ln));
                      const int m0 = x * SEQ + j * 64 + wave * 8;
                      gla_combine_rows((const h16*)(args.ws + WS_OGLA), PROJ, (const float*)args.in[8], (h16*)(args.ws + WS_MIX), m0, m0 + 8, 1, ln);
                      __syncthreads(); }
              } } }
        if (BOTH(PH_MIX) || rep + 1 < REPS(PH_MIX)) xcd_barrier(bar);
    }
    if (IN(PH_COMB)) for (int rep = 0; rep < REPS(PH_COMB); ++rep) {
    }
    if (IN(PH_OUT)) for (int rep = 0; rep < REPS(PH_OUT); ++rep) {
        g8::PlainProb p{(const h16*)(args.ws + WS_MIX), (const h16*)(args.ws + WS_WOUTT), DM, DM, DM};
        g8::StaticOrder S; S.init(T / 256, DM / 256, G, bx);
        g8::EpiResid E{(const float*)args.in[0], (h16*)(args.ws + WS_X1H), (float*)(args.ws + WS_SSQ)};
        g8::gemm_phase<g8::PlainProb, g8::EpiResid, g8::StaticOrder, true>(lds, p, S, E);
        if (BOTH(PH_OUT) || rep + 1 < REPS(PH_OUT)) xcd_barrier(bar);
    }
    if (IN(PH_ROUTE)) {
        for (int blk = bx; blk < T / 64; blk += G)
            rt::route_block(lds, (const h16*)(args.ws + WS_X1H), (const h16*)(args.ws + WS_WRT16), (const float*)(args.ws + WS_SSQ), (const float*)args.in[18], (const float*)args.in[20],
                            (float*)(args.ws + WS_RS2), (int*)(args.ws + WS_TOKE), (int*)(args.ws + WS_TOKP), (float*)(args.ws + WS_TOKW), (int*)(args.ws + WS_ETOK), (float*)(args.ws + WS_ESC), (int*)(ctl + CW_CNT), blk * 64);
        if (BOTH(PH_ROUTE)) xcd_barrier(bar);
    }
    volatile LAS int* GT = (volatile LAS int*)(lds + MISC_OFF + 128);
    if (IN(PH_UP) || IN(PH_DOWN) || IN(PH_FIN)) {
        if (tid == 0) { int tp = 0, rb = 0; for (int e = 0; e < NEXP; ++e) { const int n = __hip_atomic_load((int*)(ctl + CW_CNT) + e, __ATOMIC_RELAXED, __HIP_MEMORY_SCOPE_AGENT); const int t = (n + 255) >> 8;
            GT[e] = tp; GT[64 + e] = rb; GT[128 + e] = n; tp += t; rb += t * 256; } GT[32] = tp; GT[64 + 32] = rb;
            int pf = 0, np = 0; for (int e = 0; e < NEXP; ++e) { const int n = GT[128 + e]; GT[192 + e] = pf; pf += n >> 8; } GT[192 + 32] = pf;
            for (int pass = 3; pass >= 0; --pass) for (int e = 0; e < NEXP; ++e) { const int r = GT[128 + e] & 255; if (r && ((r - 1) >> 6) == pass) { GT[232 + np] = e; ++np; } } }
        __syncthreads();
    }
    if (IN(PH_UP)) for (int rep = 0; rep < REPS(PH_UP); ++rep) {
        g8::GatherProb p{(const h16*)(args.ws + WS_X1H), (const h16*)(args.ws + WS_WGUT), (const int*)(args.ws + WS_ETOK), GT, DM, DM, DM};
        g8::DynGroupSched S{GT, 2, ctl + CW_MOEQ, MISC + 20};
        g8::EpiHid E{(const float*)(args.ws + WS_ESC), GT, (h16*)(args.ws + WS_HID), ctl + CW_DONE};
        g8::gemm_phase<g8::GatherProb, g8::EpiHid, g8::DynGroupSched, true, true>(lds, p, S, E);
        if (!IN(PH_DOWN)) { if (BOTH(PH_UP) || rep + 1 < REPS(PH_UP)) xcd_barrier(bar); }
        else __syncthreads();
    }
    if (IN(PH_DOWN)) for (int rep = 0; rep < REPS(PH_DOWN); ++rep) {
        g8::SlotProb p{(const h16*)(args.ws + WS_HID), (const h16*)(args.ws + WS_WDT), GT, DEXP, DEXP, DEXP};
        g8::DynGroupSchedDep S{{GT, 4, ctl + CW_MOEQ + 64, MISC + 22}, ctl + CW_DONE, 16u};
        g8::EpiY E{GT, (h16*)(args.ws + WS_Y)};
        g8::gemm_phase<g8::SlotProb, g8::EpiY, g8::DynGroupSchedDep, true, true>(lds, p, S, E);
        if (BOTH(PH_DOWN) || rep + 1 < REPS(PH_DOWN)) xcd_barrier(bar);
    }
    if (IN(PH_FIN)) {
        const h16* X1H = (const h16*)(args.ws + WS_X1H); const h16* Y = (const h16*)(args.ws + WS_Y);
        const int* TOKE = (const int*)(args.ws + WS_TOKE); const int* TOKP = (const int*)(args.ws + WS_TOKP);
        typedef _Float16 h8 __attribute__((ext_vector_type(8)));
        for (int q0 = 0; gw + NGW * q0 < T; q0 += 8) {
        int myslot = 0;
        { const int q = lane >> 1, r = lane & 1, m = gw + NGW * (q0 + q); if (lane < 16 && m < T) myslot = GT[64 + TOKE[m * 2 + r]] + TOKP[m * 2 + r]; }
        for (int q = 0; q < 8; q += 2) {
            const int mA = gw + NGW * (q0 + q), mB = mA + NGW; if (mA >= T) break;
            const bool hasB = mB < T;
            const int sA0 = __shfl(myslot, 2 * q), sA1 = __shfl(myslot, 2 * q + 1), sB0 = __shfl(myslot, 2 * q + 2), sB1 = __shfl(myslot, 2 * q + 3);
            h8 a[2][2], y0[2][2], y1[2][2];
#pragma unroll
            for (int j = 0; j < 2; ++j) { const int c = j * 512 + lane * 8;
                a[0][j] = *(const h8*)(X1H + (size_t)mA * DM + c); y0[0][j] = *(const h8*)(Y + (size_t)sA0 * DM + c); y1[0][j] = *(const h8*)(Y + (size_t)sA1 * DM + c);
                a[1][j] = *(const h8*)(X1H + (size_t)(hasB ? mB : mA) * DM + c); y0[1][j] = *(const h8*)(Y + (size_t)(hasB ? sB0 : sA0) * DM + c); y1[1][j] = *(const h8*)(Y + (size_t)(hasB ? sB1 : sA1) * DM + c); }
#pragma unroll
            for (int t2 = 0; t2 < 2; ++t2) { if (t2 == 1 && !hasB) break; const int m = t2 ? mB : mA;
#pragma unroll
                for (int j = 0; j < 2; ++j) { const int c = j * 512 + lane * 8; f32x4 o0, o1;
#pragma unroll
                    for (int k = 0; k < 4; ++k) { o0[k] = (float)a[t2][j][k] + ((float)y0[t2][j][k] + (float)y1[t2][j][k]); o1[k] = (float)a[t2][j][4 + k] + ((float)y0[t2][j][4 + k] + (float)y1[t2][j][4 + k]); }
                    *(f32x4*)(args.out + (size_t)m * DM + c) = o0; *(f32x4*)(args.out + (size_t)m * DM + c + 4) = o1; } }
        }
        }
    }
#undef IN
#undef BOTH
#undef REPS
}

extern "C" void kernel_launch(void* const* d_in, const int* in_sizes, int n_in, void* d_out, int out_size, void* d_ws, size_t ws_size, hipStream_t stream) {
    if (n_in != 24 || out_size != T * DM || ws_size < WS_END) { fprintf(stderr, "kernel_launch: unexpected shapes (n_in %d out %d ws %zu)\n", n_in, out_size, ws_size); return; }
    static int grid = 0;
    if (grid == 0) {
        int dev = 0, cus = 0;
        if (hipGetDevice(&dev) != hipSuccess || hipDeviceGetAttribute(&cus, hipDeviceAttributeMultiprocessorCount, dev) != hipSuccess) { fprintf(stderr, "kernel_launch: device query failed\n"); grid = -1; return; }
        if (hipFuncSetAttribute((const void*)mega_fwd, hipFuncAttributeMaxDynamicSharedMemorySize, LDS_BYTES) != hipSuccess) { fprintf(stderr, "kernel_launch: hipFuncSetAttribute failed\n"); grid = -1; return; }
        int per_cu = 0; (void)hipOccupancyMaxActiveBlocksPerMultiprocessor(&per_cu, (const void*)mega_fwd, NTHREADS, LDS_BYTES); (void)hipGetLastError();
        if (per_cu < 1) fprintf(stderr, "kernel_launch: note: occupancy query reports %d\n", per_cu);
        grid = cus;
    }
    if (grid < 0) return;
    char* ws = (char*)d_ws; float* out = (float*)d_out;
    (void)hipMemsetAsync(ws + WS_CTL, 0, CTL_ZERO_BYTES, stream);
    MArgs a{};
    for (int i = 0; i < 24; ++i) a.in[i] = d_in[i];
    a.out = out; a.ws = (unsigned char*)d_ws; a.ph_lo = 0; a.ph_hi = PH_END; a.li = 0;
    hipLaunchKernelGGL(mega_fwd, dim3(grid), dim3(NTHREADS), LDS_BYTES, stream, a);
}
```

```cpp
#include <hip/hip_runtime.h>
#include <cstdio>
#include <cstdint>

typedef _Float16 h16;

constexpr int BATCH = 8, SEQ = 2048, T = BATCH * SEQ, DM = 1024;
constexpr int NPROJ = 2048;
constexpr int PC_Q = 0, PC_K = 256, PC_V = 512, PC_GATE = 1024, PC_MQA = 1536, PC_MKVA = 1792, PC_KROPE = 1920, PC_LRF = 1952, PC_LRB = 1968;
constexpr int NEXP = 32, DEXP = 256;
constexpr int ECAP = 16384;
constexpr int SLOT_ROWS = 32768 + 32 * 256;
constexpr float EPS = 1e-6f;

constexpr size_t MiB = 1u << 20;
constexpr size_t WS_CTL = 0;
constexpr size_t WS_WINT = 1 * MiB;
constexpr size_t WS_WQBT = 5 * MiB;
constexpr size_t WS_WKVBT = 5 * MiB + 512 * 1024;
constexpr size_t WS_WOUTT = 6 * MiB;
constexpr size_t WS_WGUT = 8 * MiB;
constexpr size_t WS_WDT = 40 * MiB;
constexpr size_t WS_ROUTE = 56 * MiB;
constexpr size_t WS_RS2 = WS_ROUTE + 256 * 1024;
constexpr size_t WS_TOKE = WS_RS2 + 64 * 1024;
constexpr size_t WS_TOKP = WS_TOKE + 128 * 1024;
constexpr size_t WS_TOKW = WS_TOKP + 128 * 1024;
constexpr size_t WS_ETOK = WS_ROUTE + 1 * MiB;
constexpr size_t WS_A = 60 * MiB;
constexpr size_t WS_H1 = WS_A, WS_PROJ = WS_A + 32 * MiB, WS_MIX = WS_A, WS_Y = WS_A;
constexpr size_t WS_B = 156 * MiB;
constexpr size_t WS_QF = WS_B, WS_KF = WS_B + 24 * MiB, WS_VF = WS_B + 48 * MiB, WS_HID = WS_B;
constexpr size_t WS_OGLA = 220 * MiB;
constexpr size_t WS_X1H = WS_OGLA;
constexpr size_t WS_WRT16 = WS_ROUTE + 3 * MiB;
constexpr size_t WS_SSQ = 254 * MiB;
constexpr size_t WS_ESC = 200 * MiB;
constexpr size_t WS_CS = 252 * MiB;
constexpr size_t WS_END = 256 * MiB;

__device__ __forceinline__ int win_src_col(int n) {
    if (n < 1536) return n;
    if (n < 1792) return 1568 + (n - 1536);
    if (n < 1920) return 1824 + (n - 1792);
    if (n < 1952) return 1952 + (n - 1920);
    if (n < 1968) return 1536 + (n - 1952);
    if (n < 1984) return 1552 + (n - 1968);
    return -1;
}

#define LAS __attribute__((address_space(3)))
#define GAS __attribute__((address_space(1)))
typedef unsigned u32x4 __attribute__((ext_vector_type(4)));
typedef float f32x4 __attribute__((ext_vector_type(4)));
#define LDS_WAIT() asm volatile("s_waitcnt lgkmcnt(0)" ::: "memory")
#define VM_WAIT() asm volatile("s_waitcnt vmcnt(0)" ::: "memory")
constexpr int NWAVES = 8, NTHREADS = 512;
constexpr int RING_BYTES = 131072, MISC_OFF = RING_BYTES + 320, LDS_BYTES = 147456;
constexpr int CW_CNT = 0;
constexpr int CW_BAR = 4096;
constexpr int CW_GLADONE = 10240;
constexpr int CW_Q = 12288;
constexpr size_t CTL_ZERO_BYTES = 131072;
constexpr int CW_MOEQ = 14336;
constexpr int CW_DONE = 16384;
constexpr int PH_MIX = 3, PH_COMB = 4, PH_OUT = 5, PH_ROUTE = 6, PH_UP = 7, PH_DOWN = 8, PH_FIN = 9, PH_END = 10;

__device__ __forceinline__ unsigned pk_h2(float a, float b) { typedef _Float16 h2 __attribute__((ext_vector_type(2))); h2 v = {(h16)a, (h16)b}; return __builtin_bit_cast(unsigned, v); }

#define XB_TMO      128
#define XB_XCNT(j)  (256  + 64 * (j))
#define XB_XSUB(j)  (1280 + 64 * (j))
#define XB_XGEN(j)  (2304 + 64 * (j))
#define XB_TOP      3328
#define XB_TOPGEN   3392
#define XCD_BAR_WORDS 3456
#define XB_SPIN_CAP (1u << 18)
__device__ __forceinline__ unsigned xb_ld(unsigned* p)              { return __hip_atomic_load(p, __ATOMIC_RELAXED, __HIP_MEMORY_SCOPE_AGENT); }
__device__ __forceinline__ unsigned xb_add(unsigned* p, unsigned v) { return __hip_atomic_fetch_add(p, v, __ATOMIC_RELAXED, __HIP_MEMORY_SCOPE_AGENT); }
__device__ __forceinline__ unsigned xb_xcc_id() { return (unsigned)__builtin_amdgcn_s_getreg((3 << 11) | 20) & 0xFu; }
#define XB_SPIN(cond, bar) do { unsigned _sp = 0; while (cond) { __builtin_amdgcn_s_sleep(1); \
    if ((++_sp & 255u) == 0u) { if (xb_ld(&(bar)[XB_TMO])) break; if (_sp > XB_SPIN_CAP) { atomicAdd(&(bar)[XB_TMO], 1u); break; } } } } while (0)
struct XcdBarrier { unsigned* bar; unsigned x; volatile LAS unsigned* st; };
__device__ __forceinline__ XcdBarrier xcd_barrier_post(unsigned* bar, volatile LAS unsigned* st) {
    XcdBarrier b; b.bar = bar; b.x = xb_xcc_id(); b.st = st;
    if (threadIdx.x == 0) (void)xb_add(&bar[XB_XCNT(b.x)], 1u);
    return b;
}
__device__ __forceinline__ void xcd_barrier_complete(unsigned* bar, unsigned x, unsigned& nloc, unsigned& nx) {
    const unsigned G = gridDim.x * gridDim.y * gridDim.z;
    unsigned sum, cnt, mine, sp = 0u;
    for (;;) {
        sum = 0u; cnt = 0u; mine = 0u;
#pragma unroll
        for (unsigned j = 0; j < 16; ++j) { const unsigned c = xb_ld(&bar[XB_XCNT(j)]); sum += c; cnt += (c > 0u) ? 1u : 0u; mine = (j == x) ? c : mine; }
        if (sum == G) break;
        __builtin_amdgcn_s_sleep(1);
        if ((++sp & 255u) == 0u) { if (xb_ld(&bar[XB_TMO])) break; if (sp > XB_SPIN_CAP) { atomicAdd(&bar[XB_TMO], 1u); break; } }
    }
    nloc = mine > 0u ? mine : 1u; nx = cnt > 0u ? cnt : 1u;
}
__device__ __forceinline__ void xcd_barrier(const XcdBarrier& b) {
    asm volatile("s_waitcnt vmcnt(0)" ::: "memory");
    __syncthreads();
    if (threadIdx.x == 0) {
        unsigned* bar = b.bar;
        __builtin_amdgcn_s_waitcnt(0);
        unsigned nloc = b.st[0], nx = b.st[1];
        if (nloc == 0u) { xcd_barrier_complete(bar, b.x, nloc, nx); b.st[0] = nloc; b.st[1] = nx; }
        const unsigned old = xb_add(&bar[XB_XSUB(b.x)], 1u);
        const unsigned gen = old / nloc;
        if (old + 1u == (gen + 1u) * nloc) {
            __builtin_amdgcn_fence(__ATOMIC_RELEASE, "agent");
            asm volatile("s_waitcnt vmcnt(0)" ::: "memory");
            const unsigned og = xb_add(&bar[XB_TOP], 1u);
            const unsigned tg = og / nx;
            if (og + 1u == (tg + 1u) * nx) xb_add(&bar[XB_TOPGEN], 1u);
            else XB_SPIN(xb_ld(&bar[XB_TOPGEN]) == tg, bar);
            __builtin_amdgcn_fence(__ATOMIC_ACQUIRE, "agent");
            asm volatile("s_waitcnt vmcnt(0)" ::: "memory");
        } else {
            XB_SPIN(xb_ld(&bar[XB_TOPGEN]) == gen, bar);
            __builtin_amdgcn_fence(__ATOMIC_ACQUIRE, "agent");
            asm volatile("s_waitcnt vmcnt(0)" ::: "memory");
        }
    }
    __syncthreads();
}

template <int NBATCH>
__device__ __forceinline__ void tr_item(const float* __restrict__ src, int src_ld, int k0, int c0, h16* __restrict__ dst, int dst_ld, long row0, int rstride,
                                        const float* __restrict__ kg, float scale, LAS float* scr, int lane, long dkofs = -1, int cstride = 8) {
#pragma unroll
    for (int bt = 0; bt < 32 / NBATCH; ++bt) {
        float tv[NBATCH];
#pragma unroll
        for (int i = 0; i < NBATCH; ++i) { const int kk = 2 * (bt * NBATCH + i) + (lane >> 5); tv[i] = src[(size_t)(k0 + kk) * src_ld + c0 + (lane & 31)]; }
#pragma unroll
        for (int i = 0; i < NBATCH; ++i) { const int kk = 2 * (bt * NBATCH + i) + (lane >> 5); float v = tv[i] * scale; if (kg) v *= kg[k0 + kk]; scr[kk * 33 + (lane & 31)] = v; }
    }
    LDS_WAIT(); asm volatile("" ::: "memory");
    const int c = lane & 7;
    const __amdgpu_buffer_rsrc_t rd = __builtin_amdgcn_make_buffer_rsrc(dst, 0, 0x7fffffff, 0x00020000);
#pragma unroll
    for (int j = 0; j < 4; ++j) { const int n = (lane >> 3) + 8 * j; const LAS float* s = scr + (8 * c) * 33 + n;
        u32x4 o; o.x = pk_h2(s[0 * 33], s[1 * 33]); o.y = pk_h2(s[2 * 33], s[3 * 33]); o.z = pk_h2(s[4 * 33], s[5 * 33]); o.w = pk_h2(s[6 * 33], s[7 * 33]);
        __builtin_amdgcn_raw_buffer_store_b128(o, rd, (int)((((long)row0 + (long)n * rstride) * dst_ld + (dkofs >= 0 ? dkofs : (long)k0) + (long)cstride * c) * 2), 0, 16); }
    LDS_WAIT(); asm volatile("" ::: "memory");
}
struct TrP { const float* src; int src_ld, k0, c0; h16* dst; int dst_ld; long row0; int rstride; const float* kg; };
__device__ __forceinline__ void tr_load(const TrP& p, float (&tv)[32], int lane) {
#pragma unroll
    for (int i = 0; i < 32; ++i) { const int kk = 2 * i + (lane >> 5); tv[i] = p.src[(size_t)(p.k0 + kk) * p.src_ld + p.c0 + (lane & 31)]; }
}
__device__ __forceinline__ void tr_finish(const TrP& p, const float (&tv)[32], LAS float* scr, int lane) {
#pragma unroll
    for (int i = 0; i < 32; ++i) { const int kk = 2 * i + (lane >> 5); float v = tv[i]; if (p.kg) v *= p.kg[p.k0 + kk]; scr[kk * 33 + (lane & 31)] = v; }
    LDS_WAIT(); asm volatile("" ::: "memory");
    const int c = lane & 7;
#pragma unroll
    for (int j = 0; j < 4; ++j) { const int n = (lane >> 3) + 8 * j; const LAS float* s = scr + (8 * c) * 33 + n;
        u32x4 o; o.x = pk_h2(s[0 * 33], s[1 * 33]); o.y = pk_h2(s[2 * 33], s[3 * 33]); o.z = pk_h2(s[4 * 33], s[5 * 33]); o.w = pk_h2(s[6 * 33], s[7 * 33]);
        *(u32x4*)(p.dst + (size_t)(p.row0 + (long)n * p.rstride) * p.dst_ld + p.k0 + 8 * c) = o; }
    LDS_WAIT(); asm volatile("" ::: "memory");
}
__device__ __forceinline__ float wave_sum(float v) {
#pragma unroll
    for (int o = 1; o < 64; o <<= 1) v += __shfl_xor(v, o);
    return v;
}
struct MArgs { const void* in[24]; float* out; unsigned char* ws; int ph_lo, ph_hi, li, pad; };
typedef const MArgs __attribute__((address_space(4)))* KArgs;

__device__ __forceinline__ TrP expert_params(KArgs a, int r) {
    unsigned char* ws = a->ws;
    const float* wg = (const float*)a->in[21]; const float* wu = (const float*)a->in[22]; const float* wd = (const float*)a->in[23]; const float* gain2 = (const float*)a->in[16];
    h16* WguT = (h16*)(ws + WS_WGUT); h16* WdT = (h16*)(ws + WS_WDT);
    if (r < 8192) { const int e = r >> 8, sx = (r >> 7) & 1, kb = (r >> 3) & 15, nb = r & 7;
        return TrP{(sx ? wu : wg) + (size_t)e * 1024 * 256, 256, 64 * kb, 32 * nb, WguT, 1024, (long)e * 512 + 64 * nb + sx, 2, gain2}; }
    r -= 8192; const int e = r >> 7, kb = (r >> 5) & 3, nb = r & 31;
    return TrP{wd + (size_t)e * 256 * 1024, 1024, 64 * kb, 32 * nb, WdT, 256, (long)e * 1024 + 32 * nb, 1, nullptr};
}
__device__ __forceinline__ void expert_items4(KArgs a, int r0, LAS float* scr, int lane) {
    float ta[32], tb[32], tc[32], td[32];
    const TrP p0 = expert_params(a, r0), p1 = expert_params(a, r0 + 1), p2 = expert_params(a, r0 + 2), p3 = expert_params(a, r0 + 3);
    tr_load(p0, ta, lane); tr_load(p1, tb, lane); tr_load(p2, tc, lane); tr_load(p3, td, lane);
    tr_finish(p0, ta, scr, lane); tr_finish(p1, tb, scr, lane); tr_finish(p2, tc, scr, lane); tr_finish(p3, td, scr, lane);
}

__device__ __forceinline__ void p0_prologue(KArgs a, LAS unsigned char* lds, int gw, int NGW, int lane, int wave) {
    unsigned char* ws = a->ws;
    LAS float* scr = (LAS float*)(lds + wave * 16384);
    const float* w_in = (const float*)a->in[3]; const float* w_qb = (const float*)a->in[10]; const float* w_kvb = (const float*)a->in[12]; const float* w_out = (const float*)a->in[15];
    const float* wg = (const float*)a->in[21]; const float* wu = (const float*)a->in[22]; const float* wd = (const float*)a->in[23];
    const float* q_gain = (const float*)a->in[9]; const float* kv_gain = (const float*)a->in[11]; const float* gain2 = (const float*)a->in[16];
    h16* WinT = (h16*)(ws + WS_WINT); h16* WqbT = (h16*)(ws + WS_WQBT); h16* WkvbT = (h16*)(ws + WS_WKVBT); h16* WoutT = (h16*)(ws + WS_WOUTT);
    h16* WguT = (h16*)(ws + WS_WGUT); h16* WdT = (h16*)(ws + WS_WDT);
    constexpr int I_IN = 16 * 62, I_OUT = 16 * 32, I_QB = 4 * 24, I_KVB = 2 * 32;
    constexpr int NITEMS = I_IN + I_OUT + I_QB + I_KVB;
    for (int it = gw; it < NITEMS; it += NGW) {
        int r = it;
        if (r < I_IN) { const int kb = r / 62, nb = r % 62, n0 = 32 * nb;
            tr_item<32>(w_in, 1984, 64 * kb, win_src_col(n0), WinT, 1024, n0, 1, nullptr, n0 < 256 ? 0.125f : 1.f, scr, lane); continue; }
        r -= I_IN;
        if (r < I_OUT) { const int kb = r >> 5, nb = r & 31;
            tr_item<32>(w_out, 1024, 64 * kb, 32 * nb, WoutT, 1024, 32 * nb, 1, nullptr, 1.f, scr, lane); continue; }
        r -= I_OUT;
        if (r < I_QB) { const int kb = r / 24, nb = r % 24, c0 = 32 * nb, h = c0 / 96, d0 = c0 % 96;
            tr_item<32>(w_qb, 768, 64 * kb, c0, WqbT + (size_t)h * 32768, 8, d0, 1, q_gain, 1.f, scr, lane, (long)kb * 8192, 1024); continue; }
        r -= I_QB;
        { const int kb = r >> 5, nb = r & 31;
            tr_item<32>(w_kvb, 1024, 64 * kb, 32 * nb, WkvbT, 256, 32 * nb, 1, kv_gain, 1.f, scr, lane); }
    }
    const u32x4 z4 = {0u, 0u, 0u, 0u};
    for (int i = gw; i < 128; i += NGW) *(u32x4*)((char*)(WinT + (size_t)1984 * 1024) + (size_t)i * 1024 + lane * 16) = z4;
    for (int i = gw; i < 256; i += NGW) { const int row = i * 4 + (lane >> 4);
        *(u32x4*)((char*)(WkvbT + (size_t)row * 256 + 128) + (lane & 15) * 16) = z4; }
    { const float* wrg = (const float*)a->in[17]; const float* wre = (const float*)a->in[19]; h16* W16 = (h16*)(ws + WS_WRT16);
      for (int i = gw; i < 256 * 1024 / 64; i += NGW) { const int idx = i * 64 + lane, k = idx & 1023, j = idx >> 10; float v = 0.f;
          if (j < 4) v = wrg[k * 4 + j] * gain2[k]; else if (j < 36) v = wre[k * 32 + (j - 4)] * gain2[k];
          W16[idx] = (h16)v; } }
    { const int* positions = (const int*)a->in[1]; float* CS = (float*)(ws + WS_CS);
      for (int i = gw; i < T * 16 / 64; i += NGW) { const int idx = i * 64 + lane, m = idx >> 4, fi = idx & 15;
          const float inv = exp2f(-(float)fi * (13.287712379549449f / 16.0f)); const float ang = (float)positions[m] * inv;
          CS[m * 32 + fi] = cosf(ang); CS[m * 32 + 16 + fi] = sinf(ang); } }
    { const float* x = (const float*)a->in[0]; const float* g1 = (const float*)a->in[2]; h16* H1 = (h16*)(ws + WS_H1);
      f32x4 g[4];
#pragma unroll
      for (int j = 0; j < 4; ++j) g[j] = ((const f32x4*)g1)[lane + 64 * j];
      for (int m = gw; m < T; m += 2 * NGW) {
          const int m2 = m + NGW;
          const f32x4* xr = (const f32x4*)(x + (size_t)m * DM) + lane; const f32x4* xr2 = (const f32x4*)(x + (size_t)(m2 < T ? m2 : m) * DM) + lane;
          f32x4 v[4], v2[4]; float s = 0.f, s2 = 0.f;
#pragma unroll
          for (int j = 0; j < 4; ++j) { v[j] = xr[64 * j]; v2[j] = xr2[64 * j]; }
#pragma unroll
          for (int j = 0; j < 4; ++j) { s += (v[j].x * v[j].x + v[j].y * v[j].y) + (v[j].z * v[j].z + v[j].w * v[j].w); s2 += (v2[j].x * v2[j].x + v2[j].y * v2[j].y) + (v2[j].z * v2[j].z + v2[j].w * v2[j].w); }
          const float rs = rsqrtf(wave_sum(s) * (1.f / DM) + EPS), rs2 = rsqrtf(wave_sum(s2) * (1.f / DM) + EPS);
          unsigned long long* o8 = (unsigned long long*)(H1 + (size_t)m * DM) + lane;
#pragma unroll
          for (int j = 0; j < 4; ++j) __hip_atomic_store(o8 + 64 * j, (unsigned long long)pk_h2(v[j].x * rs * g[j].x, v[j].y * rs * g[j].y) | ((unsigned long long)pk_h2(v[j].z * rs * g[j].z, v[j].w * rs * g[j].w) << 32), __ATOMIC_RELAXED, __HIP_MEMORY_SCOPE_AGENT);
          if (m2 < T) { unsigned long long* p8 = (unsigned long long*)(H1 + (size_t)m2 * DM) + lane;
#pragma unroll
              for (int j = 0; j < 4; ++j) __hip_atomic_store(p8 + 64 * j, (unsigned long long)pk_h2(v2[j].x * rs2 * g[j].x, v2[j].y * rs2 * g[j].y) | ((unsigned long long)pk_h2(v2[j].z * rs2 * g[j].z, v2[j].w * rs2 * g[j].w) << 32), __ATOMIC_RELAXED, __HIP_MEMORY_SCOPE_AGENT); }
      } }
}

namespace g8 {
typedef _Float16 f16x8 __attribute__((ext_vector_type(8)));
constexpr int BM = 256, BK = 64, HALF = 128, HTB = HALF * BK * 2, STAGE_BYTES = 8 * HTB, NXCD = 8, WGM = 8;
__host__ __device__ __forceinline__ int lds_byte(int r, int c) { const int st = (r >> 4) * 2 + (c >> 5), rr = r & 15, cc = c & 31, ob = rr * 64 + cc * 2; return st * 1024 + (ob ^ (((ob >> 9) & 1) << 5)); }
__host__ __device__ __forceinline__ void stage_rc(int b, int& R, int& C) { const int st = b / 1024, sb = b % 1024, swz = sb ^ (((sb >> 9) & 1) << 5); R = (st >> 1) * 16 + swz / 64; C = (st & 1) * 32 + (swz % 64) / 2; }
__host__ __device__ __forceinline__ int perm32(int rho) { const int n = rho >> 4, i = rho & 15; return 8 * (i >> 2) + 4 * n + (i & 3); }
struct Unit { int pm, pn, e, half; };
struct StaticOrder {
    int nM, nN, nwg, G, c;
    __device__ __forceinline__ void init(int nM_, int nN_, int G_, int c_) { nM = nM_; nN = nN_; nwg = nM * nN; G = G_; c = c_; }
    __device__ __forceinline__ bool next(int i, Unit& u) const {
        const long L = (long)i * G + c; if (L >= nwg) return false;
        int wgid = (int)L; { const int q = nwg / NXCD, r = nwg % NXCD, xcd = wgid % NXCD, off = wgid / NXCD; wgid = (xcd < r ? xcd * (q + 1) : r * (q + 1) + (xcd - r) * q) + off; }
        const int nig = WGM * nN, gid = wgid / nig, fm = gid * WGM, gsz = (nM - fm) < WGM ? (nM - fm) : WGM;
        u.pm = fm + ((wgid % nig) % gsz); u.pn = (wgid % nig) / gsz; u.e = 0; u.half = 0; return true;
    }
    __device__ __forceinline__ void a_ready(const Unit&) const {}
};
struct PlainProb {
    static constexpr int AUX_A = 0;
    const h16* A; const h16* Bt; int lda, ldb, K;
    __device__ __forceinline__ const char* a_base() const { return (const char*)A; }
    __device__ __forceinline__ unsigned a_row_off(const Unit& u, int h, int R) const { return (unsigned)((u.pm * BM + h * HALF + R) * lda); }
    __device__ __forceinline__ const char* b_base(const Unit& u) const { return (const char*)(Bt + (size_t)u.pn * BM * ldb); }
};

template <class P, class Epi, class Sched, bool ALIGN_EPI, bool HALFSKIP = false>
__device__ __forceinline__ void gemm_phase(LAS unsigned char* lds, const P& p, const Sched& S, const Epi& E) {
    int tid_ = threadIdx.x; asm volatile("" : "+v"(tid_));
    const int tid = tid_, wid = __builtin_amdgcn_readfirstlane(tid >> 6), lane = tid & 63, wr = wid >> 2, wc = wid & 3, fr = lane & 15, fq = lane >> 4;
    const int K = p.K, nt = K / BK;
    int Rs[2], Cs[2]; unsigned voffB[2];
#pragma unroll
    for (int i = 0; i < 2; ++i) { int R, C; stage_rc(tid * 16 + i * 8192, R, C); Rs[i] = R; Cs[i] = C; const int Rb = Epi::PERM ? ((R & ~31) + perm32(R & 31)) : R; voffB[i] = (unsigned)(Rb * p.ldb + C) * 2u; }
    const size_t kstep = (size_t)(BK * 2);
    const size_t hstepB = (size_t)HALF * p.ldb * 2;
    const unsigned ldsw = (unsigned)wid * 1024u;
    const int aoff = lds_byte(wr * 64 + fr, fq * 8), boff = lds_byte(wc * 32 + fr, fq * 8);
#define G8_SA(b, h) (((b) * 2 + (h)) * HTB)
#define G8_SB(b, h) ((4 + (b) * 2 + (h)) * HTB)
#define G8_STAGE_X(bufoff, gbase, voff, aux) do { _Pragma("unroll") for (int _i = 0; _i < 2; ++_i) \
        __builtin_amdgcn_global_load_lds((const unsigned*)((const char*)(gbase) + (voff)[_i]), (LAS unsigned*)(lds + (bufoff) + ldsw + _i * 8192), 16, 0, aux); } while (0)
#define G8_STAGE(bufoff, gbase, voff) G8_STAGE_X(bufoff, gbase, voff, 0)
#define G8_STAGE_A(bufoff, gbase, voff) G8_STAGE_X(bufoff, gbase, voff, P::AUX_A)
#define G8_LDA(dst, b, h) do { _Pragma("unroll") for (int m = 0; m < 4; ++m) _Pragma("unroll") for (int k = 0; k < 2; ++k) dst[m][k] = *(const LAS f16x8*)(lds + G8_SA(b, h) + aoff + m * 2048 + k * 1024); } while (0)
#define G8_LDB(dst, b, h) do { _Pragma("unroll") for (int n = 0; n < 2; ++n) _Pragma("unroll") for (int k = 0; k < 2; ++k) dst[n][k] = *(const LAS f16x8*)(lds + G8_SB(b, h) + boff + n * 2048 + k * 1024); } while (0)
#define G8_MMA(ai, bj, At, Bt) do { __builtin_amdgcn_s_setprio(1); _Pragma("unroll") for (int m = 0; m < 4; ++m) _Pragma("unroll") for (int n = 0; n < 2; ++n) _Pragma("unroll") for (int k = 0; k < 2; ++k) \
        acc[ai][bj][m][n] = __builtin_amdgcn_mfma_f32_16x16x32_f16(Bt[n][k], At[m][k], acc[ai][bj][m][n], 0, 0, 0); __builtin_amdgcn_s_setprio(0); } while (0)
#define G8_WAIT_V(n) asm volatile("s_waitcnt vmcnt(" #n ")" ::: "memory")
#define G8_WAIT_L(n) asm volatile("s_waitcnt lgkmcnt(" #n ")" ::: "memory")
#define G8_BAR __builtin_amdgcn_s_barrier()
#define G8_SCHED __builtin_amdgcn_sched_barrier(0)
    Unit cur, nxt; int ui = 0;
    if (!S.next(0, cur)) return;
    f32x4 acc[2][2][4][2];
#pragma unroll
    for (int a = 0; a < 2; ++a)
#pragma unroll
        for (int b = 0; b < 2; ++b)
#pragma unroll
            for (int m = 0; m < 4; ++m)
#pragma unroll
                for (int n = 0; n < 2; ++n) acc[a][b][m][n] = (f32x4){0.f, 0.f, 0.f, 0.f};
    f16x8 At[4][2], B0[2][2], B1[2][2];
    const char* const A0 = p.a_base();
    unsigned vAc[2][2], vAn[2][2];
#pragma unroll
    for (int h = 0; h < 2; ++h)
#pragma unroll
        for (int i = 0; i < 2; ++i) vAc[h][i] = (p.a_row_off(cur, h, Rs[i]) + (unsigned)Cs[i]) * 2u;
    const char* cB = p.b_base(cur);
    S.a_ready(cur);
    G8_STAGE(G8_SB(0, 0), cB, voffB); G8_STAGE(G8_SB(0, 1), cB + hstepB, voffB); G8_STAGE_A(G8_SA(0, 0), A0, vAc[0]); G8_STAGE_A(G8_SA(0, 1), A0, vAc[1]);
    if (wr == 1) G8_BAR;
    G8_WAIT_V(2); G8_BAR;
    G8_STAGE(G8_SB(1, 0), cB + kstep, voffB); G8_STAGE_A(G8_SA(1, 0), A0 + kstep, vAc[0]); G8_STAGE(G8_SB(1, 1), cB + hstepB + kstep, voffB);
    G8_WAIT_V(6); G8_BAR;
    for (;;) {
        const bool has_next = S.next(ui + 1, nxt);
        if (has_next) {
#pragma unroll
            for (int h = 0; h < 2; ++h)
#pragma unroll
                for (int i = 0; i < 2; ++i) vAn[h][i] = (p.a_row_off(nxt, h, Rs[i]) + (unsigned)Cs[i]) * 2u;
        } else {
#pragma unroll
            for (int h = 0; h < 2; ++h)
#pragma unroll
                for (int i = 0; i < 2; ++i) vAn[h][i] = vAc[h][i];
        }
        const char* nB = has_next ? p.b_base(nxt) : cB;
        const bool skip1 = HALFSKIP && cur.half != 0;
        for (int t = 0; t < nt; t += 2) {
            const bool last = (t == nt - 2);
            if (last && has_next) S.a_ready(nxt);
            const char* a1 = A0 + (size_t)(t + 1) * kstep;
            const char* a2 = last ? A0 : A0 + (size_t)(t + 2) * kstep; const char* b2 = last ? nB : cB + (size_t)(t + 2) * kstep;
            const char* a3 = a2 + kstep; const char* b3 = b2 + kstep;
            unsigned v2[2][2];
#pragma unroll
            for (int h = 0; h < 2; ++h)
#pragma unroll
                for (int i = 0; i < 2; ++i) v2[h][i] = last ? vAn[h][i] : vAc[h][i];
            G8_LDB(B0, 0, 0); G8_LDB(B1, 0, 1); G8_SCHED; G8_LDA(At, 0, 0); G8_STAGE_A(G8_SA(1, 1), a1, vAc[1]);
            G8_WAIT_V(8); G8_WAIT_L(0); G8_BAR; G8_MMA(0, 0, At, B0); G8_MMA(0, 1, At, B1); G8_BAR; G8_SCHED;
            if (!skip1) G8_LDA(At, 0, 1); G8_STAGE(G8_SB(0, 0), b2, voffB); G8_STAGE(G8_SB(0, 1), b2 + hstepB, voffB); G8_STAGE_A(G8_SA(0, 0), a2, v2[0]);
            G8_WAIT_V(8); G8_WAIT_L(0); G8_BAR; if (!skip1) { G8_MMA(1, 0, At, B0); G8_MMA(1, 1, At, B1); } G8_BAR; G8_SCHED;
            G8_LDB(B0, 1, 0); G8_LDB(B1, 1, 1); G8_SCHED; G8_LDA(At, 1, 0); G8_STAGE_A(G8_SA(0, 1), a2, v2[1]);
            G8_WAIT_V(8); G8_WAIT_L(0); G8_BAR; G8_MMA(0, 0, At, B0); G8_MMA(0, 1, At, B1); G8_BAR; G8_SCHED;
            if (!skip1) G8_LDA(At, 1, 1); G8_STAGE(G8_SB(1, 0), b3, voffB); G8_STAGE(G8_SB(1, 1), b3 + hstepB, voffB); G8_STAGE_A(G8_SA(1, 0), a3, v2[0]);
            G8_WAIT_V(8); G8_WAIT_L(0); G8_BAR; if (!skip1) { G8_MMA(1, 0, At, B0); G8_MMA(1, 1, At, B1); } G8_BAR; G8_SCHED;
        }
        if constexpr (ALIGN_EPI) { if (wr == 0) G8_BAR; }
        if constexpr (!Epi::AFTER_DRAIN) { E(acc, cur, wr, wc, fr, fq); }
        if (!has_next) break;
#pragma unroll
        for (int a = 0; a < 2; ++a)
#pragma unroll
            for (int b = 0; b < 2; ++b)
#pragma unroll
                for (int m = 0; m < 4; ++m)
#pragma unroll
                    for (int n = 0; n < 2; ++n) acc[a][b][m][n] = (f32x4){0.f, 0.f, 0.f, 0.f};
        cur = nxt; cB = nB; ++ui;
#pragma unroll
        for (int h = 0; h < 2; ++h)
#pragma unroll
            for (int i = 0; i < 2; ++i) vAc[h][i] = vAn[h][i];
        if constexpr (ALIGN_EPI) { if (wr == 1) G8_BAR; }
    }
    G8_WAIT_V(0);
    if constexpr (!ALIGN_EPI) { if (wr == 0) G8_BAR; }
    G8_BAR;
    if constexpr (Epi::AFTER_DRAIN) { E.fused(acc, cur, wr, wc, fr, fq, lds, wid, lane); }
#undef G8_SA
#undef G8_SB
#undef G8_STAGE
#undef G8_STAGE_A
#undef G8_STAGE_X
#undef G8_LDA
#undef G8_LDB
#undef G8_MMA
#undef G8_WAIT_V
#undef G8_WAIT_L
#undef G8_BAR
#undef G8_SCHED
}
struct EpiH16 {
    static constexpr bool PERM = true, AFTER_DRAIN = false;
    h16* O; int ldc; h16* QL;
    __device__ __forceinline__ void operator()(const f32x4 (&acc)[2][2][4][2], const Unit& u, int wr, int wc, int fr, int fq) const {
        const int row0 = u.pm * BM + wr * 64 + fr, col0 = u.pn * BM + wc * 32 + 8 * fq;
        const __amdgpu_buffer_rsrc_t ro = __builtin_amdgcn_make_buffer_rsrc(O, 0, 0x7fffffff, 0x00020000), rq = __builtin_amdgcn_make_buffer_rsrc(QL, 0, 0x7fffffff, 0x00020000);
#pragma unroll
        for (int ai = 0; ai < 2; ++ai)
#pragma unroll
            for (int m = 0; m < 4; ++m) { const unsigned rowb = (unsigned)(((row0 + ai * HALF + m * 16) * ldc + col0) * 2);
#pragma unroll
                for (int bj = 0; bj < 2; ++bj) { const f32x4 v0 = acc[ai][bj][m][0], v1 = acc[ai][bj][m][1];
                    u32x4 w; w.x = pk_h2(v0[0], v0[1]); w.y = pk_h2(v0[2], v0[3]); w.z = pk_h2(v1[0], v1[1]); w.w = pk_h2(v1[2], v1[3]);
                    __builtin_amdgcn_raw_buffer_store_b128(w, ro, (int)(rowb + bj * HALF * 2), 0, 16);
                    if (u.pn == 6) { const int row = row0 + ai * HALF + m * 16, chunk = wc * 4 + fq + 16 * bj; __builtin_amdgcn_raw_buffer_store_b128(w, rq, (int)((((row >> 5) * 32 + chunk) * 32 + (row & 31)) * 16), 0, 16); } } }
    }
};
struct OneUnit { Unit u; __device__ __forceinline__ bool next(int i, Unit& o) const { if (i) return false; o = u; return true; } __device__ __forceinline__ void a_ready(const Unit&) const {} };
typedef unsigned u32x2 __attribute__((ext_vector_type(2)));
__device__ __forceinline__ float ssq8(const u32x4 w) {
    typedef _Float16 h2 __attribute__((ext_vector_type(2))); float s = 0.f;
#pragma unroll
    for (int i = 0; i < 4; ++i) { const unsigned ui = w[i]; const h2 v = __builtin_bit_cast(h2, ui); const float a = (float)v.x, b = (float)v.y; s += a * a + b * b; }
    return s;
}
struct EpiKV {
    static constexpr bool PERM = false, AFTER_DRAIN = true;
    const h16* PROJ; const float* kn_gain; const float* CS; h16* KF; h16* VF;
    __device__ __forceinline__ void fused(f32x4 (&acc)[2][2][4][2], const Unit& u, int wr, int wc, int fr, int fq, LAS unsigned char* lds, int wid, int lane) const {
        LAS float* P = (LAS float*)lds;
        LAS float* RS = (LAS float*)(lds + 8192);
        LAS float* KR = (LAS float*)(lds + 8192 + 1024);
        int tid = wid * 64 + lane; asm volatile("" : "+v"(tid));
        u32x4 pr[8], pk2[2];
        { const h16* rp = PROJ + (size_t)(u.pm * BM + (tid >> 1)) * NPROJ; const u32x4* ap = (const u32x4*)(rp + PC_MKVA + (tid & 1) * 64); const u32x4* kp = (const u32x4*)(rp + PC_KROPE + (tid & 1) * 16);
#pragma unroll
          for (int i = 0; i < 8; ++i) pr[i] = ap[i];
          pk2[0] = kp[0]; pk2[1] = kp[1]; }
        if (wc < 2) {
#pragma unroll
            for (int ai = 0; ai < 2; ++ai)
#pragma unroll
                for (int m = 0; m < 4; ++m)
#pragma unroll
                    for (int bj = 0; bj < 2; ++bj) { float sq = 0.f;
#pragma unroll
                        for (int n = 0; n < 2; ++n) { const f32x4 x = acc[ai][bj][m][n]; sq += (x[0] * x[0] + x[1] * x[1]) + (x[2] * x[2] + x[3] * x[3]); }
                        sq += __shfl_xor(sq, 16); sq += __shfl_xor(sq, 32);
                        if (fq == 0) P[((ai * HALF + wr * 64 + m * 16 + fr) * 2 + bj) * 2 + wc] = sq; }
        }
        { const int row = tid >> 1, half = tid & 1; float sq = 0.f;
#pragma unroll
          for (int i = 0; i < 8; ++i) sq += ssq8(pr[i]);
          float kq = ssq8(pk2[0]) + ssq8(pk2[1]);
          sq += __shfl_xor(sq, 1); kq += __shfl_xor(kq, 1);
          if (half == 0) { RS[row] = rsqrtf(sq * (1.f / 128.f) + EPS); KR[row] = kq; } }
        typedef _Float16 h4 __attribute__((ext_vector_type(4)));
        const int gofs = wc < 2 ? wc * 32 + 4 * fq : 64 + 4 * fq;
        const f32x4 gA = *(const f32x4*)(kn_gain + gofs), gB = *(const f32x4*)(kn_gain + gofs + 16);
        h4 ra1[2], ra2[2]; f32x4 rcs[2], rsn[2];
#define EK_ROPE(k) do { if (wc >= 2) { const int gm_ = u.pm * BM + ((k) >> 2) * HALF + wr * 64 + ((k) & 3) * 16 + fr; const h16* rp_ = PROJ + (size_t)gm_ * NPROJ + PC_KROPE + 4 * fq; \
            ra1[(k) % 2] = *(const h4*)rp_; ra2[(k) % 2] = *(const h4*)(rp_ + 16); rcs[(k) % 2] = *(const f32x4*)(CS + (size_t)gm_ * 32 + 4 * fq); rsn[(k) % 2] = *(const f32x4*)(CS + (size_t)gm_ * 32 + 16 + 4 * fq); } } while (0)
#pragma unroll
        for (int k = 0; k < 2; ++k) { ra1[k] = (h4){0, 0, 0, 0}; ra2[k] = (h4){0, 0, 0, 0}; rcs[k] = (f32x4){0.f, 0.f, 0.f, 0.f}; rsn[k] = (f32x4){0.f, 0.f, 0.f, 0.f}; }
        EK_ROPE(0); EK_ROPE(1);
        LDS_WAIT(); __builtin_amdgcn_s_barrier(); asm volatile("" ::: "memory");
#pragma unroll
        for (int ai = 0; ai < 2; ++ai)
#pragma unroll
            for (int m = 0; m < 4; ++m) { const int r = ai * HALF + wr * 64 + m * 16 + fr, gm = u.pm * BM + r, b = gm / SEQ, sp = gm % SEQ; const float rkv = RS[r], krs = KR[r];
                const h4 a1 = ra1[(ai * 4 + m) % 2], a2 = ra2[(ai * 4 + m) % 2]; const f32x4 cs = rcs[(ai * 4 + m) % 2], sn = rsn[(ai * 4 + m) % 2];
                if (ai * 4 + m + 2 < 8) EK_ROPE(ai * 4 + m + 2);
                if (wc < 2) {
#pragma unroll
                    for (int bj = 0; bj < 2; ++bj) { const float tot = (P[(r * 2 + bj) * 2] + P[(r * 2 + bj) * 2 + 1]) * rkv * rkv + krs;
                        const float sc = rkv * rsqrtf(tot * (1.f / 96.f) + EPS);
                        const int d0 = wc * 32 + 4 * fq;
                        const f32x4 v0 = acc[ai][bj][m][0] * gA * sc, v1 = acc[ai][bj][m][1] * gB * sc;
                        h16* kp = KF + ((((size_t)(b * 8 + u.pn * 2 + bj) * 32 + (sp >> 6)) * 12 + (d0 >> 3)) * 64 + (sp & 63)) * 8 + (d0 & 7);
                        u32x2 w0, w1; w0.x = pk_h2(v0[0], v0[1]); w0.y = pk_h2(v0[2], v0[3]); w1.x = pk_h2(v1[0], v1[1]); w1.y = pk_h2(v1[2], v1[3]);
                        __hip_atomic_store((unsigned long long*)kp, (unsigned long long)w0.x | ((unsigned long long)w0.y << 32), __ATOMIC_RELAXED, __HIP_MEMORY_SCOPE_AGENT); __hip_atomic_store((unsigned long long*)(kp + 2 * 512), (unsigned long long)w1.x | ((unsigned long long)w1.y << 32), __ATOMIC_RELAXED, __HIP_MEMORY_SCOPE_AGENT); }
                } else {
#pragma unroll
                    for (int bj = 0; bj < 2; ++bj) { const int e0 = (wc - 2) * 32 + 4 * fq; const f32x4 v0 = acc[ai][bj][m][0] * rkv, v1 = acc[ai][bj][m][1] * rkv;
                        { int rr = r; asm volatile("" : "+v"(rr)); const int t16 = rr & 15, pos = (rr & 48) + (t16 < 4 ? t16 : t16 < 8 ? t16 + 4 : t16 < 12 ? t16 - 4 : t16);
                          LAS h16* vp = (LAS h16*)(lds + 16384) + (((bj * 4 + (rr >> 6)) * 8 + (pos >> 3)) * 64 + e0) * 8 + (pos & 7);
#pragma unroll
                          for (int j = 0; j < 4; ++j) { vp[j * 8] = (h16)v0[j]; vp[(16 + j) * 8] = (h16)v1[j]; } }
                        }
                    { const int bj = wc - 2; const float tot = (P[(r * 2 + bj) * 2] + P[(r * 2 + bj) * 2 + 1]) * rkv * rkv + krs; const float ri = rsqrtf(tot * (1.f / 96.f) + EPS);
                      f32x4 t1, t2;
#pragma unroll
                      for (int j = 0; j < 4; ++j) { t1[j] = (float)a1[j] * ri * gA[j]; t2[j] = (float)a2[j] * ri * gB[j]; }
                      const f32x4 o1 = t1 * cs - t2 * sn, o2 = t1 * sn + t2 * cs;
                      h16* kp = KF + ((((size_t)(b * 8 + u.pn * 2 + bj) * 32 + (sp >> 6)) * 12 + ((64 + 4 * fq) >> 3)) * 64 + (sp & 63)) * 8 + ((4 * fq) & 7);
                      u32x2 w0, w1; w0.x = pk_h2(o1[0], o1[1]); w0.y = pk_h2(o1[2], o1[3]); w1.x = pk_h2(o2[0], o2[1]); w1.y = pk_h2(o2[2], o2[3]);
                      __hip_atomic_store((unsigned long long*)kp, (unsigned long long)w0.x | ((unsigned long long)w0.y << 32), __ATOMIC_RELAXED, __HIP_MEMORY_SCOPE_AGENT); __hip_atomic_store((unsigned long long*)(kp + 2 * 512), (unsigned long long)w1.x | ((unsigned long long)w1.y << 32), __ATOMIC_RELAXED, __HIP_MEMORY_SCOPE_AGENT); }
                } }
        LDS_WAIT(); __builtin_amdgcn_s_barrier(); asm volatile("" ::: "memory");
        { const int b0 = (u.pm * BM) / SEQ, t0 = ((u.pm * BM) % SEQ) >> 6;
          const __amdgpu_buffer_rsrc_t rvf = __builtin_amdgcn_make_buffer_rsrc(VF, 0, 0x7fffffff, 0x00020000);
#pragma unroll
          for (int i = 0; i < 8; ++i) { const int ch = i * 512 + tid, blk = ch >> 9, off = ch & 511;
              const u32x4 v = *(const LAS u32x4*)(lds + 16384 + ch * 16);
              __builtin_amdgcn_raw_buffer_store_b128(v, rvf, (int)(((((unsigned)(b0 * 8 + u.pn * 2 + (blk >> 2)) * 32 + t0 + (blk & 3)) * 4096) + off * 8) * 2), 0, 16); } }
    }
};
struct EpiResid {
    static constexpr bool PERM = true, AFTER_DRAIN = false;
    const float* X; h16* O; float* SSQ;
    __device__ __forceinline__ void operator()(const f32x4 (&acc)[2][2][4][2], const Unit& u, int wr, int wc, int fr, int fq) const {
        const int row0 = u.pm * BM + wr * 64 + fr, col0 = u.pn * BM + wc * 32 + 8 * fq;
#pragma unroll
        for (int aq = 0; aq < 4; ++aq) { const int ai = aq >> 1;
            f32x4 xa[2][2][2];
#pragma unroll
            for (int mm = 0; mm < 2; ++mm)
#pragma unroll
                for (int bj = 0; bj < 2; ++bj) { const float* xp = X + (size_t)(row0 + ai * HALF + ((aq & 1) * 2 + mm) * 16) * DM + col0 + bj * HALF; xa[mm][bj][0] = *(const f32x4*)xp; xa[mm][bj][1] = *(const f32x4*)(xp + 4); }
#pragma unroll
            for (int mm = 0; mm < 2; ++mm) { const int m = (aq & 1) * 2 + mm; const int row = row0 + ai * HALF + m * 16; float sq = 0.f;
#pragma unroll
                for (int bj = 0; bj < 2; ++bj) { const f32x4 x0 = xa[mm][bj][0], x1 = xa[mm][bj][1];
                    const f32x4 v0 = acc[ai][bj][m][0] + x0, v1 = acc[ai][bj][m][1] + x1;
                    sq += (v0[0] * v0[0] + v0[1] * v0[1]) + (v0[2] * v0[2] + v0[3] * v0[3]) + (v1[0] * v1[0] + v1[1] * v1[1]) + (v1[2] * v1[2] + v1[3] * v1[3]);
                    u32x4 w; w.x = pk_h2(v0[0], v0[1]); w.y = pk_h2(v0[2], v0[3]); w.z = pk_h2(v1[0], v1[1]); w.w = pk_h2(v1[2], v1[3]);
                    *(u32x4*)(O + (size_t)row * DM + col0 + bj * HALF) = w; }
                sq += __shfl_xor(sq, 16); sq += __shfl_xor(sq, 32);
                if (fq == 0) SSQ[(size_t)row * 16 + u.pn * 4 + wc] = sq; } }
    }
};
struct DynGroupSched {
    const volatile LAS int* GT; int ncol; unsigned* ctr; volatile LAS unsigned* slot;
    __device__ __forceinline__ bool next(int i, Unit& u) const {
        if (threadIdx.x == 0) slot[i & 1] = __hip_atomic_fetch_add(ctr, 1u, __ATOMIC_RELAXED, __HIP_MEMORY_SCOPE_AGENT);
        asm volatile("s_waitcnt vmcnt(0) lgkmcnt(0)" ::: "memory"); __builtin_amdgcn_s_barrier(); asm volatile("" ::: "memory");
        const int L = (int)slot[i & 1], total = GT[32] * ncol; if (L >= total) return false;
        const int g = L / ncol, nfull = GT[192 + 32]; int e = 0, pm;
        if (g < nfull) {
            const int le = threadIdx.x & 31, lo = GT[192 + le], hi2 = GT[192 + le + 1];
            const unsigned long long m = __ballot(lo <= g && g < hi2);
            e = (int)(__ffsll((long long)m) - 1) & 31; pm = g - GT[192 + e]; }
        else { e = GT[232 + (g - nfull)]; pm = GT[128 + e] >> 8; }
        u.e = e; u.pm = pm; u.pn = L - g * ncol; u.half = (GT[128 + e] - pm * 256) <= 128; return true;
    }
    __device__ __forceinline__ void a_ready(const Unit&) const {}
};
struct DynGroupSchedDep : DynGroupSched {
    unsigned* DONE; unsigned need;
    __device__ __forceinline__ void a_ready(const Unit& u) const {
        if (threadIdx.x < 64) {
            unsigned* p = DONE + 16 * (GT[u.e] + u.pm); unsigned sp = 0;
            while ((unsigned)__builtin_amdgcn_readfirstlane(__hip_atomic_load(p, __ATOMIC_RELAXED, __HIP_MEMORY_SCOPE_AGENT)) < need) { __builtin_amdgcn_s_sleep(2); if (++sp > (1u << 22)) break; }
            asm volatile("s_waitcnt vmcnt(0)" ::: "memory");
        }
        asm volatile("" ::: "memory"); __builtin_amdgcn_s_barrier(); asm volatile("" ::: "memory");
    }
};
struct GatherProb {
    static constexpr int AUX_A = 0;
    const h16* X; const h16* W; const int* ETOK; const volatile LAS int* GT; int lda, ldb, K;
    __device__ __forceinline__ const char* a_base() const { return (const char*)X; }
    __device__ __forceinline__ unsigned a_row_off(const Unit& u, int h, int R) const { int pos = u.pm * BM + h * HALF + R; const int n = GT[128 + u.e]; pos = pos < n ? pos : n - 1;
        return (unsigned)ETOK[u.e * ECAP + pos] * (unsigned)lda; }
    __device__ __forceinline__ const char* b_base(const Unit& u) const { return (const char*)(W + ((size_t)u.e * 512 + (size_t)u.pn * BM) * ldb); }
};
struct SlotProb {
    static constexpr int AUX_A = 16;
    const h16* H; const h16* W; const volatile LAS int* GT; int lda, ldb, K;
    __device__ __forceinline__ const char* a_base() const { return (const char*)H; }
    __device__ __forceinline__ unsigned a_row_off(const Unit& u, int h, int R) const { return (unsigned)((GT[64 + u.e] + u.pm * BM + h * HALF + R) * lda); }
    __device__ __forceinline__ const char* b_base(const Unit& u) const { return (const char*)(W + ((size_t)u.e * 1024 + (size_t)u.pn * BM) * ldb); }
};
struct EpiHid {
    static constexpr bool PERM = true, AFTER_DRAIN = false;
    const float* ESC; const volatile LAS int* GT; h16* HID; unsigned* DONE;
    __device__ __forceinline__ void operator()(const f32x4 (&acc)[2][2][4][2], const Unit& u, int wr, int wc, int fr, int fq) const {
        const int n = GT[128 + u.e], base = GT[64 + u.e];
        typedef float f32x2 __attribute__((ext_vector_type(2)));
        f32x2 esc[8];
        const float* ep0 = ESC + (size_t)u.e * ECAP * 2;
#pragma unroll
        for (int k = 0; k < 8; ++k) { const int pos = u.pm * BM + (k >> 2) * HALF + wr * 64 + (k & 3) * 16 + fr; esc[k] = *(const f32x2*)(ep0 + (size_t)(pos < n ? pos : n - 1) * 2); }
#pragma unroll
        for (int ai = 0; ai < 2; ++ai) { if (ai == 1 && u.half) break;
#pragma unroll
            for (int m = 0; m < 4; ++m) { const int pos = u.pm * BM + ai * HALF + wr * 64 + m * 16 + fr; const bool ok = pos < n;
                const float rs = ok ? esc[ai * 4 + m][0] : 0.f, w = ok ? esc[ai * 4 + m][1] : 0.f;
#pragma unroll
                for (int bj = 0; bj < 2; ++bj) { const f32x4 v0 = acc[ai][bj][m][0] * rs, v1 = acc[ai][bj][m][1] * rs;
                    const float h0 = v0[0] / (1.f + __expf(-v0[0])) * v0[1] * w, h1 = v0[2] / (1.f + __expf(-v0[2])) * v0[3] * w;
                    const float h2 = v1[0] / (1.f + __expf(-v1[0])) * v1[1] * w, h3 = v1[2] / (1.f + __expf(-v1[2])) * v1[3] * w;
                    const unsigned long long o = (unsigned long long)pk_h2(h0, h1) | ((unsigned long long)pk_h2(h2, h3) << 32);
                    __hip_atomic_store((unsigned long long*)(HID + (size_t)(base + pos) * DEXP + u.pn * 128 + bj * 64 + wc * 16 + 4 * fq), o, __ATOMIC_RELAXED, __HIP_MEMORY_SCOPE_AGENT); } } }
        asm volatile("s_waitcnt vmcnt(0)" ::: "memory");
        if (fr == 0 && fq == 0) __hip_atomic_fetch_add(DONE + 16 * (GT[u.e] + u.pm), 1u, __ATOMIC_RELAXED, __HIP_MEMORY_SCOPE_AGENT);
    }
};
struct EpiY {
    static constexpr bool PERM = true, AFTER_DRAIN = false;
    const volatile LAS int* GT; h16* Y;
    __device__ __forceinline__ void operator()(const f32x4 (&acc)[2][2][4][2], const Unit& u, int wr, int wc, int fr, int fq) const {
        const int row0 = GT[64 + u.e] + u.pm * BM + wr * 64 + fr, col0 = u.pn * BM + wc * 32 + 8 * fq;
#pragma unroll
        for (int ai = 0; ai < 2; ++ai) { if (ai == 1 && u.half) break;
#pragma unroll
            for (int m = 0; m < 4; ++m) { h16* rowp = Y + (size_t)(row0 + ai * HALF + m * 16) * DM + col0;
#pragma unroll
                for (int bj = 0; bj < 2; ++bj) { const f32x4 v0 = acc[ai][bj][m][0], v1 = acc[ai][bj][m][1];
                    u32x4 w; w.x = pk_h2(v0[0], v0[1]); w.y = pk_h2(v0[2], v0[3]); w.z = pk_h2(v1[0], v1[1]); w.w = pk_h2(v1[2], v1[3]);
                    *(u32x4*)(rowp + bj * HALF) = w; } } }
    }
};
}

__device__ __forceinline__ void gla_combine_rows(const h16* OGLA, const h16* PROJ, const float* og_gain, h16* MIX, int m0, int m1, int mstep, int lane) {
    typedef _Float16 h8 __attribute__((ext_vector_type(8)));
    const int c = lane * 8;
    const f32x4 g0 = *(const f32x4*)(og_gain + (c & 127)), g1 = *(const f32x4*)(og_gain + (c & 127) + 4);
    for (int mb = m0; mb < m1; mb += 4 * mstep) {
        h8 a[4], b2[4], g[4];
#pragma unroll
        for (int q = 0; q < 4; ++q) { const int m = mb + q * mstep < m1 ? mb + q * mstep : mb;
            a[q] = *(const h8*)(OGLA + (size_t)m * 512 + c); b2[q] = *(const h8*)(OGLA + ((size_t)T + m) * 512 + c); g[q] = *(const h8*)(PROJ + (size_t)m * NPROJ + PC_GATE + c); }
#pragma unroll
        for (int q = 0; q < 4; ++q) { const int m = mb + q * mstep; if (m >= m1) break;
            float o[8]; float sq = 0.f;
#pragma unroll
            for (int k = 0; k < 8; ++k) { o[k] = (float)a[q][k] + (float)b2[q][k]; sq += o[k] * o[k]; }
            sq += __shfl_xor(sq, 1); sq += __shfl_xor(sq, 2); sq += __shfl_xor(sq, 4); sq += __shfl_xor(sq, 8);
            const float rs = rsqrtf(sq * (1.f / 128.f) + EPS);
            float r[8];
#pragma unroll
            for (int k = 0; k < 8; ++k) { const float gg = (float)g[q][k]; r[k] = o[k] * rs * (k < 4 ? g0[k] : g1[k - 4]) * (gg / (1.f + __expf(-gg))); }
            u32x4 w; w.x = pk_h2(r[0], r[1]); w.y = pk_h2(r[2], r[3]); w.z = pk_h2(r[4], r[5]); w.w = pk_h2(r[6], r[7]);
            *(u32x4*)(MIX + (size_t)m * DM + c) = w; }
    }
}

namespace at {
typedef _Float16 f16x8 __attribute__((ext_vector_type(8)));
typedef float f32x16 __attribute__((ext_vector_type(16)));
typedef __fp16 fp16x2 __attribute__((ext_vector_type(2)));
constexpr int KB_BYTES = 12288, VB_BYTES = 8192, TILE_BYTES = KB_BYTES + VB_BYTES, BUF_BYTES = 2 * TILE_BYTES, NT2 = SEQ / 128;
constexpr float THR = 8.f;
__device__ __forceinline__ int crow(int r, int hi) { return (r & 3) + 8 * (r >> 2) + 4 * hi; }
#define AT_DMA(gsrc, ldsoff) __builtin_amdgcn_global_load_lds((const unsigned*)(gsrc), (LAS unsigned*)(lds + (ldsoff)), 16, 0, 0)
__device__ __forceinline__ void attn_unit(LAS unsigned char* lds, const h16* __restrict__ QLAT, const h16* __restrict__ WQBT, const float* __restrict__ qn_gain, const float* __restrict__ CS,
                                          const h16* __restrict__ KF, const h16* __restrict__ VT, h16* __restrict__ MIX, int bh, int qb) {
    int tid = threadIdx.x; asm volatile("" : "+v"(tid));
    const int lane = tid & 63, wid = __builtin_amdgcn_readfirstlane(tid >> 6), r32 = lane & 31, hi = lane >> 5;
    LAS float* wsf = (LAS float*)(lds + 2 * BUF_BYTES) + wid * 64;
    const h16* kg = KF + (size_t)bh * SEQ * 96 + wid * 512 + lane * 8;
    const h16* vg = VT + (size_t)bh * SEQ * 64 + wid * 512 + lane * 8;
    const int kdst = wid * 1024, vdst = KB_BYTES + wid * 1024;
    constexpr int WQ_OFF = BUF_BYTES;
    const int b_ = bh >> 3, h_ = bh & 7; const int gm = b_ * SEQ + qb * 256 + wid * 32 + r32;
    { const h16* wb = WQBT + (size_t)h_ * 32768;
#pragma unroll
      for (int j = 0; j < 6; ++j) { const int c16 = (wid * 6 + j) * 64 + lane, kc = c16 / 96, n = c16 - kc * 96;
          AT_DMA(wb + ((size_t)kc * 128 + n) * 8, WQ_OFF + (wid * 6 + j) * 1024); } }
    f16x8 lf[16];
    { const h16* lp = QLAT + ((size_t)(gm >> 5) * 1024 + hi * 32 + r32) * 8;
#pragma unroll
      for (int ks = 0; ks < 16; ++ks) lf[ks] = *(const f16x8*)(lp + (size_t)ks * 512); }
    f32x4 rcs[2], rsn[2];
#pragma unroll
    for (int g = 0; g < 2; ++g) { rcs[g] = *(const f32x4*)(CS + (size_t)gm * 32 + 8 * g + 4 * hi); rsn[g] = *(const f32x4*)(CS + (size_t)gm * 32 + 16 + 8 * g + 4 * hi); }
#define AT_ISSUE1(t, off) do { AT_DMA(kg + (size_t)(t) * 6144, (off) + kdst); if (wid < 4) AT_DMA(kg + (size_t)(t) * 6144 + 8 * 512, (off) + kdst + 8192); AT_DMA(vg + (size_t)(t) * 4096, (off) + vdst); } while (0)
#define AT_ISSUE(t2, b) do { AT_ISSUE1(2 * (t2), (b) * BUF_BYTES); AT_ISSUE1(2 * (t2) + 1, (b) * BUF_BYTES + TILE_BYTES); } while (0)
    f32x16 o0, o1;
#pragma unroll
    for (int r = 0; r < 16; ++r) { o0[r] = 0.f; o1[r] = 0.f; }
    float m_run = 0.f, l_run = 0.f;
    AT_ISSUE(0, 0);
    asm volatile("s_waitcnt vmcnt(0)" ::: "memory"); __builtin_amdgcn_s_barrier(); asm volatile("" ::: "memory");
    f16x8 qf[6];
    { f32x16 qa[3];
#pragma unroll
      for (int nb = 0; nb < 3; ++nb)
#pragma unroll
          for (int r = 0; r < 16; ++r) qa[nb][r] = 0.f;
#pragma unroll
      for (int ks = 0; ks < 16; ++ks)
#pragma unroll
          for (int nb = 0; nb < 3; ++nb) { const f16x8 wf = *(const LAS f16x8*)(lds + WQ_OFF + ((2 * ks + hi) * 96 + 32 * nb + r32) * 16);
              qa[nb] = __builtin_amdgcn_mfma_f32_32x32x16_f16(wf, lf[ks], qa[nb], 0, 0, 0); }
      float ss = 0.f;
#pragma unroll
      for (int ks = 0; ks < 16; ++ks)
#pragma unroll
          for (int j = 0; j < 8; ++j) { const float v = (float)lf[ks][j]; ss += v * v; }
      ss += __shfl_xor(ss, 32);
      const float rq = rsqrtf(ss * (1.f / 256.f) + EPS);
      float tot = 0.f;
#pragma unroll
      for (int nb = 0; nb < 3; ++nb)
#pragma unroll
          for (int r = 0; r < 16; ++r) tot += qa[nb][r] * qa[nb][r];
      tot += __shfl_xor(tot, 32);
      const float sc = rq * rsqrtf(rq * rq * tot * (1.f / 96.f) + EPS) * (0.10206207261596577f * 1.4426950408889634f);
#pragma unroll
      for (int nb = 0; nb < 3; ++nb)
#pragma unroll
          for (int g = 0; g < 4; ++g) { const f32x4 gn = *(const f32x4*)(qn_gain + 32 * nb + 8 * g + 4 * hi);
#pragma unroll
              for (int j = 0; j < 4; ++j) qa[nb][4 * g + j] *= gn[j] * sc; }
#pragma unroll
      for (int g = 0; g < 2; ++g)
#pragma unroll
          for (int j = 0; j < 4; ++j) { const float t1 = qa[2][4 * g + j], t2 = qa[2][8 + 4 * g + j]; qa[2][4 * g + j] = t1 * rcs[g][j] - t2 * rsn[g][j]; qa[2][8 + 4 * g + j] = t1 * rsn[g][j] + t2 * rcs[g][j]; }
      asm volatile("s_waitcnt lgkmcnt(0)" ::: "memory"); __builtin_amdgcn_s_barrier(); asm volatile("" ::: "memory");
      LAS unsigned char* qt = lds + WQ_OFF + wid * (32 * 208) + r32 * 208;
#pragma unroll
      for (int nb = 0; nb < 3; ++nb)
#pragma unroll
          for (int g = 0; g < 4; ++g) { g8::u32x2 w2; w2.x = pk_h2(qa[nb][4 * g], qa[nb][4 * g + 1]); w2.y = pk_h2(qa[nb][4 * g + 2], qa[nb][4 * g + 3]);
              *(LAS g8::u32x2*)(qt + (32 * nb + 8 * g + 4 * hi) * 2) = w2; }
      asm volatile("s_waitcnt lgkmcnt(0)" ::: "memory");
#pragma unroll
      for (int ks = 0; ks < 6; ++ks) qf[ks] = *(const LAS f16x8*)(qt + (16 * ks + 8 * hi) * 2);
      asm volatile("s_waitcnt lgkmcnt(0)" ::: "memory"); __builtin_amdgcn_s_barrier(); asm volatile("" ::: "memory"); }
    for (int t = 0; t < NT2; ++t) {
        const int cur = t & 1;
        if (t + 1 < NT2) AT_ISSUE(t + 1, cur ^ 1);
        LAS unsigned char* Kb = lds + cur * BUF_BYTES; LAS unsigned char* Vb = Kb + KB_BYTES;
        f32x16 s[4];
        { const float nm = -m_run;
#pragma unroll
          for (int q = 0; q < 4; ++q)
#pragma unroll
              for (int r = 0; r < 16; ++r) s[q][r] = nm; }
#pragma unroll
        for (int tl = 0; tl < 2; ++tl) {
            f16x8 kf[12];
#pragma unroll
            for (int ks = 0; ks < 6; ++ks) { kf[2 * ks] = *(const LAS f16x8*)(Kb + tl * TILE_BYTES + (2 * ks + hi) * 1024 + r32 * 16); kf[2 * ks + 1] = *(const LAS f16x8*)(Kb + tl * TILE_BYTES + (2 * ks + hi) * 1024 + (32 + r32) * 16); }
            asm volatile("s_waitcnt lgkmcnt(0)" ::: "memory"); __builtin_amdgcn_sched_barrier(0);
            __builtin_amdgcn_s_setprio(1);
#pragma unroll
            for (int ks = 0; ks < 6; ++ks) {
                s[2 * tl] = __builtin_amdgcn_mfma_f32_32x32x16_f16(kf[2 * ks], qf[ks], s[2 * tl], 0, 0, 0);
                s[2 * tl + 1] = __builtin_amdgcn_mfma_f32_32x32x16_f16(kf[2 * ks + 1], qf[ks], s[2 * tl + 1], 0, 0, 0);
            }
            __builtin_amdgcn_s_setprio(0);
        }
        float mx = fmaxf(fmaxf(s[0][0], s[1][0]), fmaxf(s[2][0], s[3][0]));
#pragma unroll
        for (int r = 1; r < 16; ++r) mx = fmaxf(mx, fmaxf(fmaxf(s[0][r], s[1][r]), fmaxf(s[2][r], s[3][r])));
        mx = fmaxf(mx, __shfl_xor(mx, 32));
        if (t == 0 || __any(mx > THR)) {
            const float d = (t == 0) ? mx : fmaxf(mx, 0.f), f = __builtin_amdgcn_exp2f(-d);
            m_run += d;
#pragma unroll
            for (int q = 0; q < 4; ++q)
#pragma unroll
                for (int r = 0; r < 16; ++r) s[q][r] -= d;
            if (t != 0) { l_run *= f;
                if (hi == 0) wsf[r32] = f;
                asm volatile("s_waitcnt lgkmcnt(0)" ::: "memory");
#pragma unroll
                for (int r = 0; r < 16; ++r) { const float ff = wsf[crow(r, hi)]; o0[r] *= ff; o1[r] *= ff; } }
        }
#pragma unroll
        for (int tl = 0; tl < 2; ++tl) {
#pragma unroll
            for (int r = 0; r < 16; ++r) { s[2 * tl][r] = __builtin_amdgcn_exp2f(s[2 * tl][r]); s[2 * tl + 1][r] = __builtin_amdgcn_exp2f(s[2 * tl + 1][r]); l_run += s[2 * tl][r]; l_run += s[2 * tl + 1][r]; }
            f16x8 vf[8], pa[4];
#pragma unroll
            for (int g = 0; g < 4; ++g) { vf[2 * g] = *(const LAS f16x8*)(Vb + tl * TILE_BYTES + (2 * g + hi) * 1024 + r32 * 16); vf[2 * g + 1] = *(const LAS f16x8*)(Vb + tl * TILE_BYTES + (2 * g + hi) * 1024 + (32 + r32) * 16); }
#pragma unroll
            for (int g = 0; g < 4; ++g)
#pragma unroll
                for (int j = 0; j < 4; ++j) { const int base = 8 * (g & 1) + 2 * j; const fp16x2 pk = __builtin_amdgcn_cvt_pkrtz(s[2 * tl + (g >> 1)][base], s[2 * tl + (g >> 1)][base + 1]); pa[g][2 * j] = (h16)pk[0]; pa[g][2 * j + 1] = (h16)pk[1]; }
            asm volatile("s_waitcnt lgkmcnt(0)" ::: "memory"); __builtin_amdgcn_sched_barrier(0);
            __builtin_amdgcn_s_setprio(1);
#pragma unroll
            for (int g = 0; g < 4; ++g) {
                o0 = __builtin_amdgcn_mfma_f32_32x32x16_f16(pa[g], vf[2 * g], o0, 0, 0, 0);
                o1 = __builtin_amdgcn_mfma_f32_32x32x16_f16(pa[g], vf[2 * g + 1], o1, 0, 0, 0);
            }
            __builtin_amdgcn_s_setprio(0);
        }
        asm volatile("s_waitcnt vmcnt(0) lgkmcnt(0)" ::: "memory"); __builtin_amdgcn_s_barrier(); asm volatile("" ::: "memory");
    }
    l_run += __shfl_xor(l_run, 32);
    if (hi == 0) wsf[r32] = 1.f / l_run;
    asm volatile("s_waitcnt lgkmcnt(0)" ::: "memory");
    const int b = bh >> 3, h = bh & 7;
    h16* op = MIX + ((size_t)b * SEQ + qb * 256 + wid * 32) * DM + 512 + h * 64 + r32;
#pragma unroll
    for (int r = 0; r < 16; ++r) { const int q = crow(r, hi); const float il = wsf[q]; op[(size_t)q * DM] = (h16)(o0[r] * il); op[(size_t)q * DM + 32] = (h16)(o1[r] * il); }
    asm volatile("s_waitcnt lgkmcnt(0)" ::: "memory"); __builtin_amdgcn_s_barrier(); asm volatile("" ::: "memory");
#undef AT_ISSUE
#undef AT_ISSUE1
}
#undef AT_DMA
}

namespace gl {
typedef _Float16 f16x8 __attribute__((ext_vector_type(8)));
typedef _Float16 f16x4 __attribute__((ext_vector_type(4)));
typedef short v4i16_t __attribute__((ext_vector_type(4)));
constexpr int RAW_Q = 0, RAW_K = 8192, RAW_V = 16384, RAW_LR = 32768, RAW_BYTES = 34816;
constexpr int OFF_QREL = 2 * RAW_BYTES, RS = 144  , IMG = 64 * RS;
constexpr int OFF_KREL = OFF_QREL + IMG, OFF_QDEC = OFF_KREL + IMG, OFF_KDECT = OFF_QDEC + IMG, OFF_SC = OFF_KDECT + IMG, OFF_TOT = OFF_SC + IMG, OFF_EBL = OFF_TOT + 2048, GLA_LDS = OFF_EBL + 256;
static_assert(GLA_LDS <= RING_BYTES, "GLA LDS map");
__device__ __forceinline__ int vswz(int token) { return 2 * ((token & 3) | (((token >> 3) & 1) << 2)); }
#define GL_DMA(gsrc, ldsoff) __builtin_amdgcn_global_load_lds((const unsigned*)(gsrc), (LAS unsigned*)(lds + (ldsoff)), 16, 0, 0)
#define GL_BAR() do { asm volatile("s_waitcnt lgkmcnt(0)" ::: "memory"); __builtin_amdgcn_s_barrier(); asm volatile("" ::: "memory"); } while (0)
__device__ __forceinline__ void gla_unit(LAS unsigned char* lds, const h16* __restrict__ PROJ, const float* __restrict__ GW, const float* __restrict__ GB, h16* __restrict__ OG, int b, int h, int dir) {
    int tid = threadIdx.x; asm volatile("" : "+v"(tid));
    const int lane = tid & 63, w = __builtin_amdgcn_readfirstlane(tid >> 6), l15 = lane & 15, kg = lane >> 4;
    typedef _Float16 h2v __attribute__((ext_vector_type(2)));
    h2v gwp[8];
#pragma unroll
    for (int r = 0; r < 8; ++r) gwp[r] = (h2v){(h16)GW[(2 * r) * 256 + h * 64 + lane], (h16)GW[(2 * r + 1) * 256 + h * 64 + lane]};
    const float gb = GB[h * 64 + lane];
    const h16* pb = PROJ + (size_t)b * SEQ * NPROJ;
    f32x4 Sacc[4];
#pragma unroll
    for (int k = 0; k < 4; ++k) Sacc[k] = (f32x4){0.f, 0.f, 0.f, 0.f};
#define GL_TOK(c, i) (dir ? (SEQ - 1 - ((c) * 64 + (i))) : ((c) * 64 + (i)))
#define GL_ISSUE(c, buf) do { const int _rb = (buf) * RAW_BYTES; \
        { const int row = 8 * w + (lane >> 3); const h16* src = pb + (size_t)GL_TOK(c, row) * NPROJ + h * 64 + (lane & 7) * 8; GL_DMA(src + PC_Q, _rb + RAW_Q + w * 1024); GL_DMA(src + PC_K, _rb + RAW_K + w * 1024); } \
        _Pragma("unroll") for (int _j = 0; _j < 2; ++_j) { const int row = 8 * w + 4 * _j + (lane >> 4); const int cc = (lane & 15) ^ vswz(row); \
            GL_DMA(pb + (size_t)GL_TOK(c, row) * NPROJ + PC_V + h * 128 + cc * 8, _rb + RAW_V + (2 * w + _j) * 1024); } \
        if (lane < 16) { const int row = 8 * w + (lane >> 1); GL_DMA(pb + (size_t)GL_TOK(c, row) * NPROJ + (dir ? PC_LRB : PC_LRF) + (lane & 1) * 8, _rb + RAW_LR + w * 256); } } while (0)
    f32x4 opend[4];
    float bl[8];
#define GL_GATES(rb_) do { float run = 0.f; const LAS unsigned char* lrp_ = lds + (rb_) * RAW_BYTES + RAW_LR; \
        _Pragma("unroll") for (int k = 0; k < 8; ++k) { const int i = 8 * w + k; const f16x8 l0 = *(const LAS f16x8*)(lrp_ + i * 32), l1 = *(const LAS f16x8*)(lrp_ + i * 32 + 16); \
            float z = gb, z1 = 0.f; \
            _Pragma("unroll") for (int r = 0; r < 4; ++r) { z = __builtin_amdgcn_fdot2((h2v){l0[2 * r], l0[2 * r + 1]}, gwp[r], z, false); z1 = __builtin_amdgcn_fdot2((h2v){l1[2 * r], l1[2 * r + 1]}, gwp[4 + r], z1, false); } \
            z += z1; \
            const float z2 = z * 1.4426950408889634f; \
            const float ls2 = fminf(z2, 0.f) - __builtin_amdgcn_logf(1.f + __builtin_amdgcn_exp2f(-fabsf(z2))); \
            run += ls2 * (1.f / 16.f); bl[k] = run; } \
        ((LAS float*)(lds + OFF_TOT))[w * 64 + lane] = run; } while (0)
    GL_ISSUE(0, 0);
    asm volatile("s_waitcnt vmcnt(0)" ::: "memory");
    GL_GATES(0);
    GL_BAR();
    for (int c = 0; c < SEQ / 64; ++c) {
        const int cur = c & 1; LAS unsigned char* raw = lds + cur * RAW_BYTES;
        if (c + 1 < SEQ / 64) GL_ISSUE(c + 1, cur ^ 1);
        float pre = 0.f, bref = 0.f, blast = 0.f;
#pragma unroll
        for (int ww = 0; ww < 8; ++ww) { const float tv = ((const LAS float*)(lds + OFF_TOT))[ww * 64 + lane]; if (ww < w) pre += tv; if (ww < 4) bref += tv; blast += tv; }
        { const int d = lane; const int dperm = (d & 32) + 8 * ((d >> 2) & 3) + 4 * ((d >> 4) & 1) + (d & 3);
          f16x8 kd; const float eref = __builtin_amdgcn_exp2f(bref), elr = __builtin_amdgcn_exp2f(blast - bref);
#pragma unroll
          for (int k = 0; k < 8; ++k) { const int i = 8 * w + k; const float bb = pre + bl[k];
              const float qv = (float)*(const LAS h16*)(raw + RAW_Q + i * 128 + d * 2), kv = (float)*(const LAS h16*)(raw + RAW_K + i * 128 + d * 2);
              const float dd = fminf(fmaxf(bb - bref, -14.f), 14.f); const float e1 = __builtin_amdgcn_exp2f(dd), e1i = __builtin_amdgcn_rcpf(e1);
              const float qr = qv * e1, kr = kv * e1i;
              *(LAS h16*)(lds + OFF_QREL + i * RS + d * 2) = (h16)qr;
              *(LAS h16*)(lds + OFF_KREL + i * RS + d * 2) = (h16)kr;
              *(LAS h16*)(lds + OFF_QDEC + i * RS + dperm * 2) = (h16)(qr * eref);
              kd[k] = (h16)(kr * elr); }
          *(LAS f16x8*)(lds + OFF_KDECT + d * RS + (8 * w) * 2) = kd;
          if (w == 0) ((LAS float*)(lds + OFF_EBL))[d] = __builtin_amdgcn_exp2f(blast); }
        GL_BAR();
#pragma unroll
        for (int q = 0; q < 2; ++q) { const int blk = 2 * w + q, ib = blk >> 2, jb = blk & 3;
            f32x4 sc = {0.f, 0.f, 0.f, 0.f};
            if (jb <= ib) {
#pragma unroll
                for (int ks = 0; ks < 2; ++ks) { const f16x8 a = *(const LAS f16x8*)(lds + OFF_KREL + (16 * jb + l15) * RS + (32 * ks + 8 * kg) * 2), bq = *(const LAS f16x8*)(lds + OFF_QREL + (16 * ib + l15) * RS + (32 * ks + 8 * kg) * 2);
                    sc = __builtin_amdgcn_mfma_f32_16x16x32_f16(a, bq, sc, 0, 0, 0); }
                if (jb == ib) {
#pragma unroll
                    for (int r = 0; r < 4; ++r) { const int j = 4 * kg + r, i = l15; const bool keep = dir ? (j < i) : (j <= i); if (!keep) sc[r] = 0.f; }
                }
            }
            f16x4 o; o[0] = (h16)sc[0]; o[1] = (h16)sc[1]; o[2] = (h16)sc[2]; o[3] = (h16)sc[3];
            *(LAS f16x4*)(lds + OFF_SC + (16 * ib + l15) * RS + (16 * jb + 4 * kg) * 2) = o; }
        f16x8 Vf[2], Sf[2];
#pragma unroll
        for (int ks = 0; ks < 2; ++ks) {
            v4i16_t t0, t1;
            { const int q = l15 >> 2, p = l15 & 3;
              const int tk0 = 32 * ks + 8 * kg + q, tk1 = tk0 + 4;
              const int c0 = (2 * w + (p >> 1)) ^ vswz(tk0), c1 = (2 * w + (p >> 1)) ^ vswz(tk1);
              t0 = __builtin_amdgcn_ds_read_tr16_b64_v4i16((LAS v4i16_t*)(raw + RAW_V + tk0 * 256 + c0 * 16 + (p & 1) * 8));
              t1 = __builtin_amdgcn_ds_read_tr16_b64_v4i16((LAS v4i16_t*)(raw + RAW_V + tk1 * 256 + c1 * 16 + (p & 1) * 8)); }
            const f16x4 a = __builtin_bit_cast(f16x4, t0), bq = __builtin_bit_cast(f16x4, t1);
            Vf[ks] = (f16x8){a[0], a[1], a[2], a[3], bq[0], bq[1], bq[2], bq[3]};
            Sf[ks] = (f16x8){(h16)Sacc[2 * ks][0], (h16)Sacc[2 * ks][1], (h16)Sacc[2 * ks][2], (h16)Sacc[2 * ks][3], (h16)Sacc[2 * ks + 1][0], (h16)Sacc[2 * ks + 1][1], (h16)Sacc[2 * ks + 1][2], (h16)Sacc[2 * ks + 1][3]};
        }
        GL_BAR();
        { f16x8 fsc[4][2], fqd[4][2], fkd[4][2]; f32x4 feb[4];
#pragma unroll
          for (int ib = 0; ib < 4; ++ib)
#pragma unroll
              for (int ks = 0; ks < 2; ++ks) { if (32 * ks <= 16 * ib + 15) fsc[ib][ks] = *(const LAS f16x8*)(lds + OFF_SC + (16 * ib + l15) * RS + (32 * ks + 8 * kg) * 2);
                  fqd[ib][ks] = *(const LAS f16x8*)(lds + OFF_QDEC + (16 * ib + l15) * RS + (32 * ks + 8 * kg) * 2); }
#pragma unroll
          for (int blk = 0; blk < 4; ++blk) { feb[blk] = *(const LAS f32x4*)(lds + OFF_EBL + (16 * blk + 4 * kg) * 4);
#pragma unroll
              for (int ks = 0; ks < 2; ++ks) fkd[blk][ks] = *(const LAS f16x8*)(lds + OFF_KDECT + (16 * blk + l15) * RS + (32 * ks + 8 * kg) * 2); }
          asm volatile("s_waitcnt lgkmcnt(0)" ::: "memory"); __builtin_amdgcn_sched_barrier(0);
          f32x4 oa[4];
#pragma unroll
          for (int ib = 0; ib < 4; ++ib) oa[ib] = (f32x4){0.f, 0.f, 0.f, 0.f};
#pragma unroll
          for (int ks = 0; ks < 2; ++ks)
#pragma unroll
              for (int ib = 0; ib < 4; ++ib) { if (32 * ks <= 16 * ib + 15) oa[ib] = __builtin_amdgcn_mfma_f32_16x16x32_f16(fsc[ib][ks], Vf[ks], oa[ib], 0, 0, 0); }
#pragma unroll
          for (int ks = 0; ks < 2; ++ks)
#pragma unroll
              for (int ib = 0; ib < 4; ++ib) oa[ib] = __builtin_amdgcn_mfma_f32_16x16x32_f16(fqd[ib][ks], Sf[ks], oa[ib], 0, 0, 0);
#pragma unroll
          for (int blk = 0; blk < 4; ++blk) Sacc[blk] = Sacc[blk] * feb[blk];
#pragma unroll
          for (int ks = 0; ks < 2; ++ks)
#pragma unroll
              for (int blk = 0; blk < 4; ++blk) Sacc[blk] = __builtin_amdgcn_mfma_f32_16x16x32_f16(fkd[blk][ks], Vf[ks], Sacc[blk], 0, 0, 0);
#pragma unroll
          for (int ib = 0; ib < 4; ++ib) opend[ib] = oa[ib]; }
        asm volatile("s_waitcnt vmcnt(0)" ::: "memory");
        if (c + 1 < SEQ / 64) GL_GATES(cur ^ 1);
        { LAS unsigned char* stg = lds + OFF_QREL + w * 2048;
#pragma unroll
          for (int ib = 0; ib < 4; ++ib)
#pragma unroll
              for (int r = 0; r < 4; ++r) *(LAS h16*)(stg + (16 * ib + 4 * kg + r) * 32 + l15 * 2) = (h16)opend[ib][r];
          asm volatile("s_waitcnt lgkmcnt(0)" ::: "memory");
#pragma unroll
          for (int q = 0; q < 2; ++q) { const int p = q * 64 + lane, i = p >> 1; const u32x4 v = *(const LAS u32x4*)(stg + p * 16);
              *(u32x4*)(OG + ((size_t)dir * T + (size_t)b * SEQ + GL_TOK(c, i)) * 512 + h * 128 + 16 * w + (p & 1) * 8) = v; } }
        GL_BAR();
    }
#undef GL_ISSUE
#undef GL_TOK
#undef GL_GATES
}
#undef GL_DMA
#undef GL_BAR
}

namespace rt {
typedef _Float16 f16x8 __attribute__((ext_vector_type(8)));
__device__ __forceinline__ void route_block(LAS unsigned char* lds, const h16* __restrict__ X1H, const h16* __restrict__ W16, const float* __restrict__ SSQ, const float* __restrict__ bg, const float* __restrict__ be,
                                            float* RS2, int* TOKE, int* TOKP, float* TOKW, int* ETOK, float* ESC, int* cnt, int row0) {
    int tid = threadIdx.x; asm volatile("" : "+v"(tid));
    const int lane = tid & 63, w = __builtin_amdgcn_readfirstlane(tid >> 6), l15 = lane & 15, kg = lane >> 4;
    f32x4 acc[4][3];
#pragma unroll
    for (int i = 0; i < 4; ++i)
#pragma unroll
        for (int j = 0; j < 3; ++j) acc[i][j] = (f32x4){0.f, 0.f, 0.f, 0.f};
    f16x8 af[4][4], bf[3][4];
#pragma unroll
    for (int ks = 0; ks < 4; ++ks) { const int k0 = 128 * w + 32 * ks + 8 * kg;
#pragma unroll
        for (int i = 0; i < 4; ++i) af[i][ks] = *(const f16x8*)(X1H + (size_t)(row0 + 16 * i + l15) * DM + k0);
#pragma unroll
        for (int j = 0; j < 3; ++j) bf[j][ks] = *(const f16x8*)(W16 + (size_t)(16 * j + l15) * DM + k0); }
#pragma unroll
    for (int ks = 0; ks < 4; ++ks)
#pragma unroll
        for (int i = 0; i < 4; ++i)
#pragma unroll
            for (int j = 0; j < 3; ++j) acc[i][j] = __builtin_amdgcn_mfma_f32_16x16x32_f16(bf[j][ks], af[i][ks], acc[i][j], 0, 0, 0);
    LAS float* PS = (LAS float*)lds;
#pragma unroll
    for (int i = 0; i < 4; ++i)
#pragma unroll
        for (int j = 0; j < 3; ++j) *(LAS f32x4*)(PS + (w * 64 + 16 * i + l15) * 48 + 16 * j + 4 * kg) = acc[i][j];
    LDS_WAIT(); __builtin_amdgcn_s_barrier(); asm volatile("" ::: "memory");
    LAS float* L = (LAS float*)(lds + 8 * 64 * 48 * 4);
    for (int t = tid; t < 64 * 12; t += NTHREADS) { const int r = t / 12, c4 = (t % 12) * 4; f32x4 sum = {0.f, 0.f, 0.f, 0.f};
#pragma unroll
        for (int ww = 0; ww < 8; ++ww) sum += *(const LAS f32x4*)(PS + (ww * 64 + r) * 48 + c4);
        *(LAS f32x4*)(L + r * 48 + c4) = sum; }
    LDS_WAIT(); __builtin_amdgcn_s_barrier(); asm volatile("" ::: "memory");
    if (tid < 64) { const int r = tid, m = row0 + r; LAS float* l = L + r * 48;
        float ss = 0.f; { const f32x4* sp = (const f32x4*)(SSQ + (size_t)m * 16);
#pragma unroll
            for (int i = 0; i < 4; ++i) { const f32x4 t4 = sp[i]; ss += (t4[0] + t4[1]) + (t4[2] + t4[3]); } }
        const float rs = rsqrtf(ss * (1.f / DM) + EPS);
        float mx = l[0] * rs + bg[0]; int gi = 0;
        for (int g = 1; g < 4; ++g) { const float v = l[g] * rs + bg[g]; if (v > mx) { mx = v; gi = g; } }
        float den = 0.f;
        for (int g = 0; g < 4; ++g) den += expf(l[g] * rs + bg[g] - mx);
        const float ptop = 1.f / den;
        LAS float* l8 = l + 4 + gi * 8;
        for (int j = 0; j < 8; ++j) l8[j] = l8[j] * rs + be[gi * 8 + j];
        float b0 = l8[0]; int i0 = 0;
        for (int j = 1; j < 8; ++j) if (l8[j] > b0) { b0 = l8[j]; i0 = j; }
        float b1 = -3.0e38f; int i1 = 0;
        for (int j = 0; j < 8; ++j) if (j != i0 && l8[j] > b1) { b1 = l8[j]; i1 = j; }
        const float p1 = expf(b1 - b0);
        const float w0 = ptop / (1.f + p1), w1 = ptop * p1 / (1.f + p1);
        const int e0 = gi * 8 + i0, e1 = gi * 8 + i1;
        LAS int* H = (LAS int*)(lds + 8 * 64 * 48 * 4 + 64 * 48 * 4);
        if (tid < 32) H[tid] = 0;
        __builtin_amdgcn_wave_barrier(); asm volatile("s_waitcnt lgkmcnt(0)" ::: "memory");
        const int r0 = __hip_atomic_fetch_add(H + e0, 1, __ATOMIC_RELAXED, __HIP_MEMORY_SCOPE_WORKGROUP), r1 = __hip_atomic_fetch_add(H + e1, 1, __ATOMIC_RELAXED, __HIP_MEMORY_SCOPE_WORKGROUP);
        __builtin_amdgcn_wave_barrier(); asm volatile("s_waitcnt lgkmcnt(0)" ::: "memory");
        if (tid < 32) { const int c = H[tid]; H[32 + tid] = c ? atomicAdd(&cnt[tid], c) : 0; }
        __builtin_amdgcn_wave_barrier(); asm volatile("s_waitcnt vmcnt(0) lgkmcnt(0)" ::: "memory");
        const int q0 = H[32 + e0] + r0, q1 = H[32 + e1] + r1;
        ETOK[e0 * ECAP + q0] = m; ETOK[e1 * ECAP + q1] = m;
        ESC[((size_t)e0 * ECAP + q0) * 2] = rs; ESC[((size_t)e0 * ECAP + q0) * 2 + 1] = w0;
        ESC[((size_t)e1 * ECAP + q1) * 2] = rs; ESC[((size_t)e1 * ECAP + q1) * 2 + 1] = w1;
        RS2[m] = rs; TOKE[m * 2] = e0; TOKE[m * 2 + 1] = e1; TOKP[m * 2] = q0; TOKP[m * 2 + 1] = q1; TOKW[m * 2] = w0; TOKW[m * 2 + 1] = w1;
    }
    __syncthreads();
}
}

__global__ void __launch_bounds__(NTHREADS, 2) mega_fwd(MArgs args_) {
    KArgs ap = (KArgs)__builtin_amdgcn_kernarg_segment_ptr(); (void)args_;
#define args (*ap)
    extern __shared__ __attribute__((aligned(16))) unsigned char lds_raw[];
    LAS unsigned char* lds = (LAS unsigned char*)lds_raw;
    volatile LAS unsigned* MISC = (volatile LAS unsigned*)(lds + MISC_OFF);
    const int tid = threadIdx.x, lane = tid & 63, wave = __builtin_amdgcn_readfirstlane(tid >> 6);
    const int G = gridDim.x, bx = blockIdx.x;
    const int vcu = (G % 8 == 0) ? (bx % 8) * (G / 8) + bx / 8 : bx;
    unsigned* ctl = (unsigned*)(args.ws + WS_CTL);
    for (int u = tid; u < (LDS_BYTES - RING_BYTES) / 4; u += NTHREADS) ((LAS unsigned*)(lds + RING_BYTES))[u] = 0u;
    __syncthreads();
    XcdBarrier bar = xcd_barrier_post(ctl + CW_BAR + args.li * XCD_BAR_WORDS, MISC + 8);
    const int gw = vcu * NWAVES + wave, NGW = G * NWAVES;
    const int lo = args.ph_lo, hi = args.ph_hi;
#ifndef DUP_PHASE
#define DUP_PHASE -1
#endif
#define REPS(k) ((k) == DUP_PHASE ? 3 : 1)
#define IN(k) (lo <= (k) && (k) < hi)
#define BOTH(k) (IN(k) && IN((k) + 1))
    asm volatile("" : "+s"(ap));
    if (IN(0)) for (int rep = 0; rep < REPS(0); ++rep) { p0_prologue(ap, lds, gw, NGW, lane, wave); if (BOTH(0) || rep + 1 < REPS(0)) xcd_barrier(bar); }
    asm volatile("" : "+s"(ap));
    if (IN(1)) for (int rep = 0; rep < REPS(1); ++rep) {
        g8::PlainProb p{(const h16*)(args.ws + WS_H1), (const h16*)(args.ws + WS_WINT), DM, DM, DM};
        g8::StaticOrder S; S.init(T / 256, NPROJ / 256, G, bx);
        g8::EpiH16 E{(h16*)(args.ws + WS_PROJ), NPROJ, (h16*)(args.ws + WS_QF)};
        g8::gemm_phase<g8::PlainProb, g8::EpiH16, g8::StaticOrder, true>(lds, p, S, E);
        if (BOTH(1) || rep + 1 < REPS(1)) xcd_barrier(bar);
    }
    asm volatile("" : "+s"(ap));
    if (IN(2)) for (int rep = 0; rep < REPS(2); ++rep) {
        const h16* PROJ = (const h16*)(args.ws + WS_PROJ); const float* CS = (const float*)(args.ws + WS_CS);
        g8::StaticOrder S; S.init(T / 256, 4, G, bx);
        g8::Unit u;
        for (int i = 0; S.next(i, u); ++i) {
            int kkv = 128; asm volatile("" : "+s"(kkv));
            g8::PlainProb p{PROJ + PC_MKVA, (const h16*)(args.ws + WS_WKVBT), NPROJ, 256, kkv};
            g8::EpiKV E{PROJ, (const float*)args.in[14], CS, (h16*)(args.ws + WS_KF), (h16*)(args.ws + WS_VF)};
            g8::OneUnit O{u};
            g8::gemm_phase<g8::PlainProb, g8::EpiKV, g8::OneUnit, false>(lds, p, O, E);
            __syncthreads();
        }
        if (BOTH(2) || rep + 1 < REPS(2)) xcd_barrier(bar);
    }
    asm volatile("" : "+s"(ap));
    if (IN(PH_MIX)) for (int rep = 0; rep < REPS(PH_MIX); ++rep) {
        const h16* PROJ = (const h16*)(args.ws + WS_PROJ);
        { const int x0 = (int)(xb_xcc_id() & 7u);
          for (int k = 0; k < 8; ++k) { const int x = (x0 + k) & 7;
              for (;;) {
                  if (tid == 0) MISC[16] = xb_add(ctl + CW_Q + 64 * (rep * 8 + x), 1u);
                  __syncthreads();
                  const int idx = (int)MISC[16];
                  __syncthreads();
                  if (idx >= 152) break;
                  if (idx < 8) { const int dir = idx & 1, hh = idx >> 1; gl::gla_unit(lds, PROJ, (const float*)args.in[dir ? 6 : 4], (const float*)args.in[dir ? 7 : 5], (h16*)(args.ws + WS_OGLA), x, hh, dir);
                      VM_WAIT(); __syncthreads();
                      if (wave == 0) { __builtin_amdgcn_fence(__ATOMIC_RELEASE, "agent"); VM_WAIT(); xb_add(ctl + CW_GLADONE + 64 * (rep * 8 + x), lane == 0 ? 1u : 0u); } }
                  else if (idx < 96 && ((idx - 8) % 11) < 8) { const int a = ((idx - 8) / 11) * 8 + ((idx - 8) % 11); at::attn_unit(lds, (const h16*)(args.ws + WS_QF), (const h16*)(args.ws + WS_WQBT), (const float*)args.in[13], (const float*)(args.ws + WS_CS), (const h16*)(args.ws + WS_KF), (const h16*)(args.ws + WS_VF), (h16*)(args.ws + WS_MIX), x * 8 + (a >> 3), a & 7); }
                  else if (idx < 120) {
                      int ln = lane; asm volatile("" : "+v"(ln));
                      const int bj = idx < 96 ? ((idx - 8) / 11) * 3 + ((idx - 8) % 11) - 8 : idx - 72;
                      const int base = (x * 48 + bj) * 32 + wave * 4; LAS float* scr = (LAS float*)(lds + wave * 16384);
                      if (rep == 0) expert_items4(ap, base, scr, ln);
                      __syncthreads(); }
                  else {
                      const int j = idx - 120;
                      if (wave == 0) { unsigned sp = 0; while ((unsigned)__builtin_amdgcn_readfirstlane(xb_ld(ctl + CW_GLADONE + 64 * (rep * 8 + x))) < 8u) { __builtin_amdgcn_s_sleep(4); if (++sp > (1u << 16)) break; }
                          __builtin_amdgcn_fence(__ATOMIC_ACQUIRE, "agent"); VM_WAIT(); }
                      __syncthreads();
                      int ln = lane; asm volatile("" : "+v"(ln));
                      const int m0 = x * SEQ + j * 64 + wave * 8;
                      gla_combine_rows((const h16*)(args.ws + WS_OGLA), PROJ, (const float*)args.in[8], (h16*)(args.ws + WS_MIX), m0, m0 + 8, 1, ln);
                      __syncthreads(); }
              } } }
        if (BOTH(PH_MIX) || rep + 1 < REPS(PH_MIX)) xcd_barrier(bar);
    }
    asm volatile("" : "+s"(ap));
    if (IN(PH_COMB)) for (int rep = 0; rep < REPS(PH_COMB); ++rep) {
    }
    asm volatile("" : "+s"(ap));
    if (IN(PH_OUT)) for (int rep = 0; rep < REPS(PH_OUT); ++rep) {
        g8::PlainProb p{(const h16*)(args.ws + WS_MIX), (const h16*)(args.ws + WS_WOUTT), DM, DM, DM};
        g8::StaticOrder S; S.init(T / 256, DM / 256, G, bx);
        g8::EpiResid E{(const float*)args.in[0], (h16*)(args.ws + WS_X1H), (float*)(args.ws + WS_SSQ)};
        g8::gemm_phase<g8::PlainProb, g8::EpiResid, g8::StaticOrder, true>(lds, p, S, E);
        if (BOTH(PH_OUT) || rep + 1 < REPS(PH_OUT)) xcd_barrier(bar);
    }
    asm volatile("" : "+s"(ap));
    if (IN(PH_ROUTE)) {
        for (int blk = bx; blk < T / 64; blk += G)
            rt::route_block(lds, (const h16*)(args.ws + WS_X1H), (const h16*)(args.ws + WS_WRT16), (const float*)(args.ws + WS_SSQ), (const float*)args.in[18], (const float*)args.in[20],
                            (float*)(args.ws + WS_RS2), (int*)(args.ws + WS_TOKE), (int*)(args.ws + WS_TOKP), (float*)(args.ws + WS_TOKW), (int*)(args.ws + WS_ETOK), (float*)(args.ws + WS_ESC), (int*)(ctl + CW_CNT), blk * 64);
        if (BOTH(PH_ROUTE)) xcd_barrier(bar);
    }
    volatile LAS int* GT = (volatile LAS int*)(lds + MISC_OFF + 128);
    asm volatile("" : "+s"(ap));
    if (IN(PH_UP) || IN(PH_DOWN) || IN(PH_FIN)) {
        if (wave == 0) {
            const int e = lane & 31; const bool act = lane < 32;
            const int n = act ? __hip_atomic_load((int*)(ctl + CW_CNT) + e, __ATOMIC_RELAXED, __HIP_MEMORY_SCOPE_AGENT) : 0;
            const int t = (n + 255) >> 8, f = n >> 8, r = n & 255;
            int tpi = t, pfi = f;
#pragma unroll
            for (int o = 1; o < 32; o <<= 1) { const int a1 = __shfl_up(tpi, o), a2 = __shfl_up(pfi, o); if (e >= o) { tpi += a1; pfi += a2; } }
            const int tp = tpi - t, pf = pfi - f;
            const int tp_tot = __shfl(tpi, 31), pf_tot = __shfl(pfi, 31);
            const int cls = r ? ((r - 1) >> 6) : -1; int pos = 0;
#pragma unroll
            for (int c = 3; c >= 0; --c) { const unsigned long long m = __ballot(act && cls == c);
                if (cls == c) pos += __popcll(m & ((1ull << e) - 1ull)); else if (cls < c) pos += __popcll(m); }
            if (act) { GT[e] = tp; GT[64 + e] = tp * 256; GT[128 + e] = n; GT[192 + e] = pf; if (r) GT[232 + pos] = e; }
            if (lane == 0) { GT[32] = tp_tot; GT[64 + 32] = tp_tot * 256; GT[192 + 32] = pf_tot; } }
        __syncthreads();
    }
    asm volatile("" : "+s"(ap));
    if (IN(PH_UP)) for (int rep = 0; rep < REPS(PH_UP); ++rep) {
        g8::GatherProb p{(const h16*)(args.ws + WS_X1H), (const h16*)(args.ws + WS_WGUT), (const int*)(args.ws + WS_ETOK), GT, DM, DM, DM};
        g8::DynGroupSched S{GT, 2, ctl + CW_MOEQ, MISC + 20};
        g8::EpiHid E{(const float*)(args.ws + WS_ESC), GT, (h16*)(args.ws + WS_HID), ctl + CW_DONE};
        g8::gemm_phase<g8::GatherProb, g8::EpiHid, g8::DynGroupSched, true, true>(lds, p, S, E);
        if (!IN(PH_DOWN)) { if (BOTH(PH_UP) || rep + 1 < REPS(PH_UP)) xcd_barrier(bar); }
        else __syncthreads();
    }
    asm volatile("" : "+s"(ap));
    if (IN(PH_DOWN)) for (int rep = 0; rep < REPS(PH_DOWN); ++rep) {
        g8::SlotProb p{(const h16*)(args.ws + WS_HID), (const h16*)(args.ws + WS_WDT), GT, DEXP, DEXP, DEXP};
        g8::DynGroupSchedDep S{{GT, 4, ctl + CW_MOEQ + 64, MISC + 22}, ctl + CW_DONE, 16u};
        g8::EpiY E{GT, (h16*)(args.ws + WS_Y)};
        g8::gemm_phase<g8::SlotProb, g8::EpiY, g8::DynGroupSchedDep, true, true>(lds, p, S, E);
        if (BOTH(PH_DOWN) || rep + 1 < REPS(PH_DOWN)) xcd_barrier(bar);
    }
    asm volatile("" : "+s"(ap));
    if (IN(PH_FIN)) {
        const h16* X1H = (const h16*)(args.ws + WS_X1H); const h16* Y = (const h16*)(args.ws + WS_Y);
        const int* TOKE = (const int*)(args.ws + WS_TOKE); const int* TOKP = (const int*)(args.ws + WS_TOKP);
        typedef _Float16 h8 __attribute__((ext_vector_type(8)));
        for (int q0 = 0; gw + NGW * q0 < T; q0 += 8) {
        int myslot = 0;
        { const int q = lane >> 1, r = lane & 1, m = gw + NGW * (q0 + q); if (lane < 16 && m < T) myslot = GT[64 + TOKE[m * 2 + r]] + TOKP[m * 2 + r]; }
        for (int q = 0; q < 8; q += 2) {
            const int mA = gw + NGW * (q0 + q), mB = mA + NGW; if (mA >= T) break;
            const bool hasB = mB < T;
            const int sA0 = __shfl(myslot, 2 * q), sA1 = __shfl(myslot, 2 * q + 1), sB0 = __shfl(myslot, 2 * q + 2), sB1 = __shfl(myslot, 2 * q + 3);
            h8 a[2][2], y0[2][2], y1[2][2];
#pragma unroll
            for (int j = 0; j < 2; ++j) { const int c = j * 512 + lane * 8;
                a[0][j] = *(const h8*)(X1H + (size_t)mA * DM + c); y0[0][j] = *(const h8*)(Y + (size_t)sA0 * DM + c); y1[0][j] = *(const h8*)(Y + (size_t)sA1 * DM + c);
                a[1][j] = *(const h8*)(X1H + (size_t)(hasB ? mB : mA) * DM + c); y0[1][j] = *(const h8*)(Y + (size_t)(hasB ? sB0 : sA0) * DM + c); y1[1][j] = *(const h8*)(Y + (size_t)(hasB ? sB1 : sA1) * DM + c); }
#pragma unroll
            for (int t2 = 0; t2 < 2; ++t2) { if (t2 == 1 && !hasB) break; const int m = t2 ? mB : mA;
#pragma unroll
                for (int j = 0; j < 2; ++j) { const int c = j * 512 + lane * 8; f32x4 o0, o1;
#pragma unroll
                    for (int k = 0; k < 4; ++k) { o0[k] = (float)a[t2][j][k] + ((float)y0[t2][j][k] + (float)y1[t2][j][k]); o1[k] = (float)a[t2][j][4 + k] + ((float)y0[t2][j][4 + k] + (float)y1[t2][j][4 + k]); }
                    *(f32x4*)(args.out + (size_t)m * DM + c) = o0; *(f32x4*)(args.out + (size_t)m * DM + c + 4) = o1; } }
        }
        }
    }
#undef args
#undef IN
#undef BOTH
#undef REPS
}

extern "C" void kernel_launch(void* const* d_in, const int* in_sizes, int n_in, void* d_out, int out_size, void* d_ws, size_t ws_size, hipStream_t stream) {
    if (n_in != 24 || out_size != T * DM || ws_size < WS_END) { fprintf(stderr, "kernel_launch: unexpected shapes (n_in %d out %d ws %zu)\n", n_in, out_size, ws_size); return; }
    static int grid = 0;
    if (grid == 0) {
        int dev = 0, cus = 0;
        if (hipGetDevice(&dev) != hipSuccess || hipDeviceGetAttribute(&cus, hipDeviceAttributeMultiprocessorCount, dev) != hipSuccess) { fprintf(stderr, "kernel_launch: device query failed\n"); grid = -1; return; }
        if (hipFuncSetAttribute((const void*)mega_fwd, hipFuncAttributeMaxDynamicSharedMemorySize, LDS_BYTES) != hipSuccess) { fprintf(stderr, "kernel_launch: hipFuncSetAttribute failed\n"); grid = -1; return; }
        int per_cu = 0; (void)hipOccupancyMaxActiveBlocksPerMultiprocessor(&per_cu, (const void*)mega_fwd, NTHREADS, LDS_BYTES); (void)hipGetLastError();
        if (per_cu < 1) fprintf(stderr, "kernel_launch: note: occupancy query reports %d\n", per_cu);
        grid = cus;
    }
    if (grid < 0) return;
    char* ws = (char*)d_ws; float* out = (float*)d_out;
    (void)hipMemsetAsync(ws + WS_CTL, 0, CTL_ZERO_BYTES, stream);
    MArgs a{};
    for (int i = 0; i < 24; ++i) a.in[i] = d_in[i];
    a.out = out; a.ws = (unsigned char*)d_ws; a.ph_lo = 0; a.ph_hi = PH_END; a.li = 0;
    hipLaunchKernelGGL(mega_fwd, dim3(grid), dim3(NTHREADS), LDS_BYTES, stream, a);
}
```
